# Optimizing an MI355X kernel written in HIP

```python
import math
import jax, jax.numpy as jnp
from jax import lax
import numpy as np

D_MODEL = 1024
BATCH = 8
SEQ = 4096
DEPTH = 4
DEC_BATCH = 32
DEC_SEQ = 64
PAST_LEN = 4096

CHUNK = 64
N_A_LAYERS = DEPTH // 2
N_B_LAYERS = DEPTH - N_A_LAYERS
M_HEADS = 8
M_DV = D_MODEL // M_HEADS
M_DK = M_DV // 2
M_IN = 2 * M_HEADS * M_DK + 2 * D_MODEL + 2 * M_HEADS
A_HEADS = 8
A_DH = D_MODEL // (2 * A_HEADS)
N_BUCKETS = 32
MAX_DISTANCE = 128
Q_BLOCK = 128
D_FF = -(-8 * D_MODEL // (3 * 256)) * 256
EPS = 1e-6
NEG_BIG = -1e30

kernel_name = 'yoco_mlstm_diffattn_stream_step'


def _rms(x, g):
    xf = x.astype(jnp.float32)
    y = xf * lax.rsqrt(jnp.mean(xf * xf, axis=-1, keepdims=True) + EPS)
    return (y * g).astype(x.dtype)


def _modulate(x, g, shift, scale):
    return _rms(x, g) * (1 + scale[:, None, :]) + shift[:, None, :]


def _swiglu(x, w_gate, w_up, w_down):
    return (jax.nn.silu(x @ w_gate) * (x @ w_up)) @ w_down


def _rel_bucket(rel):
    nb = N_BUCKETS // 2
    max_exact = nb // 2
    ret = jnp.where(rel > 0, nb, 0)
    n = jnp.abs(rel)
    large = max_exact + (jnp.log(jnp.maximum(n, 1).astype(jnp.float32) / max_exact)
                         / math.log(MAX_DISTANCE / max_exact) * (nb - max_exact)).astype(jnp.int32)
    large = jnp.minimum(large, nb - 1)
    return ret + jnp.where(n < max_exact, n, large)


def _mlstm_chunk_step(carry, inp):
    C, n, m = carry
    q, k, v, ig, lf = inp
    L = q.shape[2]
    tri = jnp.tril(jnp.ones((L, L), dtype=bool))
    b = jnp.cumsum(lf, axis=-1)
    dmat = jnp.where(tri, b[..., :, None] - b[..., None, :] + ig[..., None, :], -jnp.inf)
    inter = b + m[..., None]
    m_t = jnp.maximum(inter, jnp.max(dmat, axis=-1))
    w_intra = jnp.exp(dmat - m_t[..., None])
    w_inter = jnp.exp(inter - m_t)
    s = jnp.einsum('bhtd,bhsd->bhts', q, k) * w_intra
    num = w_inter[..., None] * jnp.einsum('bhtd,bhde->bhte', q, C) + jnp.einsum('bhts,bhse->bhte', s, v)
    den = w_inter * jnp.einsum('bhtd,bhd->bht', q, n) + jnp.sum(s, axis=-1)
    h = num / jnp.maximum(jnp.abs(den), jnp.exp(-m_t))[..., None]
    b_end = b[..., -1]
    g = b_end[..., None] - b + ig
    m_new = jnp.maximum(b_end + m, jnp.max(g, axis=-1))
    w_old = jnp.exp(b_end + m - m_new)
    w_new = jnp.exp(g - m_new[..., None])
    C_new = w_old[..., None, None] * C + jnp.einsum('bhs,bhsd,bhse->bhde', w_new, k, v)
    n_new = w_old[..., None] * n + jnp.einsum('bhs,bhsd->bhd', w_new, k)
    return (C_new, n_new, m_new), h


def _mlstm_mixer(xm, w_in, b_gates, head_g, w_out, carry, chunk_len):
    B, T, _ = xm.shape
    nc = T // chunk_len
    qk = M_HEADS * M_DK
    proj = xm @ w_in
    q, k, v, o, gates = jnp.split(proj, [qk, 2 * qk, 2 * qk + D_MODEL, 2 * qk + 2 * D_MODEL], axis=-1)
    gates = gates.astype(jnp.float32) + b_gates.astype(jnp.float32)
    ig = gates[..., :M_HEADS]
    lf = jax.nn.log_sigmoid(gates[..., M_HEADS:])

    def to_chunks(a, d):
        return a.reshape(B, nc, chunk_len, M_HEADS, d).transpose(1, 0, 3, 2, 4)

    def gate_chunks(a):
        return a.reshape(B, nc, chunk_len, M_HEADS).transpose(1, 0, 3, 2)

    qc = to_chunks(q, M_DK)
    kc = to_chunks(k, M_DK) * (M_DK ** -0.5)
    vc = to_chunks(v, M_DV)
    carry = tuple(a.astype(jnp.float32) for a in carry)
    carry, h = lax.scan(_mlstm_chunk_step, carry, (qc, kc, vc, gate_chunks(ig), gate_chunks(lf)))
    h = h.transpose(1, 0, 3, 2, 4).reshape(B, T, M_HEADS, M_DV)
    h = _rms(h, head_g).reshape(B, T, D_MODEL) * jax.nn.sigmoid(o)
    return (h @ w_out).astype(xm.dtype), carry


def _shared_kv(x, kv_g, w_k, w_v, k_g):
    B, T, _ = x.shape
    h = _rms(x, kv_g)
    k = _rms((h @ w_k).reshape(B, T, A_HEADS, 2, A_DH), k_g)
    v = (h @ w_v).reshape(B, T, A_HEADS, 2 * A_DH)
    return k, v


def _diff_attention(xm, k_all, v_all, q_offset, w_q, q_g, lam_p, head_g, w_o, rel_bias, lam_init):
    B, T, _ = xm.shape
    Tk = k_all.shape[1]
    q = _rms((xm @ w_q).reshape(B, T, A_HEADS, 2, A_DH), q_g) * (A_DH ** -0.5)
    lp = lam_p.astype(jnp.float32)
    lam = jnp.exp(jnp.sum(lp[0] * lp[1])) - jnp.exp(jnp.sum(lp[2] * lp[3])) + lam_init
    qb = min(T, Q_BLOCK)
    nb = T // qb
    q_blocks = q.reshape(B, nb, qb, A_HEADS, 2, A_DH).transpose(1, 0, 2, 3, 4, 5)
    k_pos = jnp.arange(Tk)
    k_chunk = k_pos // CHUNK
    table = rel_bias.astype(jnp.float32)

    def block(args):
        qblk, start = args
        q_pos = q_offset + start + jnp.arange(qb)
        s = jnp.einsum('bqhcd,bkhcd->bhcqk', qblk, k_all).astype(jnp.float32)
        bias = table[_rel_bucket(k_pos[None, :] - q_pos[:, None])]
        bias = bias.transpose(2, 0, 1)[None, :, None]
        mask = k_chunk[None, :] <= (q_pos // CHUNK)[:, None]
        p = jax.nn.softmax(jnp.where(mask, s + bias, NEG_BIG), axis=-1)
        a = p[:, :, 0] - lam * p[:, :, 1]
        return jnp.einsum('bhqk,bkhe->bqhe', a, v_all)

    o = lax.map(block, (q_blocks, jnp.arange(nb) * qb))
    o = o.transpose(1, 0, 2, 3, 4).reshape(B, T, A_HEADS, 2 * A_DH)
    o = _rms(o, head_g) * (1 - lam_init)
    return (o.reshape(B, T, D_MODEL) @ w_o).astype(xm.dtype)


def _trunk(x, c, mstate, past_k, past_v, q_offset, chunk_len, p):
    new_C, new_n, new_m = [], [], []
    k_all = v_all = new_k = new_v = None
    for l in range(DEPTH):
        mod = jax.nn.silu(c) @ p['ada_w'][l] + p['ada_b'][l]
        sh1, sc1, g1, sh2, sc2, g2 = jnp.split(mod, 6, axis=-1)
        xm = _modulate(x, p['norm_g'][l, 0], sh1, sc1)
        if l < N_A_LAYERS:
            carry = (mstate[0][l], mstate[1][l], mstate[2][l])
            y, (C, n, m) = _mlstm_mixer(xm, p['mlstm_w_in'][l], p['mlstm_b_gates'][l], p['mlstm_head_g'][l],
                                        p['mlstm_w_out'][l], carry, chunk_len)
            new_C.append(C)
            new_n.append(n)
            new_m.append(m)
        else:
            j = l - N_A_LAYERS
            lam_init = 0.8 - 0.6 * math.exp(-0.3 * l)
            y = _diff_attention(xm, k_all, v_all, q_offset, p['attn_w_q'][j], p['q_norm_g'][j],
                                p['attn_lambda'][j], p['attn_head_g'][j], p['attn_w_o'][j],
                                p['rel_bias'], lam_init)
        x = x + g1[:, None, :] * y
        xm = _modulate(x, p['norm_g'][l, 1], sh2, sc2)
        x = x + g2[:, None, :] * _swiglu(xm, p['ffn_w_gate'][l], p['ffn_w_up'][l], p['ffn_w_down'][l])
        if l == N_A_LAYERS - 1:
            new_k, new_v = _shared_kv(x, p['kv_norm_g'], p['w_k'], p['w_v'], p['k_norm_g'])
            if past_k is None:
                k_all, v_all = new_k, new_v
            else:
                k_all = jnp.concatenate([past_k, new_k], axis=1)
                v_all = jnp.concatenate([past_v, new_v], axis=1)
    return x, jnp.stack(new_C), jnp.stack(new_n), jnp.stack(new_m), new_k, new_v


def setup_inputs(seed: int = 0) -> dict:
    key = jax.random.key(seed)
    ks = jax.random.split(key, 40)

    def nrm(k, shape, scale):
        return jax.random.normal(k, shape, jnp.float32) * scale

    def gain(k, shape):
        return 1.0 + nrm(k, shape, 0.02)

    fan = D_MODEL ** -0.5
    b_in = nrm(ks[12], (N_A_LAYERS, M_HEADS), 0.1)
    b_f = jnp.linspace(3.0, 6.0, M_HEADS, dtype=jnp.float32)[None, :] + nrm(ks[13], (N_A_LAYERS, M_HEADS), 0.1)
    return {
        'x_prompt': nrm(ks[0], (BATCH, SEQ, D_MODEL), 1.0),
        'x_sample': nrm(ks[1], (DEC_BATCH, DEC_SEQ, D_MODEL), 1.0),
        'c_prompt': nrm(ks[2], (BATCH, D_MODEL), 1.0),
        'c_sample': nrm(ks[3], (DEC_BATCH, D_MODEL), 1.0),
        'state_mlstm_C': nrm(ks[4], (N_A_LAYERS, DEC_BATCH, M_HEADS, M_DK, M_DV), 0.1),
        'state_mlstm_n': nrm(ks[5], (N_A_LAYERS, DEC_BATCH, M_HEADS, M_DK), 0.1),
        'state_mlstm_m': jax.random.uniform(ks[6], (N_A_LAYERS, DEC_BATCH, M_HEADS), jnp.float32, 0.0, 2.0),
        'cache_k': nrm(ks[7], (DEC_BATCH, PAST_LEN, A_HEADS, 2, A_DH), 1.0),
        'cache_v': nrm(ks[8], (DEC_BATCH, PAST_LEN, A_HEADS, 2 * A_DH), 1.0),
        'ada_w': nrm(ks[9], (DEPTH, D_MODEL, 6 * D_MODEL), 0.5 * fan),
        'ada_b': nrm(ks[10], (DEPTH, 6 * D_MODEL), 0.02),
        'norm_g': gain(ks[11], (DEPTH, 2, D_MODEL)),
        'mlstm_w_in': nrm(ks[14], (N_A_LAYERS, D_MODEL, M_IN), fan),
        'mlstm_b_gates': jnp.concatenate([b_in, b_f], axis=-1),
        'mlstm_head_g': gain(ks[15], (N_A_LAYERS, M_HEADS, M_DV)),
        'mlstm_w_out': nrm(ks[16], (N_A_LAYERS, D_MODEL, D_MODEL), fan),
        'kv_norm_g': gain(ks[17], (D_MODEL,)),
        'w_k': nrm(ks[18], (D_MODEL, D_MODEL), fan),
        'w_v': nrm(ks[19], (D_MODEL, D_MODEL), fan),
        'k_norm_g': gain(ks[20], (A_DH,)),
        'attn_w_q': nrm(ks[21], (N_B_LAYERS, D_MODEL, D_MODEL), fan),
        'q_norm_g': gain(ks[22], (N_B_LAYERS, A_DH)),
        'attn_lambda': nrm(ks[23], (N_B_LAYERS, 4, A_DH), 0.1),
        'attn_head_g': gain(ks[24], (N_B_LAYERS, 2 * A_DH)),
        'attn_w_o': nrm(ks[25], (N_B_LAYERS, D_MODEL, D_MODEL), fan),
        'rel_bias': nrm(ks[26], (N_BUCKETS, A_HEADS), 0.5),
        'ffn_w_gate': nrm(ks[27], (DEPTH, D_MODEL, D_FF), fan),
        'ffn_w_up': nrm(ks[28], (DEPTH, D_MODEL, D_FF), fan),
        'ffn_w_down': nrm(ks[29], (DEPTH, D_FF, D_MODEL), D_FF ** -0.5),
    }


def reference(x_prompt, x_sample, c_prompt, c_sample, state_mlstm_C, state_mlstm_n, state_mlstm_m,
              cache_k, cache_v, ada_w, ada_b, norm_g, mlstm_w_in, mlstm_b_gates, mlstm_head_g, mlstm_w_out,
              kv_norm_g, w_k, w_v, k_norm_g, attn_w_q, q_norm_g, attn_lambda, attn_head_g, attn_w_o,
              rel_bias, ffn_w_gate, ffn_w_up, ffn_w_down):
    p = dict(ada_w=ada_w, ada_b=ada_b, norm_g=norm_g, mlstm_w_in=mlstm_w_in, mlstm_b_gates=mlstm_b_gates,
             mlstm_head_g=mlstm_head_g, mlstm_w_out=mlstm_w_out, kv_norm_g=kv_norm_g, w_k=w_k, w_v=w_v,
             k_norm_g=k_norm_g, attn_w_q=attn_w_q, q_norm_g=q_norm_g, attn_lambda=attn_lambda,
             attn_head_g=attn_head_g, attn_w_o=attn_w_o, rel_bias=rel_bias, ffn_w_gate=ffn_w_gate,
             ffn_w_up=ffn_w_up, ffn_w_down=ffn_w_down)
    B = x_prompt.shape[0]
    zero_state = (jnp.zeros((N_A_LAYERS, B, M_HEADS, M_DK, M_DV), jnp.float32),
                  jnp.zeros((N_A_LAYERS, B, M_HEADS, M_DK), jnp.float32),
                  jnp.zeros((N_A_LAYERS, B, M_HEADS), jnp.float32))
    y_prompt, prompt_C, prompt_n, prompt_m, prompt_k, prompt_v = _trunk(
        x_prompt, c_prompt, zero_state, None, None, 0, CHUNK, p)
    y_sample, sample_C, sample_n, sample_m, sample_k, sample_v = _trunk(
        x_sample, c_sample, (state_mlstm_C, state_mlstm_n, state_mlstm_m), cache_k, cache_v,
        PAST_LEN, x_sample.shape[1], p)
    return (y_prompt, y_sample, prompt_C, prompt_n, prompt_m, prompt_k, prompt_v,
            sample_C, sample_n, sample_m, sample_k, sample_v)
```

```cpp
#include <hip/hip_runtime.h>
#include <cstdio>
#include <cstdint>

#ifndef PH_MASK
#define PH_MASK 0xFFFF
#endif
#define PH_ON(k) (((PH_MASK) >> (k)) & 1)
#ifndef REP_MASK
#define REP_MASK 0
#endif
#define REP_N(k) ((((REP_MASK) >> (k)) & 1) ? 2 : 1)
#ifndef ML3_MASK
#define ML3_MASK 0x2
#endif
#ifndef MK_SINGLE_LAUNCH
#define MK_SINGLE_LAUNCH 1
#endif

#define DI __device__ __forceinline__
#define LAS __attribute__((address_space(3)))
#define GAS __attribute__((address_space(1)))

typedef unsigned short bf16_t;
typedef short bf16x8 __attribute__((ext_vector_type(8)));
typedef short v4i16 __attribute__((ext_vector_type(4)));
typedef float f32x2 __attribute__((ext_vector_type(2)));
typedef float f32x4 __attribute__((ext_vector_type(4)));
typedef float f32x16 __attribute__((ext_vector_type(16)));
typedef unsigned u32x2 __attribute__((ext_vector_type(2)));
typedef unsigned u32x4 __attribute__((ext_vector_type(4)));
typedef __bf16 bf16x2_t __attribute__((ext_vector_type(2)));

constexpr int D = 1024, MP = 32768, MS = 2048, M = MP + MS, NSEQ = 40;
constexpr int DFF = 2816, MIN = 3088, NPROJ = 3072;
constexpr int KSROWS = 4160;
constexpr float EPS = 1e-6f;
constexpr float LOG2E = 1.4426950408889634f;

constexpr int OFF_Y = 0, OFF_PC = 35651584, OFF_PN = 36700160, OFF_PM = 36708352, OFF_PK = 36708480, OFF_PV = 70262912,
              OFF_SC = 103817344, OFF_SN = 108011648, OFF_SM = 108044416, OFF_SK = 108044928, OFF_SV = 110142080, OUT_TOTAL = 112239232;

constexpr size_t MiB = 1u << 20;
constexpr size_t WS_CTL = 0, CTL_ZERO_BYTES = 1 * MiB;
constexpr size_t WS_MOD = 1 * MiB;
constexpr size_t WS_WIN = 5 * MiB;
constexpr size_t WS_WMO = 17 * MiB;
constexpr size_t WS_WQ = 25 * MiB;
constexpr size_t WS_WKV = 29 * MiB;
constexpr size_t WS_WGU = 33 * MiB;
constexpr size_t WS_WD = 77 * MiB;
constexpr size_t WS_GATES = 99 * MiB;
constexpr size_t WS_XM = 102 * MiB;
constexpr size_t WS_HG = 170 * MiB;
constexpr size_t WS_PROJ = 238 * MiB;
constexpr size_t WS_HID = 442 * MiB;
constexpr size_t WS_KP = 629 * MiB;
constexpr size_t WS_VP = 693 * MiB;
constexpr size_t WS_KS = 757 * MiB;
constexpr size_t WS_VS = 1017 * MiB;
constexpr size_t WS_XB = 1277 * MiB;
constexpr size_t WS_CL = 1345 * MiB;
constexpr size_t WS_CP = 1488 * MiB;
constexpr size_t WS_NL = 1616 * MiB;
constexpr size_t WS_TAB = 1618 * MiB;
constexpr size_t WS_NPREV = 1623 * MiB;
constexpr size_t WS_MPREV = 1625 * MiB;
constexpr size_t WS_END = 1626 * MiB;

constexpr int LDS_BYTES = 163840;
constexpr int MISC_OFF = 163840 - 256;
constexpr int NWAVES = 8;

DI unsigned pk2(float lo, float hi) { f32x2 v = {lo, hi}; bf16x2_t b = __builtin_convertvector(v, bf16x2_t); return __builtin_bit_cast(unsigned, b); }
DI float bf_lo(unsigned w) { return __uint_as_float(w << 16); }
DI float bf_hi(unsigned w) { return __uint_as_float(w & 0xffff0000u); }
DI u32x4 pack8f(const f32x4 a, const f32x4 b) { u32x4 r; r.x = pk2(a.x, a.y); r.y = pk2(a.z, a.w); r.z = pk2(b.x, b.y); r.w = pk2(b.z, b.w); return r; }
DI bf16x8 pack_step(const f32x16& x, int s) {
    u32x4 p; p.x = pk2(x[8 * s + 0], x[8 * s + 1]); p.y = pk2(x[8 * s + 2], x[8 * s + 3]); p.z = pk2(x[8 * s + 4], x[8 * s + 5]); p.w = pk2(x[8 * s + 6], x[8 * s + 7]);
    return __builtin_bit_cast(bf16x8, p);
}
DI int opaque_tid(int wv0) { int t; asm volatile("v_mbcnt_lo_u32_b32 %0, -1, 0\n\tv_mbcnt_hi_u32_b32 %0, -1, %0" : "=&v"(t)); t |= wv0 << 6; asm volatile("" : "+v"(t)); return t; }
DI float xor32_sum(float v) { const unsigned u = __float_as_uint(v); auto rr = __builtin_amdgcn_permlane32_swap(u, u, false, false); return __uint_as_float(rr[0]) + __uint_as_float(rr[1]); }
DI float xor32_max(float v) { const unsigned u = __float_as_uint(v); auto rr = __builtin_amdgcn_permlane32_swap(u, u, false, false); return fmaxf(__uint_as_float(rr[0]), __uint_as_float(rr[1])); }
DI float max3f(float a, float b, float c) { float r; asm("v_max3_f32 %0, %1, %2, %3" : "=v"(r) : "v"(a), "v"(b), "v"(c)); return r; }
DI int crow(int reg, int hh) { return (reg & 3) + 8 * (reg >> 2) + 4 * hh; }
DI float wave_sum(float v) {
#pragma unroll
    for (int o = 1; o < 64; o <<= 1) v += __shfl_xor(v, o);
    return v;
}
DI bf16x8 tr_pair(LAS const unsigned char* p0, LAS const unsigned char* p1) {
    v4i16 lo = __builtin_amdgcn_ds_read_tr16_b64_v4i16((LAS v4i16*)p0);
    v4i16 hi = __builtin_amdgcn_ds_read_tr16_b64_v4i16((LAS v4i16*)p1);
    return __builtin_shufflevector(lo, hi, 0, 1, 2, 3, 4, 5, 6, 7);
}
#define MFMA32(a, b, c) __builtin_amdgcn_mfma_f32_32x32x16_bf16((a), (b), (c), 0, 0, 0)
#define WG_BARRIER() do { asm volatile("s_waitcnt vmcnt(0) lgkmcnt(0)" ::: "memory"); __builtin_amdgcn_s_barrier(); asm volatile("" ::: "memory"); } while (0)
#define LDS_BARRIER() do { asm volatile("s_waitcnt lgkmcnt(0)" ::: "memory"); __builtin_amdgcn_s_barrier(); asm volatile("" ::: "memory"); } while (0)

namespace pg8 {
#define PG8_LAS __attribute__((address_space(3)))
constexpr int BM = 256, BK = 64, HALF = 128, HTB = HALF * BK * 2, STAGE_BYTES = 8 * HTB, NXCD = 8, WGM = 8;
__host__ __device__ __forceinline__ int lds_byte(int r, int c) { const int st = (r >> 4) * 2 + (c >> 5), rr = r & 15, cc = c & 31, ob = rr * 64 + cc * 2; return st * 1024 + (ob ^ (((ob >> 9) & 1) << 5)); }
__host__ __device__ __forceinline__ void stage_rc(int b, int& R, int& C) { const int st = b / 1024, sb = b % 1024, swz = sb ^ (((sb >> 9) & 1) << 5); R = (st >> 1) * 16 + swz / 64; C = (st & 1) * 32 + (swz % 64) / 2; }
__host__ __device__ __forceinline__ int perm32(int rho) { const int n = rho >> 4, i = rho & 15; return 8 * (i >> 2) + 4 * n + (i & 3); }
struct Unit { int pm, pn; };
struct Gemm { const bf16_t* A; const bf16_t* Bt; int M, N, K; };
struct StaticOrder {
    int nM, nN, nwg, G, c;
    __host__ __device__ void init(int M_, int N_, int G_, int c_) { nM = M_ / BM; nN = N_ / BM; nwg = nM * nN; G = G_; c = c_; }
    __host__ __device__ bool next(int i, Unit& u) const {
        const long L = (long)i * G + c; if (L >= nwg) return false;
        int wgid = (int)L; { const int q = nwg / NXCD, r = nwg % NXCD, xcd = wgid % NXCD, off = wgid / NXCD; wgid = (xcd < r ? xcd * (q + 1) : r * (q + 1) + (xcd - r) * q) + off; }
        const int nig = WGM * nN, gid = wgid / nig, fm = gid * WGM, gsz = (nM - fm) < WGM ? (nM - fm) : WGM;
        u.pm = fm + ((wgid % nig) % gsz); u.pn = (wgid % nig) / gsz; return true;
    }
    __device__ __forceinline__ void a_ready(const Unit&) const {}
    __device__ __forceinline__ void done(const Unit&) const {}
};

template <class Epi, class Sched, bool ALIGN_EPI = false, bool SP2 = false>
__device__ __forceinline__ void gemm_phase(PG8_LAS unsigned char* lds, const Gemm g, const Sched& S, const Epi& E, int wv0) {
    const int tid = opaque_tid(wv0), wid = __builtin_amdgcn_readfirstlane(tid >> 6), lane = tid & 63, wr = wid >> 2, wc = wid & 3, fr = lane & 15, fq = lane >> 4;
    const int K = g.K, nt = K / BK;
    unsigned voffA[2], voffB[2];
#pragma unroll
    for (int i = 0; i < 2; ++i) { int R, C; stage_rc(tid * 16 + i * 8192, R, C); const int Rb = Epi::PERM ? ((R & ~31) + perm32(R & 31)) : R;
        voffA[i] = (unsigned)(R * K + C) * 2u; voffB[i] = (unsigned)(Rb * K + C) * 2u; }
    const size_t kstep = (size_t)(BK * 2);
    const size_t hstep = (size_t)HALF * K * 2;
    const size_t tstep = 2 * hstep;
    const unsigned ldsw = (unsigned)wid * 1024u;
    const int aoff = lds_byte(wr * 64 + fr, fq * 8), boff = lds_byte(wc * 32 + fr, fq * 8);
#define PG8_SA(b, h) (((b) * 2 + (h)) * HTB)
#define PG8_SB(b, h) ((4 + (b) * 2 + (h)) * HTB)
#define PG8_STAGE(bufoff, gbase, voff) do { _Pragma("unroll") for (int _i = 0; _i < 2; ++_i) \
        __builtin_amdgcn_global_load_lds((const unsigned*)((const char*)(gbase) + (voff)[_i]), (PG8_LAS unsigned*)(lds + (bufoff) + ldsw + _i * 8192), 16, 0, 0); } while (0)
#define PG8_LDA(dst, b, h) do { _Pragma("unroll") for (int m = 0; m < 4; ++m) _Pragma("unroll") for (int k = 0; k < 2; ++k) dst[m][k] = *(const PG8_LAS bf16x8*)(lds + PG8_SA(b, h) + aoff + m * 2048 + k * 1024); } while (0)
#define PG8_LDB(dst, b, h) do { _Pragma("unroll") for (int n = 0; n < 2; ++n) _Pragma("unroll") for (int k = 0; k < 2; ++k) dst[n][k] = *(const PG8_LAS bf16x8*)(lds + PG8_SB(b, h) + boff + n * 2048 + k * 1024); } while (0)
#define PG8_MMA(ai, bj, At, Bt) do { __builtin_amdgcn_s_setprio(1); _Pragma("unroll") for (int m = 0; m < 4; ++m) _Pragma("unroll") for (int n = 0; n < 2; ++n) _Pragma("unroll") for (int k = 0; k < 2; ++k) \
        acc[ai][bj][m][n] = __builtin_amdgcn_mfma_f32_16x16x32_bf16(Bt[n][k], At[m][k], acc[ai][bj][m][n], 0, 0, 0); __builtin_amdgcn_s_setprio(0); } while (0)
#define PG8_WAIT_V(n) asm volatile("s_waitcnt vmcnt(" #n ")" ::: "memory")
#define PG8_WAIT_L(n) asm volatile("s_waitcnt lgkmcnt(" #n ")" ::: "memory")
#define PG8_BAR __builtin_amdgcn_s_barrier()
#define PG8_SCHED __builtin_amdgcn_sched_barrier(0)
    Unit cur, nxt; int ui = 0;
    if (!S.next(0, cur)) return;
    f32x4 acc[2][2][4][2];
#pragma unroll
    for (int a = 0; a < 2; ++a)
#pragma unroll
        for (int b = 0; b < 2; ++b)
#pragma unroll
            for (int m = 0; m < 4; ++m)
#pragma unroll
                for (int n = 0; n < 2; ++n) acc[a][b][m][n] = (f32x4){0.f, 0.f, 0.f, 0.f};
    bf16x8 At[4][2], B0[2][2], B1[2][2];
    const char* cA = (const char*)g.A + (size_t)cur.pm * tstep; const char* cB = (const char*)g.Bt + (size_t)cur.pn * tstep;
    S.a_ready(cur);
    if constexpr (SP2) {
        PG8_STAGE(PG8_SB(0, 0), cB, voffB); PG8_STAGE(PG8_SB(0, 1), cB + hstep, voffB); PG8_STAGE(PG8_SA(0, 0), cA, voffA); PG8_STAGE(PG8_SA(0, 1), cA + hstep, voffA);
        if (wr == 1) PG8_BAR;
        PG8_WAIT_V(2); PG8_BAR;
        PG8_STAGE(PG8_SB(1, 0), cB + kstep, voffB); PG8_STAGE(PG8_SA(1, 0), cA + kstep, voffA); PG8_STAGE(PG8_SB(1, 1), cB + hstep + kstep, voffB);
        PG8_WAIT_V(6); PG8_BAR;
    } else {
        PG8_STAGE(PG8_SB(0, 0), cB, voffB); PG8_STAGE(PG8_SA(0, 0), cA, voffA); PG8_STAGE(PG8_SB(0, 1), cB + hstep, voffB); PG8_STAGE(PG8_SA(0, 1), cA + hstep, voffA);
        if (wr == 1) PG8_BAR;
        PG8_WAIT_V(4); PG8_BAR;
        PG8_STAGE(PG8_SB(1, 0), cB + kstep, voffB); PG8_STAGE(PG8_SA(1, 0), cA + kstep, voffA); PG8_STAGE(PG8_SB(1, 1), cB + hstep + kstep, voffB);
        PG8_WAIT_V(6); PG8_BAR;
    }
    for (;;) {
        const bool has_next = S.next(ui + 1, nxt);
        const char* nA = has_next ? (const char*)g.A + (size_t)nxt.pm * tstep : cA; const char* nB = has_next ? (const char*)g.Bt + (size_t)nxt.pn * tstep : cB;
        for (int t = 0; t < nt; t += 2) {
            const bool last = (t == nt - 2);
            const char* a1 = cA + (size_t)(t + 1) * kstep;
            const char* a2 = last ? nA : cA + (size_t)(t + 2) * kstep; const char* b2 = last ? nB : cB + (size_t)(t + 2) * kstep;
            const char* a3 = a2 + kstep; const char* b3 = b2 + kstep;
            if (last && has_next) S.a_ready(nxt);
            if constexpr (SP2) {
            PG8_LDB(B0, 0, 0); PG8_LDB(B1, 0, 1); PG8_SCHED; PG8_LDA(At, 0, 0); PG8_STAGE(PG8_SA(1, 1), a1 + hstep, voffA);
            PG8_WAIT_V(8); PG8_WAIT_L(0); PG8_BAR; PG8_MMA(0, 0, At, B0); PG8_MMA(0, 1, At, B1); PG8_BAR; PG8_SCHED;
            PG8_LDA(At, 0, 1); PG8_STAGE(PG8_SB(0, 0), b2, voffB); PG8_STAGE(PG8_SB(0, 1), b2 + hstep, voffB); PG8_STAGE(PG8_SA(0, 0), a2, voffA);
            PG8_WAIT_V(8); PG8_WAIT_L(0); PG8_BAR; PG8_MMA(1, 0, At, B0); PG8_MMA(1, 1, At, B1); PG8_BAR; PG8_SCHED;
            PG8_LDB(B0, 1, 0); PG8_LDB(B1, 1, 1); PG8_SCHED; PG8_LDA(At, 1, 0); PG8_STAGE(PG8_SA(0, 1), a2 + hstep, voffA);
            PG8_WAIT_V(8); PG8_WAIT_L(0); PG8_BAR; PG8_MMA(0, 0, At, B0); PG8_MMA(0, 1, At, B1); PG8_BAR; PG8_SCHED;
            PG8_LDA(At, 1, 1); PG8_STAGE(PG8_SB(1, 0), b3, voffB); PG8_STAGE(PG8_SB(1, 1), b3 + hstep, voffB); PG8_STAGE(PG8_SA(1, 0), a3, voffA);
            PG8_WAIT_V(8); PG8_WAIT_L(0); PG8_BAR; PG8_MMA(1, 0, At, B0); PG8_MMA(1, 1, At, B1); PG8_BAR; PG8_SCHED;
            } else {
            PG8_LDB(B0, 0, 0); PG8_SCHED; PG8_LDA(At, 0, 0); PG8_STAGE(PG8_SA(1, 1), a1 + hstep, voffA);
            PG8_WAIT_L(8); PG8_BAR; PG8_WAIT_L(0); PG8_MMA(0, 0, At, B0); PG8_BAR; PG8_SCHED;
            PG8_LDB(B1, 0, 1); PG8_STAGE(PG8_SB(0, 0), b2, voffB);
            PG8_BAR; PG8_WAIT_L(0); PG8_MMA(0, 1, At, B1); PG8_BAR;
            PG8_LDA(At, 0, 1); PG8_STAGE(PG8_SA(0, 0), a2, voffA);
            PG8_BAR; PG8_WAIT_L(0); PG8_MMA(1, 0, At, B0); PG8_BAR; PG8_SCHED;
            PG8_STAGE(PG8_SB(0, 1), b2 + hstep, voffB);
            PG8_WAIT_V(6); PG8_BAR; PG8_MMA(1, 1, At, B1); PG8_BAR;
            PG8_LDB(B0, 1, 0); PG8_SCHED; PG8_LDA(At, 1, 0); PG8_STAGE(PG8_SA(0, 1), a2 + hstep, voffA);
            PG8_WAIT_L(8); PG8_BAR; PG8_WAIT_L(0); PG8_MMA(0, 0, At, B0); PG8_BAR; PG8_SCHED;
            PG8_LDB(B1, 1, 1); PG8_STAGE(PG8_SB(1, 0), b3, voffB);
            PG8_BAR; PG8_WAIT_L(0); PG8_MMA(0, 1, At, B1); PG8_BAR;
            PG8_LDA(At, 1, 1); PG8_STAGE(PG8_SA(1, 0), a3, voffA);
            PG8_BAR; PG8_WAIT_L(0); PG8_MMA(1, 0, At, B0); PG8_BAR; PG8_SCHED;
            PG8_STAGE(PG8_SB(1, 1), b3 + hstep, voffB);
            PG8_WAIT_V(6); PG8_BAR; PG8_MMA(1, 1, At, B1); PG8_BAR;
            }
        }
        if constexpr (ALIGN_EPI) { if (wr == 0) PG8_BAR; }
        E(acc, cur, wr, wc, fr, fq); S.done(cur);
        if (!has_next) break;
#pragma unroll
        for (int a = 0; a < 2; ++a)
#pragma unroll
            for (int b = 0; b < 2; ++b)
#pragma unroll
                for (int m = 0; m < 4; ++m)
#pragma unroll
                    for (int n = 0; n < 2; ++n) acc[a][b][m][n] = (f32x4){0.f, 0.f, 0.f, 0.f};
        cur = nxt; cA = nA; cB = nB; ++ui;
        if constexpr (ALIGN_EPI) { if (wr == 1) PG8_BAR; }
    }
    PG8_WAIT_V(0);
    if constexpr (!ALIGN_EPI) { if (wr == 0) PG8_BAR; }
    PG8_BAR;
#undef PG8_SA
#undef PG8_SB
#undef PG8_STAGE
#undef PG8_LDA
#undef PG8_LDB
#undef PG8_MMA
#undef PG8_WAIT_V
#undef PG8_WAIT_L
#undef PG8_BAR
#undef PG8_SCHED
}
}

typedef const f32x4 (&AccRef)[2][2][4][2];

struct EpiProj {
    static constexpr bool PERM = true, AFTER_DRAIN = false;
    bf16_t* O;
    DI void operator()(AccRef acc, const pg8::Unit& u, int wr, int wc, int fr, int fq) const {
        const int row0 = u.pm * 256 + wr * 64 + fr, colt = u.pn * 256, col0 = colt + wc * 32 + 8 * fq;
        const float sc = (colt >= 512 && colt < 1024) ? 0.125f : 1.0f;
#pragma unroll
        for (int ai = 0; ai < 2; ++ai)
#pragma unroll
            for (int m = 0; m < 4; ++m) { bf16_t* rowp = O + (size_t)(row0 + ai * 128 + m * 16) * NPROJ + col0;
#pragma unroll
                for (int bj = 0; bj < 2; ++bj) { *(u32x4*)(rowp + bj * 128) = pack8f(acc[ai][bj][m][0] * sc, acc[ai][bj][m][1] * sc); } }
    }
};
struct EpiSwiglu {
    static constexpr bool PERM = true, AFTER_DRAIN = false;
    bf16_t* H;
    DI void operator()(AccRef acc, const pg8::Unit& u, int wr, int wc, int fr, int fq) const {
        const int row0 = u.pm * 256 + wr * 64 + fr, col0 = u.pn * 128 + wc * 32 + 8 * fq;
#pragma unroll
        for (int ai = 0; ai < 2; ++ai)
#pragma unroll
            for (int m = 0; m < 4; ++m) {
                f32x4 h[2];
#pragma unroll
                for (int n = 0; n < 2; ++n) {
                    const f32x4 g = acc[ai][0][m][n], up = acc[ai][1][m][n];
#pragma unroll
                    for (int e = 0; e < 4; ++e) {
                        const float r = __builtin_amdgcn_rcpf(1.0f + __builtin_amdgcn_exp2f(g[e]));
                        h[n][e] = (g[e] * up[e]) * r; }
                }
                *(u32x4*)(H + (size_t)(row0 + ai * 128 + m * 16) * DFF + col0) = pack8f(h[0], h[1]);
            }
    }
};
DI f32x4 ld4(const void* base, size_t e, int bf) {
    if (bf) { const u32x2 w = *(const u32x2*)((const bf16_t*)base + e); return (f32x4){bf_lo(w.x), bf_hi(w.x), bf_lo(w.y), bf_hi(w.y)}; }
    return *(const f32x4*)((const float*)base + e);
}
DI void st4(void* base, size_t e, int bf, const f32x4 v) {
    if (bf) { u32x2 w; w.x = pk2(v[0], v[1]); w.y = pk2(v[2], v[3]); *(u32x2*)((bf16_t*)base + e) = w; }
    else *(f32x4*)((float*)base + e) = v;
}
struct EpiRes {
    static constexpr bool PERM = true, AFTER_DRAIN = false;
    const void* resP; const void* resS; void* out; const float* gate; int res_bf, out_bf;
    DI void operator()(AccRef acc, const pg8::Unit& u, int wr, int wc, int fr, int fq) const {
        const int col0 = u.pn * 256 + wc * 32 + 8 * fq;
#pragma unroll
        for (int ai = 0; ai < 2; ++ai) {
            const int rowb = u.pm * 256 + ai * 128 + wr * 64;
            const int seq = rowb < MP ? (rowb >> 12) : 8 + ((rowb - MP) >> 6);
            const float* gp = gate + (size_t)seq * 6144 + col0;
            const void* rb = rowb < MP ? resP : resS;
            const size_t re = (size_t)((rowb < MP ? rowb : rowb - MP) + fr) * D + col0, oe = (size_t)(rowb + fr) * D + col0;
            f32x4 gv[2][2];
#pragma unroll
            for (int bj = 0; bj < 2; ++bj)
#pragma unroll
                for (int n = 0; n < 2; ++n) gv[bj][n] = *(const f32x4*)(gp + bj * 128 + n * 4);
#pragma unroll
            for (int m = 0; m < 4; ++m) {
#pragma unroll
                for (int bj = 0; bj < 2; ++bj) {
                    const size_t e1 = re + m * 16 * D + bj * 128, e2 = oe + m * 16 * D + bj * 128;
                    f32x4 r0, r1;
                    if (res_bf) { const u32x4 w = *(const u32x4*)((const bf16_t*)rb + e1);
                        r0 = (f32x4){bf_lo(w.x), bf_hi(w.x), bf_lo(w.y), bf_hi(w.y)}; r1 = (f32x4){bf_lo(w.z), bf_hi(w.z), bf_lo(w.w), bf_hi(w.w)}; }
                    else { r0 = *(const f32x4*)((const float*)rb + e1); r1 = *(const f32x4*)((const float*)rb + e1 + 4); }
                    const f32x4 v0 = r0 + gv[bj][0] * acc[ai][bj][m][0], v1 = r1 + gv[bj][1] * acc[ai][bj][m][1];
                    if (out_bf) *(u32x4*)((bf16_t*)out + e2) = pack8f(v0, v1);
                    else { __builtin_nontemporal_store(v0, (f32x4*)((float*)out + e2)); __builtin_nontemporal_store(v1, (f32x4*)((float*)out + e2 + 4)); }
                }
                asm volatile("" ::: "memory");
            }
        }
    }
};
struct EpiQ {
    static constexpr bool PERM = true, AFTER_DRAIN = false;
    bf16_t* Q; const float* qg; float scale;
    DI void operator()(AccRef acc, const pg8::Unit& u, int wr, int wc, int fr, int fq) const {
        const int row0 = u.pm * 256 + wr * 64 + fr, colg = u.pn * 256 + wc * 64;
        f32x4 g4[2][2];
#pragma unroll
        for (int bj = 0; bj < 2; ++bj)
#pragma unroll
            for (int n = 0; n < 2; ++n) g4[bj][n] = *(const f32x4*)(qg + 32 * bj + 8 * fq + 4 * n);
#pragma unroll
        for (int ai = 0; ai < 2; ++ai)
#pragma unroll
            for (int m = 0; m < 4; ++m) {
                float ss = 0.f;
#pragma unroll
                for (int bj = 0; bj < 2; ++bj)
#pragma unroll
                    for (int n = 0; n < 2; ++n) { const f32x4 v = acc[ai][bj][m][n]; ss += (v[0] * v[0] + v[1] * v[1]) + (v[2] * v[2] + v[3] * v[3]); }
                ss += __shfl_xor(ss, 16); ss = xor32_sum(ss);
                const float rs = __builtin_amdgcn_rsqf(ss * (1.0f / 64.0f) + EPS) * scale;
                bf16_t* rowp = Q + (size_t)(row0 + ai * 128 + m * 16) * D + colg + 8 * fq;
#pragma unroll
                for (int bj = 0; bj < 2; ++bj) *(u32x4*)(rowp + 32 * bj) = pack8f(acc[ai][bj][m][0] * rs * g4[bj][0], acc[ai][bj][m][1] * rs * g4[bj][1]);
            }
    }
};
struct EpiKV {
    static constexpr bool PERM = true, AFTER_DRAIN = false;
    float* out; unsigned char* ws; const float* kg;
    DI void operator()(AccRef acc, const pg8::Unit& u, int wr, int wc, int fr, int fq) const {
        const bool isk = u.pn < 4;
        const int colb = isk ? (u.pn * 256 + wc * 64 + 8 * fq) : ((u.pn - 4) * 256 + wc * 32 + 8 * fq);
        const int cstep = isk ? 32 : 128;
        f32x4 g4[2][2];
#pragma unroll
        for (int bj = 0; bj < 2; ++bj)
#pragma unroll
            for (int n = 0; n < 2; ++n) g4[bj][n] = isk ? *(const f32x4*)(kg + 32 * bj + 8 * fq + 4 * n) : (f32x4){1.f, 1.f, 1.f, 1.f};
#pragma unroll
        for (int ai = 0; ai < 2; ++ai) {
            const int rowb = u.pm * 256 + ai * 128 + wr * 64;
            float* op; bf16_t* bp;
            if (rowb < MP) { const size_t oo = isk ? (size_t)OFF_PK : (size_t)OFF_PV, bo = isk ? WS_KP : WS_VP;
                op = out + oo + (size_t)(rowb + fr) * D + colb; bp = (bf16_t*)(ws + bo) + (size_t)(rowb + fr) * D + colb; }
            else { const int r2 = rowb - MP; const size_t oo = isk ? (size_t)OFF_SK : (size_t)OFF_SV, bo = isk ? WS_KS : WS_VS;
                op = out + oo + (size_t)(r2 + fr) * D + colb; bp = (bf16_t*)(ws + bo) + ((size_t)(r2 >> 6) * KSROWS + 4096 + fr) * D + colb; }
#pragma unroll
            for (int m = 0; m < 4; ++m) {
                float rs = 1.0f;
                if (isk) {
                    float ss = 0.f;
#pragma unroll
                    for (int bj = 0; bj < 2; ++bj)
#pragma unroll
                        for (int n = 0; n < 2; ++n) { const f32x4 v = acc[ai][bj][m][n]; ss += (v[0] * v[0] + v[1] * v[1]) + (v[2] * v[2] + v[3] * v[3]); }
                    ss += __shfl_xor(ss, 16); ss = xor32_sum(ss);
                    rs = __builtin_amdgcn_rsqf(ss * (1.0f / 64.0f) + EPS);
                }
#pragma unroll
                for (int bj = 0; bj < 2; ++bj) {
                    const f32x4 v0 = acc[ai][bj][m][0] * rs * g4[bj][0], v1 = acc[ai][bj][m][1] * rs * g4[bj][1];
                    float* o2 = op + m * 16 * D + bj * cstep; bf16_t* b2 = bp + m * 16 * D + bj * cstep;
                    __builtin_nontemporal_store(v0, (f32x4*)(o2)); __builtin_nontemporal_store(v1, (f32x4*)(o2 + 4));
                    *(u32x4*)(b2) = pack8f(v0, v1);
                }
                asm volatile("" ::: "memory");
            }
        }
    }
};

constexpr int GS_A = 0, GS_B = 17408, GS_BUF = 52224;
template <class Epi, bool BMAP1 = false>
DI void gemm_small(LAS unsigned char* lds, const bf16_t* A, const bf16_t* Bt, int nM, int nN, int K, const Epi& E, int vcu, int G, int tid, int wave, int lane) {
    const int wr = wave >> 2, wc = wave & 3, r = lane & 31, hh = lane >> 5;
    const int srow = tid >> 4, scc = tid & 15, nkt = K >> 7;
    struct Stage { u32x4 a0, a1, b0, b1, b2, b3; };
#pragma unroll 1
    for (int u = vcu; u < nM * nN; u += G) {
        const int pm = u / nN, pn = u % nN;
        const bf16_t* ga = A + (size_t)(pm * 64 + srow) * K + scc * 8;
        const bf16_t* gb = Bt + (size_t)((BMAP1 ? 256 * (pn >> 1) + 32 * ((2 * pn) & 3) : pn * 128) + srow) * K + scc * 8;
        constexpr int BR1 = BMAP1 ? 128 : 32, BR2 = BMAP1 ? 32 : 64, BR3 = BMAP1 ? 160 : 96;
        auto load = [&](Stage& st, int kt) {
            const bf16_t* pa = ga + kt * 128; const bf16_t* pb = gb + kt * 128;
            st.a0 = *(const u32x4*)pa; st.a1 = *(const u32x4*)(pa + (size_t)32 * K);
            st.b0 = *(const u32x4*)pb; st.b1 = *(const u32x4*)(pb + (size_t)BR1 * K); st.b2 = *(const u32x4*)(pb + (size_t)BR2 * K); st.b3 = *(const u32x4*)(pb + (size_t)BR3 * K);
        };
        auto store = [&](const Stage& st, LAS unsigned char* buf) {
            LAS unsigned char* pa = buf + GS_A + srow * 272 + scc * 16; LAS unsigned char* pb = buf + GS_B + srow * 272 + scc * 16;
            *(LAS u32x4*)pa = st.a0; *(LAS u32x4*)(pa + 32 * 272) = st.a1;
            *(LAS u32x4*)pb = st.b0; *(LAS u32x4*)(pb + 32 * 272) = st.b1; *(LAS u32x4*)(pb + 64 * 272) = st.b2; *(LAS u32x4*)(pb + 96 * 272) = st.b3;
        };
        f32x16 acc = f32x16{};
        auto compute = [&](const LAS unsigned char* buf) {
            const LAS unsigned char* pa = buf + GS_A + (32 * wr + r) * 272 + hh * 16; const LAS unsigned char* pb = buf + GS_B + (32 * wc + r) * 272 + hh * 16;
#pragma unroll
            for (int kh = 0; kh < 2; ++kh) {
                bf16x8 af[4], bfr[4];
#pragma unroll
                for (int ks = 0; ks < 4; ++ks) { af[ks] = *(const LAS bf16x8*)(pa + (4 * kh + ks) * 32); bfr[ks] = *(const LAS bf16x8*)(pb + (4 * kh + ks) * 32); }
#pragma unroll
                for (int ks = 0; ks < 4; ++ks) acc = MFMA32(af[ks], bfr[ks], acc);
            }
        };
        Stage s0, s1, s2, s3;
        load(s0, 0); load(s1, 1); if (2 < nkt) load(s2, 2); if (3 < nkt) load(s3, 3);
#pragma unroll 1
        for (int kt = 0; kt < nkt; kt += 4) {
            store(s0, lds); LDS_BARRIER(); if (kt + 4 < nkt) load(s0, kt + 4); compute(lds);
            if (kt + 1 < nkt) { store(s1, lds + GS_BUF); LDS_BARRIER(); if (kt + 5 < nkt) load(s1, kt + 5); compute(lds + GS_BUF); }
            if (kt + 2 < nkt) { store(s2, lds); LDS_BARRIER(); if (kt + 6 < nkt) load(s2, kt + 6); compute(lds); }
            if (kt + 3 < nkt) { store(s3, lds + GS_BUF); LDS_BARRIER(); if (kt + 7 < nkt) load(s3, kt + 7); compute(lds + GS_BUF); }
        }
        E(acc, pm, pn, wr, wc, r, hh);
        LDS_BARRIER();
    }
}
struct EpiResSmall {
    const void* res; void* out; const float* gate; int res_bf, out_bf;
    DI void operator()(const f32x16& acc, int pm, int pn, int wr, int wc, int r, int hh) const {
        const int col = pn * 128 + wc * 32 + r;
        const float g = gate[(size_t)(8 + pm) * 6144 + col];
        const size_t base = (size_t)(pm * 64 + 32 * wr + 4 * hh) * D + col;
#pragma unroll
        for (int i = 0; i < 16; ++i) { const size_t o = base + (size_t)((i & 3) + 8 * (i >> 2)) * D;
            const float rv = res_bf ? __uint_as_float((unsigned)((const bf16_t*)res)[o] << 16) : ((const float*)res)[o];
            const float v = rv + g * acc[i];
            if (out_bf) ((bf16_t*)out)[o] = (bf16_t)(pk2(v, 0.f) & 0xffffu); else ((float*)out)[o] = v; }
    }
};

struct EpiQSmall {
    bf16_t* Q; const float* qg; float scale; LAS float* X;
    DI void operator()(const f32x16& acc, int pm, int pn, int wr, int wc, int r, int hh) const {
        float ss[16];
#pragma unroll
        for (int i = 0; i < 16; ++i) { float v = acc[i] * acc[i];
#pragma unroll
            for (int o = 1; o < 32; o <<= 1) v += __shfl_xor(v, o);
            ss[i] = v; }
        const int w = wr * 4 + wc;
        if (r == 0) {
#pragma unroll
            for (int i = 0; i < 16; ++i) X[(w * 2 + hh) * 16 + i] = ss[i];
        }
        LDS_BARRIER();
        const int col = pn * 128 + wc * 32 + r;
        const float g = qg[(wc & 1) * 32 + r] * scale;
        bf16_t* qp = Q + (size_t)(pm * 64 + 32 * wr + 4 * hh) * D + col;
#pragma unroll
        for (int i = 0; i < 16; ++i) {
            const float tot = ss[i] + X[((w ^ 1) * 2 + hh) * 16 + i];
            const float rs = __builtin_amdgcn_rsqf(tot * (1.0f / 64.0f) + EPS);
            qp[(size_t)((i & 3) + 8 * (i >> 2)) * D] = (bf16_t)(pk2(acc[i] * rs * g, 0.f) & 0xffffu);
        }
    }
};

template <bool NORM>
struct EpiKVSmall {
    float* out; bf16_t* bc; const float* kg; LAS float* X;
    DI void operator()(const f32x16& acc, int pm, int pn, int wr, int wc, int r, int hh) const {
        const int col = pn * 128 + wc * 32 + r;
        float* op = out + (size_t)(pm * 64 + 32 * wr + 4 * hh) * D + col;
        bf16_t* bp = bc + ((size_t)pm * KSROWS + 4096 + 32 * wr + 4 * hh) * D + col;
        if constexpr (NORM) {
            float ss[16];
#pragma unroll
            for (int i = 0; i < 16; ++i) { float v = acc[i] * acc[i];
#pragma unroll
                for (int o = 1; o < 32; o <<= 1) v += __shfl_xor(v, o);
                ss[i] = v; }
            const int w = wr * 4 + wc;
            if (r == 0) {
#pragma unroll
                for (int i = 0; i < 16; ++i) X[(w * 2 + hh) * 16 + i] = ss[i];
            }
            LDS_BARRIER();
            const float g = kg[(wc & 1) * 32 + r];
#pragma unroll
            for (int i = 0; i < 16; ++i) {
                const float tot = ss[i] + X[((w ^ 1) * 2 + hh) * 16 + i];
                const float v = acc[i] * __builtin_amdgcn_rsqf(tot * (1.0f / 64.0f) + EPS) * g;
                const size_t o = (size_t)((i & 3) + 8 * (i >> 2)) * D;
                op[o] = v; bp[o] = (bf16_t)(pk2(v, 0.f) & 0xffffu);
            }
        } else {
#pragma unroll
            for (int i = 0; i < 16; ++i) { const size_t o = (size_t)((i & 3) + 8 * (i >> 2)) * D; op[o] = acc[i]; bp[o] = (bf16_t)(pk2(acc[i], 0.f) & 0xffffu); }
        }
    }
};

#define XB_TMO      128
#define XB_XCNT(j)  (256  + 64 * (j))
#define XB_XSUB(j)  (1280 + 64 * (j))
#define XB_XGEN(j)  (2304 + 64 * (j))
#define XB_TOP      3328
#define XB_TOPGEN   3392
#define XCD_BAR_WORDS 3456
#define XB_SPIN_CAP (1u << 22)
DI unsigned xb_ld(unsigned* p)              { return __hip_atomic_load(p, __ATOMIC_RELAXED, __HIP_MEMORY_SCOPE_AGENT); }
DI unsigned xb_add(unsigned* p, unsigned v) { return __hip_atomic_fetch_add(p, v, __ATOMIC_RELAXED, __HIP_MEMORY_SCOPE_AGENT); }
DI unsigned xb_xcc_id() { return (unsigned)__builtin_amdgcn_s_getreg((3 << 11) | 20) & 0xFu; }
#define XB_SPIN(cond, bar) do { unsigned _sp = 0; while (cond) { __builtin_amdgcn_s_sleep(1); \
    if ((++_sp & 255u) == 0u) { if (xb_ld(&(bar)[XB_TMO])) break; if (_sp > XB_SPIN_CAP) { atomicAdd(&(bar)[XB_TMO], 1u); break; } } } } while (0)
struct XcdBarrier { unsigned* bar; unsigned x; int w0; volatile LAS unsigned* st; };
DI bool xb_thread0(int w0) { return w0 == 0 && __builtin_amdgcn_mbcnt_hi(~0u, __builtin_amdgcn_mbcnt_lo(~0u, 0u)) == 0u; }
DI XcdBarrier xcd_barrier_post(unsigned* bar, int w0, volatile LAS unsigned* st) {
    XcdBarrier b; b.bar = bar; b.x = xb_xcc_id(); b.w0 = w0; b.st = st;
    if (xb_thread0(w0)) (void)xb_add(&bar[XB_XCNT(b.x)], 1u);
    return b;
}
DI void xcd_barrier_complete(unsigned* bar, unsigned x, unsigned& nloc, unsigned& nx) {
    const unsigned G = gridDim.x * gridDim.y * gridDim.z;
    unsigned sum, cnt, mine, sp = 0u;
    for (;;) {
        sum = 0u; cnt = 0u; mine = 0u;
#pragma unroll
        for (unsigned j = 0; j < 16; ++j) { const unsigned c = xb_ld(&bar[XB_XCNT(j)]); sum += c; cnt += (c > 0u) ? 1u : 0u; mine = (j == x) ? c : mine; }
        if (sum == G) break;
        __builtin_amdgcn_s_sleep(1);
        if ((++sp & 255u) == 0u) { if (xb_ld(&bar[XB_TMO])) break; if (sp > XB_SPIN_CAP) { atomicAdd(&bar[XB_TMO], 1u); break; } }
    }
    nloc = mine > 0u ? mine : 1u; nx = cnt > 0u ? cnt : 1u;
}
DI void xcd_barrier(const XcdBarrier& b) {
    asm volatile("s_waitcnt vmcnt(0)" ::: "memory");
    __syncthreads();
    if (xb_thread0(b.w0)) {
        unsigned* bar = b.bar;
        __builtin_amdgcn_s_waitcnt(0);
        unsigned nloc = b.st[0], nx = b.st[1];
        if (nloc == 0u) { xcd_barrier_complete(bar, b.x, nloc, nx); b.st[0] = nloc; b.st[1] = nx; }
        const unsigned old = xb_add(&bar[XB_XSUB(b.x)], 1u);
        const unsigned gen = old / nloc;
        if (old + 1u == (gen + 1u) * nloc) {
            __builtin_amdgcn_fence(__ATOMIC_RELEASE, "agent");
            asm volatile("s_waitcnt vmcnt(0)" ::: "memory");
            const unsigned og = xb_add(&bar[XB_TOP], 1u);
            const unsigned tg = og / nx;
            if (og + 1u == (tg + 1u) * nx) xb_add(&bar[XB_TOPGEN], 1u);
            else XB_SPIN(xb_ld(&bar[XB_TOPGEN]) == tg, bar);
            __builtin_amdgcn_fence(__ATOMIC_ACQUIRE, "agent");
            xb_add(&bar[XB_XGEN(b.x)], 1u);
            asm volatile("s_waitcnt vmcnt(0)" ::: "memory");
        } else {
            XB_SPIN(xb_ld(&bar[XB_XGEN(b.x)]) == gen, bar);
            __builtin_amdgcn_fence(__ATOMIC_ACQUIRE, "agent");
            asm volatile("s_waitcnt vmcnt(0)" ::: "memory");
        }
    }
    __syncthreads();
}

struct Args { const float* in[29]; float* out; unsigned char* ws; int ph_lo, ph_hi; };
typedef const __attribute__((address_space(4))) Args& ArgsRef;
DI ArgsRef kargs() { const __attribute__((address_space(4))) Args* p = (const __attribute__((address_space(4))) Args*)__builtin_amdgcn_kernarg_segment_ptr(); asm volatile("" : "+s"(p)); return *p; }
enum { I_XP = 0, I_XS, I_CP, I_CS, I_SC, I_SN, I_SM, I_CK, I_CV, I_ADAW, I_ADAB, I_NORMG, I_WIN, I_BG, I_MHG, I_WOUT, I_KVG, I_WK, I_WV, I_KG,
       I_WQ, I_QG, I_LAM, I_AHG, I_WO, I_RELB, I_WGATE, I_WUP, I_WDOWN };

constexpr long CACHE_CH = 2 * 16777216L, CACHE_T0 = 2097152L, CACHE_T1 = 2 * 2097152L, CACHE_T2 = CACHE_T1 + 1048576L, CACHE_T3 = CACHE_T2 + 1048576L;
DI int dst_row_map(int mode, int n) {
    if (mode == 1) return (n & ~255) | (((n >> 5) & 1) << 7) | (((n >> 6) & 3) << 5) | (n & 31);
    if (mode == 2) return 256 * (n >> 7) + (n & 127);
    if (mode == 3) return 256 * (n >> 7) + 128 + (n & 127);
    return n;
}
DI void transpose_item(const float* __restrict__ W, int ldw, int K, bf16_t* WT, int k0, int n0, int drow0, float wsc, LAS float* scr, int lane) {
    float wv[32];
#pragma unroll
    for (int i = 0; i < 32; ++i) { const int kk = 2 * i + (lane >> 5); wv[i] = __builtin_nontemporal_load(W + (size_t)(k0 + kk) * ldw + n0 + (lane & 31)); }
#pragma unroll
    for (int i = 0; i < 32; ++i) { const int kk = 2 * i + (lane >> 5); scr[kk * 33 + (lane & 31)] = wv[i]; }
    asm volatile("s_waitcnt lgkmcnt(0)" ::: "memory");
    const int c = lane & 7;
#pragma unroll
    for (int j = 0; j < 4; ++j) { const int n = (lane >> 3) + 8 * j; const LAS float* s = scr + (8 * c) * 33 + n;
        u32x4 o; o.x = pk2(s[0 * 33] * wsc, s[1 * 33] * wsc); o.y = pk2(s[2 * 33] * wsc, s[3 * 33] * wsc); o.z = pk2(s[4 * 33] * wsc, s[5 * 33] * wsc); o.w = pk2(s[6 * 33] * wsc, s[7 * 33] * wsc);
        *(u32x4*)(WT + (size_t)(drow0 + n) * K + k0 + 8 * c) = o; }
    asm volatile("s_waitcnt lgkmcnt(0)" ::: "memory");
}
DI void prologue_weights(ArgsRef a, LAS unsigned char* lds, int gw, int NGW, int wave, int lane, int sel) {
    LAS float* scr = (LAS float*)(lds + wave * 8448);
    unsigned char* ws = a.ws;
    constexpr int I_WINI = 16 * 96, I_SQ = 16 * 32, I_GU = 16 * 88, I_DN = 44 * 32;
    constexpr int NITEMS = 2 * I_WINI + 4 * I_SQ + 2 * I_SQ + 2 * I_SQ + 8 * I_GU + 4 * I_DN;
    for (int it = gw; it < NITEMS; it += NGW) {
        int r = it; const float* W; int ldw, K, nblk, mode; bf16_t* WT; int first = 0;
        if (r < 2 * I_WINI) { const int l = r / I_WINI; first = (l == 0); r -= l * I_WINI; W = a.in[I_WIN] + (size_t)l * 1024 * MIN; ldw = MIN; K = 1024; nblk = 96; mode = 0; WT = (bf16_t*)(ws + WS_WIN) + (size_t)l * NPROJ * 1024; }
        else { r -= 2 * I_WINI;
        if (r < 4 * I_SQ) { const int l = r / I_SQ; first = (l == 0); r -= l * I_SQ; W = (l < 2 ? a.in[I_WOUT] + (size_t)l * 1048576 : a.in[I_WO] + (size_t)(l - 2) * 1048576); ldw = 1024; K = 1024; nblk = 32; mode = 0; WT = (bf16_t*)(ws + WS_WMO) + (size_t)l * 1048576; }
        else { r -= 4 * I_SQ;
        if (r < 2 * I_SQ) { const int j = r / I_SQ; r -= j * I_SQ; W = a.in[I_WQ] + (size_t)j * 1048576; ldw = 1024; K = 1024; nblk = 32; mode = 1; WT = (bf16_t*)(ws + WS_WQ) + (size_t)j * 1048576; }
        else { r -= 2 * I_SQ;
        if (r < 2 * I_SQ) { const int j = r / I_SQ; r -= j * I_SQ; W = j ? a.in[I_WV] : a.in[I_WK]; ldw = 1024; K = 1024; nblk = 32; mode = j ? 0 : 1; WT = (bf16_t*)(ws + WS_WKV) + (size_t)j * 1048576; }
        else { r -= 2 * I_SQ;
        if (r < 8 * I_GU) { const int q = r / I_GU; r -= q * I_GU; const int l = q >> 1, up = q & 1; first = (l == 0); W = (up ? a.in[I_WUP] : a.in[I_WGATE]) + (size_t)l * 1024 * DFF; ldw = DFF; K = 1024; nblk = 88; mode = 2 + up; WT = (bf16_t*)(ws + WS_WGU) + (size_t)l * 5632 * 1024; }
        else { r -= 8 * I_GU; const int l = r / I_DN; first = (l == 0); r -= l * I_DN; W = a.in[I_WDOWN] + (size_t)l * DFF * 1024; ldw = 1024; K = DFF; nblk = 32; mode = 0; WT = (bf16_t*)(ws + WS_WD) + (size_t)l * 1024 * DFF; } } } } }
        if (first == sel) continue;
        const int kb = r / nblk, nb = r % nblk;
        const float wsc = mode == 2 ? -LOG2E : (mode == 3 ? -0.6931471805599453f : 1.0f);
        transpose_item(W, ldw, K, WT, 64 * kb, 32 * nb, dst_row_map(mode, 32 * nb), wsc, scr, lane);
    }
}
DI void prologue_cache(ArgsRef a, int gtid, int NT, long cbeg, long cend) {
    constexpr long NCH = 16777216L;
    const long len = cend - cbeg, step = 4L * NT;
    if (len <= 0) return;
    const int T = (int)((len + step - 1) / step);
    const int ib = (int)cbeg + gtid, ie = (int)cend, ilen = (int)len, istep = (int)step;
    auto ld = [&](f32x4 (&v)[4][2], int t) {
#pragma unroll
        for (int j = 0; j < 4; ++j) { int ci = ib + t * istep + j * NT; if (ci >= ie) ci -= ilen;
            const int which = ci >= (int)NCH; const unsigned c = (unsigned)(which ? ci - (int)NCH : ci);
            const float* src = (const float*)((const char*)(which ? a.in[I_CV] : a.in[I_CK]) + (size_t)(c * 32u));
            v[j][0] = __builtin_nontemporal_load((const f32x4*)src); v[j][1] = __builtin_nontemporal_load((const f32x4*)(src + 4)); }
    };
    auto st = [&](const f32x4 (&v)[4][2], int t) {
#pragma unroll
        for (int j = 0; j < 4; ++j) { int ci = ib + t * istep + j * NT; if (ci >= ie) ci -= ilen;
            const int which = ci >= (int)NCH; const unsigned c = (unsigned)(which ? ci - (int)NCH : ci);
            const unsigned b = c >> 19, rest = c & ((1u << 19) - 1u);
            bf16_t* dst = (bf16_t*)(a.ws + (which ? WS_VS : WS_KS) + (size_t)(b * (unsigned)(KSROWS * 2048) + rest * 16u));
            __builtin_nontemporal_store(pack8f(v[j][0], v[j][1]), (u32x4*)dst); }
    };
    f32x4 va[4][2], vb[4][2];
    int t = 0;
    ld(va, 0);
#pragma unroll 1
    while (t + 2 < T) { ld(vb, t + 1); st(va, t); ld(va, t + 2); st(vb, t + 1); t += 2; }
    if (t + 1 < T) { ld(vb, t + 1); st(va, t); st(vb, t + 1); } else st(va, t);
}
DI void prologue_adaln(ArgsRef a, LAS unsigned char* lds, int vcu, int G, int tid, int wave, int lane) {
    LAS float* sc = (LAS float*)lds;
    LAS float* red = (LAS float*)(lds + 81920);
    float* mod = (float*)(a.ws + WS_MOD);
    for (int it = vcu; it < 8 * 96; it += G) {
        const int l = it / 192, j0 = ((it % 192) >> 1) * 64;
        { const int p = it & 1;
            for (int i = tid; i < 1024; i += 512) {
#pragma unroll
                for (int s = 0; s < 20; ++s) { const int sq = 20 * p + s; const float c = sq < 8 ? a.in[I_CP][sq * 1024 + i] : a.in[I_CS][(sq - 8) * 1024 + i];
                    sc[i * 20 + s] = c / (1.0f + __expf(-c)); }
            }
            LDS_BARRIER();
            float acc[20];
#pragma unroll
            for (int s = 0; s < 20; ++s) acc[s] = 0.f;
            const float* wp = a.in[I_ADAW] + ((size_t)l * 1024 + wave * 128) * 6144 + j0 + lane;
#pragma unroll 1
            for (int i0 = 0; i0 < 128; i0 += 16) {
                float w16[16];
#pragma unroll
                for (int k = 0; k < 16; ++k) w16[k] = wp[(size_t)(i0 + k) * 6144];
#pragma unroll
                for (int k = 0; k < 16; ++k) {
                    const float w = w16[k];
                    const LAS f32x4* s4 = (const LAS f32x4*)(sc + (wave * 128 + i0 + k) * 20);
#pragma unroll
                    for (int q = 0; q < 5; ++q) { const f32x4 v = s4[q]; acc[4 * q] += v.x * w; acc[4 * q + 1] += v.y * w; acc[4 * q + 2] += v.z * w; acc[4 * q + 3] += v.w * w; }
                    if ((k & 3) == 3) asm volatile("" ::: "memory");
                }
            }
#pragma unroll
            for (int s = 0; s < 20; ++s) red[(wave * 20 + s) * 64 + lane] = acc[s];
            LDS_BARRIER();
            for (int o = tid; o < 1280; o += 512) { const int s = o >> 6, jj = o & 63; float v = a.in[I_ADAB][l * 6144 + j0 + jj];
#pragma unroll
                for (int w = 0; w < 8; ++w) v += red[(w * 20 + s) * 64 + jj];
                mod[((size_t)l * 40 + 20 * p + s) * 6144 + j0 + jj] = v; }
            LDS_BARRIER();
        }
    }
}

template <int CTRL, int ROWMASK> DI float dpp_f(float old, float src) {
    return __builtin_bit_cast(float, __builtin_amdgcn_update_dpp(__builtin_bit_cast(int, old), __builtin_bit_cast(int, src), CTRL, ROWMASK, 0xf, false));
}
DI float wave_scan_add(float v) {
    v += dpp_f<0x111, 0xf>(0.f, v); v += dpp_f<0x112, 0xf>(0.f, v); v += dpp_f<0x114, 0xf>(0.f, v); v += dpp_f<0x118, 0xf>(0.f, v);
    v += dpp_f<0x142, 0xa>(0.f, v); v += dpp_f<0x143, 0xc>(0.f, v); return v;
}
DI float wave_scan_max(float v) {
    const float ninf = -3.0e38f;
    v = fmaxf(v, dpp_f<0x111, 0xf>(ninf, v)); v = fmaxf(v, dpp_f<0x112, 0xf>(ninf, v)); v = fmaxf(v, dpp_f<0x114, 0xf>(ninf, v)); v = fmaxf(v, dpp_f<0x118, 0xf>(ninf, v));
    v = fmaxf(v, dpp_f<0x142, 0xa>(ninf, v)); v = fmaxf(v, dpp_f<0x143, 0xc>(ninf, v)); return v;
}

DI float wave_sum_u(float v) { v = wave_scan_add(v); return __builtin_bit_cast(float, __builtin_amdgcn_readlane(__builtin_bit_cast(int, v), 63)); }

DI int ncol(int lane, int q) { return 8 * lane + 512 * (q >> 1) + 4 * (q & 1); }
DI void ld8pair(const void* base, size_t e, int bf, f32x4& a0, f32x4& a1) {
    if (bf) { const u32x4 w = __builtin_nontemporal_load((const u32x4*)((const bf16_t*)base + e)); a0 = (f32x4){bf_lo(w.x), bf_hi(w.x), bf_lo(w.y), bf_hi(w.y)}; a1 = (f32x4){bf_lo(w.z), bf_hi(w.z), bf_lo(w.w), bf_hi(w.w)}; }
    else { a0 = *(const f32x4*)((const float*)base + e); a1 = *(const f32x4*)((const float*)base + e + 4); }
}
template <bool MODULATE, bool GATES>
DI void norm_phase(ArgsRef a, LAS unsigned char* lds, const void* xP, const void* xS, int in_bf, const float* g, const float* modl, int sh_off, int sc_off,
                   const float* Wg  , const float* bg, int vcu, int G, int tid, int wave, int lane) {
    bf16_t* XM = (bf16_t*)(a.ws + WS_XM);
    float* gates = (float*)(a.ws + WS_GATES);
    LAS float* wl = (LAS float*)lds;
    if (GATES) {
        for (int i = tid; i < 1024 * 16; i += 512) { const int r = i >> 4, c = i & 15; wl[c * 1024 + r] = Wg[(size_t)r * MIN + c]; }
        LDS_BARRIER();
    }
    f32x4 gv[4], shv[4], scv[4];
#pragma unroll
    for (int q = 0; q < 4; ++q) { gv[q] = *(const f32x4*)(g + ncol(lane, q)); shv[q] = (f32x4){0.f, 0.f, 0.f, 0.f}; scv[q] = shv[q]; }
    int cur_seq = -1;
    const float bgv = (GATES && lane < 16) ? bg[lane] : 0.f;
    const int NW = G * NWAVES, gw = vcu * NWAVES + wave;
    const int per = (M + NW - 1) / NW;
    const int r0 = gw * per, r1 = (r0 + per < M) ? r0 + per : M;
    f32x4 xn[4];
    auto load_row = [&](int row) {
        const void* xb = row < MP ? xP : xS; const size_t e0 = (size_t)(row < MP ? row : row - MP) * D + 8 * lane;
#pragma unroll
        for (int h2 = 0; h2 < 2; ++h2) ld8pair(xb, e0 + 512 * h2, in_bf, xn[2 * h2], xn[2 * h2 + 1]);
    };
    if (r0 < r1) load_row(r0);
    for (int row = r0; row < r1; ++row) {
        f32x4 x[4]; float ss = 0.f;
#pragma unroll
        for (int q = 0; q < 4; ++q) { x[q] = xn[q]; ss += (x[q][0] * x[q][0] + x[q][1] * x[q][1]) + (x[q][2] * x[q][2] + x[q][3] * x[q][3]); }
        if (row + 1 < r1) load_row(row + 1);
        if (MODULATE) {
            const int seq = row < MP ? (row >> 12) : 8 + ((row - MP) >> 6);
            if (seq != cur_seq) { cur_seq = seq; const float* mp = modl + (size_t)seq * 6144;
#pragma unroll
                for (int q = 0; q < 4; ++q) { shv[q] = *(const f32x4*)(mp + sh_off + ncol(lane, q)); scv[q] = *(const f32x4*)(mp + sc_off + ncol(lane, q)) + 1.0f; } }
        }
        ss = wave_sum_u(ss);
        const float rstd = __builtin_amdgcn_rsqf(ss * (1.0f / D) + EPS);
#pragma unroll
        for (int q = 0; q < 4; ++q) { x[q] = x[q] * rstd * gv[q]; if (MODULATE) x[q] = x[q] * scv[q] + shv[q]; }
        bf16_t* o = XM + (size_t)row * D + 8 * lane;
#pragma unroll
        for (int h2 = 0; h2 < 2; ++h2) *(u32x4*)(o + 512 * h2) = pack8f(x[2 * h2], x[2 * h2 + 1]);
        if (GATES) {
            float mine = 0.f;
#pragma unroll
            for (int c = 0; c < 16; ++c) {
                float acc = 0.f;
#pragma unroll
                for (int q = 0; q < 4; ++q) { const f32x4 w = *(const LAS f32x4*)(wl + c * 1024 + ncol(lane, q)); acc += (x[q][0] * w.x + x[q][1] * w.y) + (x[q][2] * w.z + x[q][3] * w.w); }
                const float t = wave_sum_u(acc); if (lane == c) mine = t;
                if (c & 1) asm volatile("" ::: "memory");
            }
            if (lane < 16) gates[(size_t)row * 16 + lane] = mine + bgv;
        }
    }
    if (GATES) LDS_BARRIER();
}

DI void norm_dual_phase(ArgsRef a, const bf16_t* XB, bf16_t* XM, bf16_t* XM2, const float* gkv, const float* g2, const float* modl2, int sh_off, int sc_off, int vcu, int G, int wave, int lane) {
    f32x4 gk[4], gv[4], shv[4], scv[4];
#pragma unroll
    for (int q = 0; q < 4; ++q) { gk[q] = *(const f32x4*)(gkv + ncol(lane, q)); gv[q] = *(const f32x4*)(g2 + ncol(lane, q)); shv[q] = (f32x4){0.f, 0.f, 0.f, 0.f}; scv[q] = shv[q]; }
    int cur_seq = -1;
    const int NW = G * NWAVES, gw = vcu * NWAVES + wave;
    const int per = (M + NW - 1) / NW;
    const int r0 = gw * per, r1 = (r0 + per < M) ? r0 + per : M;
    f32x4 xn[4];
    auto load_row = [&](int row) {
#pragma unroll
        for (int h2 = 0; h2 < 2; ++h2) ld8pair(XB, (size_t)row * D + 8 * lane + 512 * h2, 1, xn[2 * h2], xn[2 * h2 + 1]);
    };
    if (r0 < r1) load_row(r0);
    for (int row = r0; row < r1; ++row) {
        f32x4 x[4]; float ss = 0.f;
#pragma unroll
        for (int q = 0; q < 4; ++q) { x[q] = xn[q]; ss += (x[q][0] * x[q][0] + x[q][1] * x[q][1]) + (x[q][2] * x[q][2] + x[q][3] * x[q][3]); }
        if (row + 1 < r1) load_row(row + 1);
        const int seq = row < MP ? (row >> 12) : 8 + ((row - MP) >> 6);
        if (seq != cur_seq) { cur_seq = seq; const float* mp = modl2 + (size_t)seq * 6144;
#pragma unroll
            for (int q = 0; q < 4; ++q) { shv[q] = *(const f32x4*)(mp + sh_off + ncol(lane, q)); scv[q] = *(const f32x4*)(mp + sc_off + ncol(lane, q)) + 1.0f; } }
        ss = wave_sum_u(ss);
        const float rstd = __builtin_amdgcn_rsqf(ss * (1.0f / D) + EPS);
        bf16_t* o1 = XM + (size_t)row * D + 8 * lane; bf16_t* o2 = XM2 + (size_t)row * D + 8 * lane;
#pragma unroll
        for (int h2 = 0; h2 < 2; ++h2) {
            const f32x4 xa = x[2 * h2] * rstd, xb2 = x[2 * h2 + 1] * rstd;
            *(u32x4*)(o1 + 512 * h2) = pack8f(xa * gk[2 * h2], xb2 * gk[2 * h2 + 1]);
            *(u32x4*)(o2 + 512 * h2) = pack8f(xa * gv[2 * h2] * scv[2 * h2] + shv[2 * h2], xb2 * gv[2 * h2 + 1] * scv[2 * h2 + 1] + shv[2 * h2 + 1]);
        }
    }
}

constexpr int ML_Q = 0, ML_K = 9216, ML_KW = 18432, ML_V = 30720, ML_BUF = 51200;
constexpr int ML_SCR = 2 * ML_BUF;
constexpr int ML_RED = ML_SCR + 8 * 2048;
constexpr int ML_NP = ML_RED + 1024;
DI float logsigmoidf(float x) { return fminf(x, 0.f) - __logf(1.0f + __expf(-fabsf(x))); }
DI void mlstm_unit(ArgsRef a, LAS unsigned char* lds, int l, int seq, int h, int tid, int wave, int lane) {
    const bool isP = seq < 8; const int NC = isP ? 64 : 1;
    const int rowbase0 = isP ? seq * 4096 : MP + (seq - 8) * 64;
    const bf16_t* PROJ = (const bf16_t*)(a.ws + WS_PROJ);
    const float* GT = (const float*)(a.ws + WS_GATES);
    bf16_t* HG = (bf16_t*)(a.ws + WS_HG);
    const int dvs = wave & 3, th = wave >> 2;
    LAS float* scr = (LAS float*)(lds + ML_SCR + wave * 2048);
    LAS float* red = (LAS float*)(lds + ML_RED);
    LAS float* npart = (LAS float*)(lds + ML_NP);
    f32x16 Cst[2]; float nst, mprev;
    const int sidx = isP ? 0 : ((l * 32 + (seq - 8)) * 8 + h);
    if (isP) { Cst[0] = f32x16{}; Cst[1] = f32x16{}; nst = 0.f; mprev = 0.f; }
    else {
        const float* Cin = a.in[I_SC] + (size_t)sidx * 8192 + 32 * dvs + (lane & 31) + (lane >> 5) * 512;
#pragma unroll
        for (int kb = 0; kb < 2; ++kb)
#pragma unroll
            for (int i = 0; i < 16; ++i) Cst[kb][i] = Cin[(32 * kb + crow(i, 0)) * 128];
        nst = a.in[I_SN][(size_t)sidx * 64 + lane]; mprev = a.in[I_SM][sidx];
    }
    scr[448 + lane] = nst;
    const int srow = tid >> 3, scc = tid & 7;
    u32x4 pq, pk, pv0, pv1; u32x2 ogn[4]; float pig, pfg;
    auto issue_loads = [&](int c) {
        const size_t rb = (size_t)(rowbase0 + c * 64);
        const bf16_t* pr = PROJ + (rb + srow) * NPROJ;
        pq = *(const u32x4*)(pr + h * 64 + scc * 8);
        pk = *(const u32x4*)(pr + 512 + h * 64 + scc * 8);
        { const int idx = tid; const int vr = idx >> 4, vc = idx & 15; pv0 = *(const u32x4*)(PROJ + (rb + vr) * NPROJ + 1024 + h * 128 + vc * 8); }
        { const int idx = tid + 512; const int vr = idx >> 4, vc = idx & 15; pv1 = *(const u32x4*)(PROJ + (rb + vr) * NPROJ + 1024 + h * 128 + vc * 8); }
        pig = GT[(rb + lane) * 16 + h]; pfg = GT[(rb + lane) * 16 + 8 + h];
        const bf16_t* po = PROJ + (rb + 32 * th + (lane & 31)) * NPROJ + 2048 + h * 128 + 32 * dvs + 4 * (lane >> 5);
#pragma unroll
        for (int g = 0; g < 4; ++g) ogn[g] = *(const u32x2*)(po + 8 * g);
    };
    float bendN, A63N;
    auto gate_tables = [&](int par) {
        const float b = wave_scan_add(logsigmoidf(pfg));
        const float av = pig - b;
        const float cm = wave_scan_max(av);
        A63N = __builtin_bit_cast(float, __builtin_amdgcn_readlane(__builtin_bit_cast(int, cm), 63));
        bendN = __builtin_bit_cast(float, __builtin_amdgcn_readlane(__builtin_bit_cast(int, b), 63));
        scr[par * 64 + lane] = av; scr[128 + par * 64 + lane] = b; scr[256 + par * 64 + lane] = cm; scr[384 + lane] = __expf(av - A63N);
    };
    auto write_tiles = [&](int par) {
        LAS unsigned char* buf = lds + par * ML_BUF;
        *(LAS u32x4*)(buf + ML_Q + srow * 144 + scc * 16) = pq;
        *(LAS u32x4*)(buf + ML_K + srow * 144 + scc * 16) = pk;
        const float w = scr[384 + srow];
        u32x4 kw; kw.x = pk2(bf_lo(pk.x) * w, bf_hi(pk.x) * w); kw.y = pk2(bf_lo(pk.y) * w, bf_hi(pk.y) * w); kw.z = pk2(bf_lo(pk.z) * w, bf_hi(pk.z) * w); kw.w = pk2(bf_lo(pk.w) * w, bf_hi(pk.w) * w);
        *(LAS u32x4*)(buf + ML_KW + srow * 192 + scc * 16) = kw;
        { const int idx = tid; *(LAS u32x4*)(buf + ML_V + (idx >> 4) * 320 + (idx & 15) * 16) = pv0; }
        { const int idx = tid + 512; *(LAS u32x4*)(buf + ML_V + (idx >> 4) * 320 + (idx & 15) * 16) = pv1; }
    };
    issue_loads(0);
    gate_tables(0);
    asm volatile("s_waitcnt lgkmcnt(0)" ::: "memory");
    write_tiles(0);
    f32x4 hgr[4];
    { const float* hgv = a.in[I_MHG] + ((size_t)l * 8 + h) * 128 + 32 * dvs + 4 * (lane >> 5);
#pragma unroll
      for (int g = 0; g < 4; ++g) hgr[g] = *(const f32x4*)(hgv + 8 * g); }
    for (int c = 0; c < NC; ++c) {
        const int par = c & 1;
        LAS unsigned char* buf = lds + par * ML_BUF;
        LDS_BARRIER();
        int lo_ = lane; asm volatile("" : "+v"(lo_));
        const int r = lo_ & 31, hh = lo_ >> 5, q16 = (lo_ & 15) >> 2, p16 = lo_ & 3, g16 = (lo_ >> 4) & 1;
        const float bend = bendN, A63 = A63N;
        u32x2 og[4];
#pragma unroll
        for (int g = 0; g < 4; ++g) og[g] = ogn[g];
        if (c + 1 < NC) issue_loads(c + 1);
        const int t = 32 * th + r;
        const float bt = scr[128 + par * 64 + t], cmt = scr[256 + par * 64 + t];
        const float Mt = fmaxf(mprev, cmt), mt = bt + Mt, winter = __expf(mprev - Mt);
        const size_t rb = (size_t)(rowbase0 + c * 64);
        f32x16 sD = f32x16{}, sF = f32x16{};
        bf16x8 qf[4];
#pragma unroll
        for (int ks = 0; ks < 4; ++ks) {
            qf[ks] = *(const LAS bf16x8*)(buf + ML_Q + t * 144 + ks * 32 + hh * 16);
            const bf16x8 kD = *(const LAS bf16x8*)(buf + ML_K + t * 144 + ks * 32 + hh * 16);
            sD = MFMA32(kD, qf[ks], sD);
        }
        if (th == 1) {
#pragma unroll
            for (int ks = 0; ks < 4; ++ks) { const bf16x8 kF = *(const LAS bf16x8*)(buf + ML_K + r * 144 + ks * 32 + hh * 16); sF = MFMA32(kF, qf[ks], sF); }
        }
        f32x16 acc = f32x16{};
#pragma unroll
        for (int kb = 0; kb < 2; ++kb)
#pragma unroll
            for (int s = 0; s < 2; ++s) {
                const LAS unsigned char* qp = buf + ML_Q + t * 144 + (32 * kb + 16 * s + 4 * hh) * 2;
                const v4i16 lo = *(const LAS v4i16*)qp, hi = *(const LAS v4i16*)(qp + 16);
                const bf16x8 qb = __builtin_shufflevector(lo, hi, 0, 1, 2, 3, 4, 5, 6, 7);
                acc = MFMA32(pack_step(Cst[kb], s), qb, acc);
            }
        float psum = 0.f;
#pragma unroll
        for (int i = 0; i < 16; ++i) {
            const int s0 = crow(i, hh);
            const float w0 = __expf(scr[par * 64 + 32 * th + s0] - Mt);
            sD[i] = (s0 <= r) ? sD[i] * w0 : 0.f;
            psum += sD[i];
        }
        if (th == 1) {
#pragma unroll
            for (int i = 0; i < 16; ++i) { const float w1 = __expf(scr[par * 64 + crow(i, hh)] - Mt); sF[i] *= w1; psum += sF[i]; }
        }
        psum = xor32_sum(psum);
        float qn = 0.f;
#pragma unroll
        for (int ks = 0; ks < 4; ++ks) { const u32x4 qq = __builtin_bit_cast(u32x4, qf[ks]); const LAS float* np = scr + 448 + 16 * ks + 8 * hh;
            qn += bf_lo(qq.x) * np[0] + bf_hi(qq.x) * np[1] + bf_lo(qq.y) * np[2] + bf_hi(qq.y) * np[3] + bf_lo(qq.z) * np[4] + bf_hi(qq.z) * np[5] + bf_lo(qq.w) * np[6] + bf_hi(qq.w) * np[7]; }
        qn = xor32_sum(qn);
        const float den = winter * qn + psum;
        const float inv = __builtin_amdgcn_rcpf(fmaxf(fabsf(den), __expf(-mt)));
#pragma unroll
        for (int i = 0; i < 16; ++i) acc[i] *= winter;
        {
            const LAS unsigned char* vb = buf + ML_V + (4 * hh + q16) * 320 + (32 * dvs + 16 * g16 + 4 * p16) * 2;
            const LAS unsigned char* vd = vb + (32 * th) * 320;
#pragma unroll
            for (int s = 0; s < 2; ++s) { const bf16x8 vf = tr_pair(vd + (16 * s) * 320, vd + (16 * s + 8) * 320); acc = MFMA32(vf, pack_step(sD, s), acc); }
            asm volatile("" ::: "memory");
            if (th == 1) {
#pragma unroll
                for (int s = 0; s < 2; ++s) { const bf16x8 vf = tr_pair(vb + (16 * s) * 320, vb + (16 * s + 8) * 320); acc = MFMA32(vf, pack_step(sF, s), acc); }
            }
        }
        {
            float ps = 0.f;
#pragma unroll
            for (int i = 0; i < 8; ++i) { const unsigned short v = *(const LAS unsigned short*)(buf + ML_KW + (8 * wave + i) * 192 + lane * 2); ps += __uint_as_float((unsigned)v << 16); }
            npart[wave * 64 + lane] = ps;
        }
        float hs = 0.f;
#pragma unroll
        for (int i = 0; i < 16; ++i) { acc[i] *= inv; hs += acc[i] * acc[i]; }
        hs = xor32_sum(hs);
        if (hh == 0) red[(th * 4 + dvs) * 32 + r] = hs;
        f32x16 Cl[2]; Cl[0] = f32x16{}; Cl[1] = f32x16{};
        {
            const LAS unsigned char* vb = buf + ML_V + (8 * hh + q16) * 320 + (32 * dvs + 16 * g16 + 4 * p16) * 2;
            const LAS unsigned char* kb_ = buf + ML_KW + (8 * hh + q16) * 192 + (16 * g16 + 4 * p16) * 2;
#pragma unroll
            for (int ks = 0; ks < 4; ++ks) {
                const bf16x8 bfv = tr_pair(vb + (16 * ks) * 320, vb + (16 * ks + 4) * 320);
#pragma unroll
                for (int kb = 0; kb < 2; ++kb) { const bf16x8 af = tr_pair(kb_ + (16 * ks) * 192 + 64 * kb, kb_ + (16 * ks + 4) * 192 + 64 * kb); Cl[kb] = MFMA32(af, bfv, Cl[kb]); }
                asm volatile("" ::: "memory");
            }
        }
        const float mloc = bend + A63, mnew = fmaxf(bend + mprev, mloc);
        const float wo = __expf(bend + mprev - mnew), wn = __expf(mloc - mnew);
#pragma unroll
        for (int kb = 0; kb < 2; ++kb)
#pragma unroll
            for (int i = 0; i < 16; ++i) Cst[kb][i] = wo * Cst[kb][i] + wn * Cl[kb][i];
        mprev = mnew;
        if (c + 1 < NC) { gate_tables(par ^ 1); asm volatile("s_waitcnt lgkmcnt(0)" ::: "memory"); write_tiles(par ^ 1); }
        LDS_BARRIER();
        const float tot = red[(th * 4 + 0) * 32 + r] + red[(th * 4 + 1) * 32 + r] + red[(th * 4 + 2) * 32 + r] + red[(th * 4 + 3) * 32 + r];
        const float rstd = __builtin_amdgcn_rsqf(tot * (1.0f / 128.0f) + EPS);
#pragma unroll
        for (int g = 0; g < 4; ++g) {
            const f32x4 hg4 = hgr[g];
            const float o0 = bf_lo(og[g].x), o1 = bf_hi(og[g].x), o2 = bf_lo(og[g].y), o3 = bf_hi(og[g].y);
            const float v0 = acc[4 * g + 0] * rstd * hg4.x * __builtin_amdgcn_rcpf(1.0f + __expf(-o0)), v1 = acc[4 * g + 1] * rstd * hg4.y * __builtin_amdgcn_rcpf(1.0f + __expf(-o1));
            const float v2 = acc[4 * g + 2] * rstd * hg4.z * __builtin_amdgcn_rcpf(1.0f + __expf(-o2)), v3 = acc[4 * g + 3] * rstd * hg4.w * __builtin_amdgcn_rcpf(1.0f + __expf(-o3));
            u32x2 o; o.x = pk2(v0, v1); o.y = pk2(v2, v3);
            *(u32x2*)(HG + (rb + t) * D + h * 128 + 32 * dvs + 8 * g + 4 * hh) = o;
        }
        {
            float nl = 0.f;
#pragma unroll
            for (int w = 0; w < 8; ++w) nl += npart[w * 64 + lane];
            nst = wo * nst + wn * nl; scr[448 + lane] = nst;
        }
    }
    {
        float* out = a.out;
        const size_t oidx = isP ? (size_t)((l * 8 + seq) * 8 + h) : (size_t)sidx;
        float* Co = out + (isP ? OFF_PC : OFF_SC) + oidx * 8192 + 32 * dvs + (lane & 31) + (lane >> 5) * 512;
        if (th == 0) {
#pragma unroll
            for (int kb = 0; kb < 2; ++kb)
#pragma unroll
                for (int i = 0; i < 16; ++i) Co[(32 * kb + crow(i, 0)) * 128] = Cst[kb][i];
        }
        if (wave == 0) { out[(isP ? OFF_PN : OFF_SN) + oidx * 64 + lane] = nst; if (lane == 0) out[(isP ? OFF_PM : OFF_SM) + oidx] = mprev; }
    }
    WG_BARRIER();
}
DI void mlstm_phase(ArgsRef a, LAS unsigned char* lds, int l, int vcu, int G, int tid, int wave, int lane) {
    const int nrest = G > 64 ? G - 64 : G, first = G > 64 ? 64 : 0;
    int u = vcu; bool inP = true;
#pragma unroll 1
    for (;;) {
        int seq, h;
        if (inP) { if (u >= 64) { inP = false; u = vcu >= first ? vcu - first : 256; continue; } seq = u >> 3; h = u & 7; u += G; }
        else { if (u >= 256) break; seq = 8 + (u >> 3); h = u & 7; u += nrest; }
        mlstm_unit(a, lds, l, seq, h, tid, wave, lane);
    }
    if (l == 0 && vcu >= first) {
        prologue_weights(a, lds, (vcu - first) * NWAVES + wave, nrest * NWAVES, wave, lane, 1);
        prologue_cache(a, (vcu - first) * 512 + tid, nrest * 512, CACHE_T3, CACHE_CH);
    }
}

constexpr int ML_NUNITS = 4352;
DI void ml_unit_decode(int u, int& rowbase, int& h) {
    if (u < 4096) { rowbase = (u >> 9) * 4096 + (u & 63) * 64; h = (u >> 6) & 7; } else { const int us = u - 4096; rowbase = MP + (us >> 3) * 64; h = us & 7; }
}
constexpr int MA_KW = 0, MA_V = 12288, MA_BUF = 32768;
constexpr int MA_SCR = 2 * MA_BUF, MA_NP = MA_SCR + 8 * 256;
DI void mlA_phase(ArgsRef a, LAS unsigned char* lds, int vcu, int G, int tid, int wave, int lane) {
    const bf16_t* PROJ = (const bf16_t*)(a.ws + WS_PROJ);
    const float* GT = (const float*)(a.ws + WS_GATES);
    float* CL = (float*)(a.ws + WS_CL); float* NL = (float*)(a.ws + WS_NL); float* TAB = (float*)(a.ws + WS_TAB);
    const int per = (ML_NUNITS + G - 1) / G, u0 = vcu * per, u1 = (u0 + per < ML_NUNITS) ? u0 + per : ML_NUNITS;
    if (u0 >= u1) return;
    const int dvs = wave & 3, kb = wave >> 2;
    LAS float* wT = (LAS float*)(lds + MA_SCR + wave * 256);
    LAS float* npart = (LAS float*)(lds + MA_NP);
    const int srow = tid >> 3, scc = tid & 7;
    struct InA { u32x4 pk, pv0, pv1; float pig, pfg; };
    InA X, Y;
    auto issue_loads = [&](InA& in, int u) {
        int rb, h; ml_unit_decode(u, rb, h);
        in.pk = *(const u32x4*)(PROJ + (size_t)(rb + srow) * NPROJ + 512 + h * 64 + scc * 8);
        { const int idx = tid; in.pv0 = *(const u32x4*)(PROJ + (size_t)(rb + (idx >> 4)) * NPROJ + 1024 + h * 128 + (idx & 15) * 8); }
        { const int idx = tid + 512; in.pv1 = *(const u32x4*)(PROJ + (size_t)(rb + (idx >> 4)) * NPROJ + 1024 + h * 128 + (idx & 15) * 8); }
        in.pig = GT[(size_t)(rb + lane) * 16 + h]; in.pfg = GT[(size_t)(rb + lane) * 16 + 8 + h];
    };
    auto stage = [&](const InA& in, int u, int par) {
        const float b = wave_scan_add(logsigmoidf(in.pfg));
        const float av = in.pig - b;
        const float cm = wave_scan_max(av);
        const float A63 = __builtin_bit_cast(float, __builtin_amdgcn_readlane(__builtin_bit_cast(int, cm), 63));
        const float bend = __builtin_bit_cast(float, __builtin_amdgcn_readlane(__builtin_bit_cast(int, b), 63));
        wT[lane] = __expf(av - A63);
        if (wave == 0) { float* t = TAB + (size_t)u * 256; t[lane] = av; t[64 + lane] = b; t[128 + lane] = cm; if (lane == 0) { t[192] = bend; t[193] = bend + A63; } }
        asm volatile("s_waitcnt lgkmcnt(0)" ::: "memory");
        LAS unsigned char* buf = lds + par * MA_BUF;
        const float w = wT[srow]; const u32x4 pk = in.pk;
        u32x4 kw; kw.x = pk2(bf_lo(pk.x) * w, bf_hi(pk.x) * w); kw.y = pk2(bf_lo(pk.y) * w, bf_hi(pk.y) * w); kw.z = pk2(bf_lo(pk.z) * w, bf_hi(pk.z) * w); kw.w = pk2(bf_lo(pk.w) * w, bf_hi(pk.w) * w);
        *(LAS u32x4*)(buf + MA_KW + srow * 192 + scc * 16) = kw;
        { const int idx = tid; *(LAS u32x4*)(buf + MA_V + (idx >> 4) * 320 + (idx & 15) * 16) = in.pv0; }
        { const int idx = tid + 512; *(LAS u32x4*)(buf + MA_V + (idx >> 4) * 320 + (idx & 15) * 16) = in.pv1; }
    };
    auto body = [&](int u, int par, InA& nxt) {
        LAS unsigned char* buf = lds + par * MA_BUF;
        LDS_BARRIER();
        int lo_ = lane; asm volatile("" : "+v"(lo_));
        const int r = lo_ & 31, hh = lo_ >> 5, q16 = (lo_ & 15) >> 2, p16 = lo_ & 3, g16 = (lo_ >> 4) & 1;
        if (u + 1 < u1) stage(nxt, u + 1, par ^ 1);
        if (u + 3 < u1) issue_loads(nxt, u + 3);
        if (u > u0 && wave == 0) {
            float nl = 0.f;
#pragma unroll
            for (int w = 0; w < 8; ++w) nl += npart[((par ^ 1) * 8 + w) * 64 + lo_];
            NL[(size_t)(u - 1) * 64 + lo_] = nl;
        }
        {
            float ps = 0.f;
#pragma unroll
            for (int i = 0; i < 8; ++i) { const unsigned short v = *(const LAS unsigned short*)(buf + MA_KW + (8 * wave + i) * 192 + lo_ * 2); ps += __uint_as_float((unsigned)v << 16); }
            npart[(par * 8 + wave) * 64 + lo_] = ps;
        }
        f32x16 Cl = f32x16{};
        {
            const LAS unsigned char* vb = buf + MA_V + (8 * hh + q16) * 320 + (32 * dvs + 16 * g16 + 4 * p16) * 2;
            const LAS unsigned char* kp = buf + MA_KW + (8 * hh + q16) * 192 + (32 * kb + 16 * g16 + 4 * p16) * 2;
            bf16x8 af[4], bfv[4];
#pragma unroll
            for (int ks = 0; ks < 4; ++ks) { bfv[ks] = tr_pair(vb + (16 * ks) * 320, vb + (16 * ks + 4) * 320); af[ks] = tr_pair(kp + (16 * ks) * 192, kp + (16 * ks + 4) * 192); }
#pragma unroll
            for (int ks = 0; ks < 4; ++ks) Cl = MFMA32(af[ks], bfv[ks], Cl);
        }
        float* Co = CL + (size_t)u * 8192 + (size_t)((kb * 4 + dvs) * 64 + lo_) * 16;
#pragma unroll
        for (int g = 0; g < 4; ++g) __builtin_nontemporal_store((f32x4){Cl[4 * g], Cl[4 * g + 1], Cl[4 * g + 2], Cl[4 * g + 3]}, (f32x4*)(Co + 4 * g));
    };
    issue_loads(X, u0); if (u0 + 1 < u1) issue_loads(Y, u0 + 1);
    stage(X, u0, 0);
    if (u0 + 2 < u1) issue_loads(X, u0 + 2);
#pragma unroll 1
    for (int u = u0; u < u1; u += 2) {
        body(u, 0, Y);
        if (u + 1 < u1) body(u + 1, 1, X);
    }
    LDS_BARRIER();
    if (wave == 0) { const int par = (u1 - 1 - u0) & 1; float nl = 0.f;
#pragma unroll
        for (int w = 0; w < 8; ++w) nl += npart[(par * 8 + w) * 64 + lane];
        NL[(size_t)(u1 - 1) * 64 + lane] = nl; }
    LDS_BARRIER();
}
DI void mlB_phase(ArgsRef a, int l, int vcu, int G, int tid) {
    const float* CL = (const float*)(a.ws + WS_CL); const float* NL = (const float*)(a.ws + WS_NL); const float* TAB = (const float*)(a.ws + WS_TAB);
    bf16_t* CP = (bf16_t*)(a.ws + WS_CP); float* NPREV = (float*)(a.ws + WS_NPREV); float* MPREV = (float*)(a.ws + WS_MPREV);
    float* out = a.out;
#pragma unroll 1
    for (int cp = vcu; cp < 256; cp += G) {
        const int chain = cp >> 2, part = cp & 3, e0 = part * 2048 + tid * 4;
        f32x4 C = (f32x4){0.f, 0.f, 0.f, 0.f}, n4 = C; float m = 0.f;
        const bool nthr = (part == 0 && tid < 16);
        const float* cl = CL + (size_t)chain * 64 * 8192 + e0; bf16_t* cpo = CP + (size_t)chain * 64 * 8192 + e0;
        const int nblk = e0 >> 10, nln = (e0 >> 4) & 63, ni0 = e0 & 15;
        const int nat0 = (32 * (nblk >> 2) + 8 * (ni0 >> 2) + 4 * (nln >> 5)) * 128 + 32 * (nblk & 3) + (nln & 31);
        float woL = 0.f, wnL = 0.f, mpL = 0.f;
        { const int ln = tid & 63; const float be = TAB[(size_t)(chain * 64 + ln) * 256 + 192], ml = TAB[(size_t)(chain * 64 + ln) * 256 + 193];
#pragma unroll 1
          for (int c = 0; c < 64; ++c) {
              const float b = __builtin_bit_cast(float, __builtin_amdgcn_readlane(__builtin_bit_cast(int, be), c)), q = __builtin_bit_cast(float, __builtin_amdgcn_readlane(__builtin_bit_cast(int, ml), c));
              const float mnew = fmaxf(b + m, q), wo = __expf(b + m - mnew), wn = __expf(q - mnew);
              if (ln == c) { woL = wo; wnL = wn; mpL = m; }
              m = mnew;
          } }
        f32x4 nb[8], nn[8];
        const float* nlp = NL + (size_t)chain * 64 * 64 + (nthr ? tid * 4 : 0);
#pragma unroll
        for (int j = 0; j < 8; ++j) { nb[j] = __builtin_nontemporal_load((const f32x4*)(cl + (size_t)j * 8192)); nn[j] = *(const f32x4*)(nlp + j * 64); }
#pragma unroll 1
        for (int cb = 0; cb < 8; ++cb) {
            f32x4 cb8[8], cn8[8];
#pragma unroll
            for (int j = 0; j < 8; ++j) { cb8[j] = nb[j]; cn8[j] = nn[j]; }
            if (cb + 1 < 8) {
#pragma unroll
                for (int j = 0; j < 8; ++j) { nb[j] = __builtin_nontemporal_load((const f32x4*)(cl + (size_t)(8 * (cb + 1) + j) * 8192)); nn[j] = *(const f32x4*)(nlp + (8 * (cb + 1) + j) * 64); }
            }
#pragma unroll
            for (int j = 0; j < 8; ++j) {
                const int c = 8 * cb + j, u = chain * 64 + c;
                const float wo = __builtin_bit_cast(float, __builtin_amdgcn_readlane(__builtin_bit_cast(int, woL), c)), wn = __builtin_bit_cast(float, __builtin_amdgcn_readlane(__builtin_bit_cast(int, wnL), c));
                { u32x2 w; w.x = pk2(C.x, C.y); w.y = pk2(C.z, C.w); *(u32x2*)(cpo + (size_t)c * 8192) = w; }
                C = C * wo + cb8[j] * wn;
                if (nthr) { *(f32x4*)(NPREV + (size_t)u * 64 + tid * 4) = n4; if (tid == 0) MPREV[u] = __builtin_bit_cast(float, __builtin_amdgcn_readlane(__builtin_bit_cast(int, mpL), c)); }
                n4 = n4 * wo + cn8[j] * wn;
            }
        }
        const size_t oidx = (size_t)(l * 64 + chain);
        { float* po = out + OFF_PC + oidx * 8192 + nat0; po[0] = C.x; po[128] = C.y; po[256] = C.z; po[384] = C.w; }
        if (nthr) { *(f32x4*)(out + OFF_PN + oidx * 64 + tid * 4) = n4; if (tid == 0) out[OFF_PM + oidx] = m; }
    }
    const int NT = G * 512, gt = vcu * 512 + tid;
    for (int i = gt; i < 256 * 2048; i += NT) {
        const int us = i >> 11, q = i & 2047, u = 4096 + us; const size_t sidx = (size_t)l * 256 + us;
        const float m = a.in[I_SM][sidx];
        const float bend = TAB[(size_t)u * 256 + 192], mloc = TAB[(size_t)u * 256 + 193];
        const float mnew = fmaxf(bend + m, mloc), wo = __expf(bend + m - mnew), wn = __expf(mloc - mnew);
        const int e = q * 4, sblk = e >> 10, sln = (e >> 4) & 63, si0 = e & 15;
        const int nat = (32 * (sblk >> 2) + 8 * (si0 >> 2) + 4 * (sln >> 5)) * 128 + 32 * (sblk & 3) + (sln & 31);
        const float* ci = a.in[I_SC] + sidx * 8192 + nat; float* co = out + OFF_SC + sidx * 8192 + nat;
        const f32x4 cl4 = *(const f32x4*)(CL + (size_t)u * 8192 + e);
        co[0] = ci[0] * wo + cl4.x * wn; co[128] = ci[128] * wo + cl4.y * wn; co[256] = ci[256] * wo + cl4.z * wn; co[384] = ci[384] * wo + cl4.w * wn;
        if (q < 16) { const f32x4 nin = *(const f32x4*)(a.in[I_SN] + sidx * 64 + q * 4), nl4 = *(const f32x4*)(NL + (size_t)u * 64 + q * 4);
            *(f32x4*)(out + OFF_SN + sidx * 64 + q * 4) = nin * wo + nl4 * wn; if (q == 0) out[OFF_SM + sidx] = mnew; }
    }
}
constexpr int MC_Q = 0, MC_K = 9216, MC_V = 18432, MC_BUF = 38912;
constexpr int MC_SCR = 2 * MC_BUF;
constexpr int MC_RED = MC_SCR + 8 * 2048, MC_HG = MC_RED + 1024;
DI void mlC_phase(ArgsRef a, LAS unsigned char* lds, int l, int vcu, int G, int tid, int wave, int lane) {
    const bf16_t* PROJ = (const bf16_t*)(a.ws + WS_PROJ);
    const float* TAB = (const float*)(a.ws + WS_TAB); const bf16_t* CP = (const bf16_t*)(a.ws + WS_CP);
    const float* NPREV = (const float*)(a.ws + WS_NPREV); const float* MPREV = (const float*)(a.ws + WS_MPREV);
    bf16_t* HG = (bf16_t*)(a.ws + WS_HG);
    const int per = (ML_NUNITS + G - 1) / G, u0 = vcu * per, u1 = (u0 + per < ML_NUNITS) ? u0 + per : ML_NUNITS;
    if (u0 >= u1) return;
    const int dvs = wave & 3, th = wave >> 2;
    LAS float* scr = (LAS float*)(lds + MC_SCR + wave * 2048);
    LAS float* red = (LAS float*)(lds + MC_RED);
    const int srow = tid >> 3, scc = tid & 7;
    LAS float* hgl = (LAS float*)(lds + MC_HG);
    for (int i = tid; i < 1024; i += 512) hgl[i] = a.in[I_MHG][(size_t)l * 1024 + i];
    struct InC { u32x4 pq, pk, pv0, pv1; float ta, tb, tc, tn; };
    InC X, Y; u32x2 ogn[4]; float mpn; bf16x8 Cn[2][2];
    auto issue_tiles = [&](InC& in, int u) {
        int rb, h; ml_unit_decode(u, rb, h);
        const bf16_t* pr = PROJ + (size_t)(rb + srow) * NPROJ;
        in.pq = *(const u32x4*)(pr + h * 64 + scc * 8);
        in.pk = *(const u32x4*)(pr + 512 + h * 64 + scc * 8);
        { const int idx = tid; in.pv0 = *(const u32x4*)(PROJ + (size_t)(rb + (idx >> 4)) * NPROJ + 1024 + h * 128 + (idx & 15) * 8); }
        { const int idx = tid + 512; in.pv1 = *(const u32x4*)(PROJ + (size_t)(rb + (idx >> 4)) * NPROJ + 1024 + h * 128 + (idx & 15) * 8); }
        const float* t = TAB + (size_t)u * 256; in.ta = t[lane]; in.tb = t[64 + lane]; in.tc = t[128 + lane];
        if (u < 4096) in.tn = NPREV[(size_t)u * 64 + lane]; else in.tn = a.in[I_SN][((size_t)l * 256 + (u - 4096)) * 64 + lane];
    };
    auto issue_regs = [&](int u) {
        int rb, h; ml_unit_decode(u, rb, h);
        const bf16_t* po = PROJ + (size_t)(rb + 32 * th + (lane & 31)) * NPROJ + 2048 + h * 128 + 32 * dvs + 4 * (lane >> 5);
#pragma unroll
        for (int g = 0; g < 4; ++g) ogn[g] = *(const u32x2*)(po + 8 * g);
        if (u < 4096) {
            mpn = MPREV[u];
#pragma unroll
            for (int kb = 0; kb < 2; ++kb) { const bf16_t* cp = CP + (size_t)u * 8192 + (size_t)((kb * 4 + dvs) * 64 + lane) * 16;
                Cn[kb][0] = *(const bf16x8*)cp; Cn[kb][1] = *(const bf16x8*)(cp + 8); }
        } else {
            const size_t sidx = (size_t)l * 256 + (u - 4096); mpn = a.in[I_SM][sidx];
            const float* Cin = a.in[I_SC] + sidx * 8192 + 32 * dvs + (lane & 31) + (lane >> 5) * 512;
#pragma unroll
            for (int kb = 0; kb < 2; ++kb) { f32x16 cf;
#pragma unroll
                for (int i = 0; i < 16; ++i) cf[i] = Cin[(32 * kb + (i & 3) + 8 * (i >> 2)) * 128];
                Cn[kb][0] = pack_step(cf, 0); Cn[kb][1] = pack_step(cf, 1); }
        }
    };
    auto stage = [&](const InC& in, int par) {
        LAS unsigned char* buf = lds + par * MC_BUF;
        *(LAS u32x4*)(buf + MC_Q + srow * 144 + scc * 16) = in.pq;
        *(LAS u32x4*)(buf + MC_K + srow * 144 + scc * 16) = in.pk;
        { const int idx = tid; *(LAS u32x4*)(buf + MC_V + (idx >> 4) * 320 + (idx & 15) * 16) = in.pv0; }
        { const int idx = tid + 512; *(LAS u32x4*)(buf + MC_V + (idx >> 4) * 320 + (idx & 15) * 16) = in.pv1; }
        scr[par * 64 + lane] = in.ta; scr[128 + par * 64 + lane] = in.tb; scr[256 + par * 64 + lane] = in.tc; scr[384 + par * 64 + lane] = in.tn;
    };
    issue_tiles(X, u0); issue_regs(u0); if (u0 + 1 < u1) issue_tiles(Y, u0 + 1);
    stage(X, 0);
    if (u0 + 2 < u1) issue_tiles(X, u0 + 2);
    LDS_BARRIER();
    auto body = [&](int u, int par, InC& nxt) {
        LAS unsigned char* buf = lds + par * MC_BUF;
        LDS_BARRIER();
        int lo_ = lane; asm volatile("" : "+v"(lo_));
        const int r = lo_ & 31, hh = lo_ >> 5, q16 = (lo_ & 15) >> 2, p16 = lo_ & 3, g16 = (lo_ >> 4) & 1;
        int rb, h; ml_unit_decode(u, rb, h);
        u32x2 og[4]; bf16x8 Cst[2][2]; const float mprev = mpn;
#pragma unroll
        for (int g = 0; g < 4; ++g) og[g] = ogn[g];
        Cst[0][0] = Cn[0][0]; Cst[0][1] = Cn[0][1]; Cst[1][0] = Cn[1][0]; Cst[1][1] = Cn[1][1];
        if (u + 1 < u1) { stage(nxt, par ^ 1); issue_regs(u + 1); }
        if (u + 3 < u1) issue_tiles(nxt, u + 3);
        const int t = 32 * th + r;
        const float bt = scr[128 + par * 64 + t], cmt = scr[256 + par * 64 + t];
        const float Mt = fmaxf(mprev, cmt), mt = bt + Mt, winter = __expf(mprev - Mt);
        f32x16 sD = f32x16{}, sF = f32x16{};
        bf16x8 qf[4];
#pragma unroll
        for (int ks = 0; ks < 4; ++ks) {
            qf[ks] = *(const LAS bf16x8*)(buf + MC_Q + t * 144 + ks * 32 + hh * 16);
            const bf16x8 kD = *(const LAS bf16x8*)(buf + MC_K + t * 144 + ks * 32 + hh * 16);
            sD = MFMA32(kD, qf[ks], sD);
        }
        if (th == 1) {
#pragma unroll
            for (int ks = 0; ks < 4; ++ks) { const bf16x8 kF = *(const LAS bf16x8*)(buf + MC_K + r * 144 + ks * 32 + hh * 16); sF = MFMA32(kF, qf[ks], sF); }
        }
        f32x16 acc = f32x16{};
#pragma unroll
        for (int kb = 0; kb < 2; ++kb)
#pragma unroll
            for (int s = 0; s < 2; ++s) {
                const LAS unsigned char* qp = buf + MC_Q + t * 144 + (32 * kb + 16 * s + 4 * hh) * 2;
                const v4i16 lo = *(const LAS v4i16*)qp, hi = *(const LAS v4i16*)(qp + 16);
                const bf16x8 qb = __builtin_shufflevector(lo, hi, 0, 1, 2, 3, 4, 5, 6, 7);
                acc = MFMA32(Cst[kb][s], qb, acc);
            }
        float psum = 0.f;
#pragma unroll
        for (int i = 0; i < 16; ++i) {
            const int s0 = crow(i, hh);
            const float w0 = __expf(scr[par * 64 + 32 * th + s0] - Mt);
            sD[i] = (s0 <= r) ? sD[i] * w0 : 0.f;
            psum += sD[i];
        }
        if (th == 1) {
#pragma unroll
            for (int i = 0; i < 16; ++i) { const float w1 = __expf(scr[par * 64 + crow(i, hh)] - Mt); sF[i] *= w1; psum += sF[i]; }
        }
        psum = xor32_sum(psum);
        float qn = 0.f;
#pragma unroll
        for (int ks = 0; ks < 4; ++ks) { const u32x4 qq = __builtin_bit_cast(u32x4, qf[ks]); const LAS float* np = scr + 384 + par * 64 + 16 * ks + 8 * hh;
            qn += bf_lo(qq.x) * np[0] + bf_hi(qq.x) * np[1] + bf_lo(qq.y) * np[2] + bf_hi(qq.y) * np[3] + bf_lo(qq.z) * np[4] + bf_hi(qq.z) * np[5] + bf_lo(qq.w) * np[6] + bf_hi(qq.w) * np[7]; }
        qn = xor32_sum(qn);
        const float den = winter * qn + psum;
        const float inv = __builtin_amdgcn_rcpf(fmaxf(fabsf(den), __expf(-mt)));
#pragma unroll
        for (int i = 0; i < 16; ++i) acc[i] *= winter;
        {
            const LAS unsigned char* vb = buf + MC_V + (4 * hh + q16) * 320 + (32 * dvs + 16 * g16 + 4 * p16) * 2;
            const LAS unsigned char* vd = vb + (32 * th) * 320;
#pragma unroll
            for (int s = 0; s < 2; ++s) { const bf16x8 vf = tr_pair(vd + (16 * s) * 320, vd + (16 * s + 8) * 320); acc = MFMA32(vf, pack_step(sD, s), acc); }
            asm volatile("" ::: "memory");
            if (th == 1) {
#pragma unroll
                for (int s = 0; s < 2; ++s) { const bf16x8 vf = tr_pair(vb + (16 * s) * 320, vb + (16 * s + 8) * 320); acc = MFMA32(vf, pack_step(sF, s), acc); }
            }
        }
        float hs = 0.f;
#pragma unroll
        for (int i = 0; i < 16; ++i) { acc[i] *= inv; hs += acc[i] * acc[i]; }
        hs = xor32_sum(hs);
        if (hh == 0) red[(th * 4 + dvs) * 32 + r] = hs;
        LDS_BARRIER();
        const float tot = red[(th * 4 + 0) * 32 + r] + red[(th * 4 + 1) * 32 + r] + red[(th * 4 + 2) * 32 + r] + red[(th * 4 + 3) * 32 + r];
        const float rstd = __builtin_amdgcn_rsqf(tot * (1.0f / 128.0f) + EPS);
#pragma unroll
        for (int g = 0; g < 4; ++g) {
            const f32x4 hgq = *(const LAS f32x4*)(hgl + h * 128 + 32 * dvs + 8 * g + 4 * hh);
            const float o0 = bf_lo(og[g].x), o1 = bf_hi(og[g].x), o2 = bf_lo(og[g].y), o3 = bf_hi(og[g].y);
            const float v0 = acc[4 * g + 0] * rstd * hgq.x * __builtin_amdgcn_rcpf(1.0f + __expf(-o0)), v1 = acc[4 * g + 1] * rstd * hgq.y * __builtin_amdgcn_rcpf(1.0f + __expf(-o1));
            const float v2 = acc[4 * g + 2] * rstd * hgq.z * __builtin_amdgcn_rcpf(1.0f + __expf(-o2)), v3 = acc[4 * g + 3] * rstd * hgq.w * __builtin_amdgcn_rcpf(1.0f + __expf(-o3));
            u32x2 o; o.x = pk2(v0, v1); o.y = pk2(v2, v3);
            *(u32x2*)(HG + (size_t)(rb + t) * D + h * 128 + 32 * dvs + 8 * g + 4 * hh) = o;
        }
    };
#pragma unroll 1
    for (int u = u0; u < u1; u += 2) {
        body(u, 0, Y);
        if (u + 1 < u1) body(u + 1, 1, X);
    }
    LDS_BARRIER();
}

constexpr int AT_HALFB = 65536;
constexpr int AT_TBL = 2 * AT_HALFB;
constexpr int AT_MISC = AT_TBL + 8192;
struct AttnHalf { const bf16_t* Q; const bf16_t* K; const bf16_t* V; int qrow0; int h, qc, t0, t1; };

template <bool SHARED, bool KSPLIT = false>
DI void attn_workunit(ArgsRef a, LAS unsigned char* lds, const AttnHalf hp, int niter, int nmax, bool merge, float lam, float onem, const LAS float* hgain,
                      int tid, int wave, int lane) {
    asm volatile("" : "+v"(lane));
    const int hw = wave >> 2, wl = wave & 3, cbr = wl >> 1, qh = wl & 1, r = lane & 31, hh = lane >> 5;
    const int q16 = (lane & 15) >> 2, p16 = lane & 3, g16 = (lane >> 4) & 1;
    LAS unsigned char* hb = lds + hw * AT_HALFB;
    const LAS float* tbl = (const LAS float*)(lds + AT_TBL) + hp.h * 256;
    bf16_t* HG = (bf16_t*)(a.ws + WS_HG);
    const int n = hp.t1 - hp.t0;
    const int wd = SHARED ? wave : wl;
    const int rowl = 4 * wd + (lane >> 4), pc = lane & 15;
    const int ck = pc ^ (rowl & 15);
    const int cv = (((pc >> 2) ^ ((lane >> 4) & 3)) << 2) | (pc & 3);
    const bf16_t* gk = hp.K + ((size_t)hp.t0 * 64 + rowl) * D + hp.h * 128 + ck * 8;
    const bf16_t* gv = hp.V + ((size_t)hp.t0 * 64 + rowl) * D + hp.h * 128 + cv * 8;
    auto kslot = [&](int j) -> LAS unsigned char* { if constexpr (SHARED) { int sj = j & 3; asm volatile("" : "+s"(sj)); return lds + sj * 32768; } else return hb + (j & 1) * 16384; };
    auto vslot = [&](int j) -> LAS unsigned char* { if constexpr (SHARED) { int sj = j & 3; asm volatile("" : "+s"(sj)); return lds + sj * 32768 + 16384; } else return hb + 32768 + (j & 1) * 16384; };
    auto dma_k = [&](int j) {
        LAS unsigned char* dst = kslot(j) + wd * 1024; const bf16_t* src = gk + (size_t)j * 64 * D;
        if constexpr (SHARED) {
#pragma unroll
            for (int q = 0; q < 2; ++q) __builtin_amdgcn_global_load_lds((const unsigned*)(src + q * 32 * D), (LAS unsigned*)(dst + q * 8192), 16, 0, KSPLIT ? 2 : 0);
        } else {
#pragma unroll
            for (int q = 0; q < 4; ++q) __builtin_amdgcn_global_load_lds((const unsigned*)(src + q * 16 * D), (LAS unsigned*)(dst + q * 4096), 16, 0, 0);
        }
    };
    auto dma_v = [&](int j) {
        LAS unsigned char* dst = vslot(j) + wd * 1024; const bf16_t* src = gv + (size_t)j * 64 * D;
        if constexpr (SHARED) {
#pragma unroll
            for (int q = 0; q < 2; ++q) __builtin_amdgcn_global_load_lds((const unsigned*)(src + q * 32 * D), (LAS unsigned*)(dst + q * 8192), 16, 0, KSPLIT ? 2 : 0);
        } else {
#pragma unroll
            for (int q = 0; q < 4; ++q) __builtin_amdgcn_global_load_lds((const unsigned*)(src + q * 16 * D), (LAS unsigned*)(dst + q * 4096), 16, 0, 0);
        }
    };
    int ka[4], va[4];
    { const int y = (cbr * 8 + hh) ^ (r & 15);
#pragma unroll
      for (int ks = 0; ks < 4; ++ks) ka[ks] = r * 256 + ((y ^ (2 * ks)) << 4);
#pragma unroll
      for (int d = 0; d < 4; ++d) va[d] = (4 * hh + q16) * 256 + ((d ^ q16) << 6) + 32 * g16 + 8 * p16; }
    if constexpr (SHARED) {
        if (nmax > 0) { dma_k(0); dma_v(0); }
        if (nmax > 1) { dma_k(1); dma_v(1); }
        if (nmax > 2) { dma_k(2); dma_v(2); }
    } else {
        if (n > 0) { dma_k(0); dma_v(0); }
        if (n > 1) dma_k(1);
    }
    bf16x8 qf[4];
    { const bf16_t* qp = hp.Q + (size_t)(hp.qrow0 + 32 * qh + r) * D + hp.h * 128 + cbr * 64 + 8 * hh;
#pragma unroll
      for (int ks = 0; ks < 4; ++ks) qf[ks] = *(const bf16x8*)(qp + 16 * ks); }
    f32x16 O[4]; O[0] = f32x16{}; O[1] = f32x16{}; O[2] = f32x16{}; O[3] = f32x16{};
    float mrun = 0.f, lrun = 0.f;
    const float c15 = tbl[0];
    f32x16 cb;
#pragma unroll
    for (int i = 0; i < 16; ++i) cb[i] = c15;
    const int qq = 32 * qh + r;
    auto qk = [&](f32x16& sA, f32x16& sB, int j) {
        const LAS unsigned char* Kt = kslot(j);
        const int dt = hp.qc - (hp.t0 + j);
        bf16x8 kf[8];
#pragma unroll
        for (int ks = 0; ks < 4; ++ks) { kf[2 * ks] = *(const LAS bf16x8*)(Kt + ka[ks]); kf[2 * ks + 1] = *(const LAS bf16x8*)(Kt + ka[ks] + 8192); }
        if (dt >= 3) {
            sA = MFMA32(kf[0], qf[0], cb); sB = MFMA32(kf[1], qf[0], cb);
        } else {
            const int base = 192 - 64 * dt - qq;
#pragma unroll
            for (int i = 0; i < 16; ++i) { sA[i] = tbl[base + crow(i, hh)] - mrun; sB[i] = tbl[base + 32 + crow(i, hh)] - mrun; }
            sA = MFMA32(kf[0], qf[0], sA); sB = MFMA32(kf[1], qf[0], sB);
        }
#pragma unroll
        for (int ks = 1; ks < 4; ++ks) { sA = MFMA32(kf[2 * ks], qf[ks], sA); sB = MFMA32(kf[2 * ks + 1], qf[ks], sB); }
    };
    auto step = [&](int i, f32x16& sA, f32x16& sB, f32x16& nA, f32x16& nB) {
        if constexpr (SHARED) {
            if (i + 2 < nmax) asm volatile("s_waitcnt vmcnt(4) lgkmcnt(0)" ::: "memory"); else asm volatile("s_waitcnt vmcnt(0) lgkmcnt(0)" ::: "memory");
            __builtin_amdgcn_s_barrier(); asm volatile("" ::: "memory");
            if (i + 3 < nmax) { dma_k(i + 3); dma_v(i + 3); }
        } else {
            asm volatile("s_waitcnt vmcnt(0) lgkmcnt(0)" ::: "memory");
            __builtin_amdgcn_s_barrier(); asm volatile("" ::: "memory");
            if (i + 2 < n) dma_k(i + 2);
            if (i + 1 < n) dma_v(i + 1);
        }
        if (i < n) {
            qk(nA, nB, i + 1);
            const LAS unsigned char* Vt = vslot(i);
            float mx0 = max3f(sA[0], sB[0], sA[1]), mx1 = max3f(sB[1], sA[2], sB[2]);
#pragma unroll
            for (int k = 3; k < 15; k += 2) { mx0 = max3f(mx0, sA[k], sB[k]); mx1 = max3f(mx1, sA[k + 1], sB[k + 1]); }
            float mx = max3f(mx0, mx1, sA[15]); mx = max3f(mx, sB[15], sB[15]); mx = xor32_max(mx);
            if (__any(mx > 6.0f)) {
                const float dm = fmaxf(mx, 0.f), alpha = __builtin_amdgcn_exp2f(-dm);
                mrun += dm; lrun *= alpha;
#pragma unroll
                for (int k = 0; k < 16; ++k) { sA[k] -= dm; sB[k] -= dm; nA[k] -= dm; nB[k] -= dm; cb[k] -= dm; }
#pragma unroll
                for (int d = 0; d < 4; ++d)
#pragma unroll
                    for (int k = 0; k < 16; ++k) O[d][k] *= alpha;
            }
            float ps = lrun;
#pragma unroll
            for (int k = 0; k < 8; ++k) { sA[k] = __builtin_amdgcn_exp2f(sA[k]); sB[k] = __builtin_amdgcn_exp2f(sB[k]); ps = ps + sA[k]; ps = ps + sB[k]; }
            const bf16x8 pA0 = pack_step(sA, 0), pB0 = pack_step(sB, 0);
            bf16x8 vf[4];
#pragma unroll
            for (int dh = 0; dh < 2; ++dh) {
#pragma unroll
                for (int d2 = 0; d2 < 2; ++d2) { const int d = 2 * dh + d2; vf[2 * d2] = tr_pair(Vt + va[d], Vt + va[d] + 8 * 256); vf[2 * d2 + 1] = tr_pair(Vt + va[d] + 32 * 256, Vt + va[d] + 40 * 256); }
#pragma unroll
                for (int d2 = 0; d2 < 2; ++d2) { const int d = 2 * dh + d2; O[d] = MFMA32(vf[2 * d2], pA0, O[d]); O[d] = MFMA32(vf[2 * d2 + 1], pB0, O[d]); }
            }
#pragma unroll
            for (int k = 8; k < 16; ++k) { sA[k] = __builtin_amdgcn_exp2f(sA[k]); sB[k] = __builtin_amdgcn_exp2f(sB[k]); ps = ps + sA[k]; ps = ps + sB[k]; }
            lrun = ps;
            const bf16x8 pA1 = pack_step(sA, 1), pB1 = pack_step(sB, 1);
#pragma unroll
            for (int dh = 0; dh < 2; ++dh) {
#pragma unroll
                for (int d2 = 0; d2 < 2; ++d2) { const int d = 2 * dh + d2; vf[2 * d2] = tr_pair(Vt + va[d] + 16 * 256, Vt + va[d] + 24 * 256); vf[2 * d2 + 1] = tr_pair(Vt + va[d] + 48 * 256, Vt + va[d] + 56 * 256); }
#pragma unroll
                for (int d2 = 0; d2 < 2; ++d2) { const int d = 2 * dh + d2; O[d] = MFMA32(vf[2 * d2], pA1, O[d]); O[d] = MFMA32(vf[2 * d2 + 1], pB1, O[d]); }
            }
        }
    };
    f32x16 s0A, s0B, s1A, s1B;
    asm volatile("s_waitcnt vmcnt(0) lgkmcnt(0)" ::: "memory");
    __builtin_amdgcn_s_barrier(); asm volatile("" ::: "memory");
    if constexpr (KSPLIT) {
        auto qk1 = [&](f32x16& sA, int j) {
            const LAS unsigned char* Kt = kslot(j) + hw * 8192;
            const int dt = hp.qc - (hp.t0 + j);
            bf16x8 kf[4];
#pragma unroll
            for (int ks = 0; ks < 4; ++ks) kf[ks] = *(const LAS bf16x8*)(Kt + ka[ks]);
            if (dt >= 3) {
                sA = MFMA32(kf[0], qf[0], cb);
            } else {
                const int base = 192 - 64 * dt - qq + 32 * hw;
#pragma unroll
                for (int i = 0; i < 16; ++i) sA[i] = tbl[base + crow(i, hh)] - mrun;
                sA = MFMA32(kf[0], qf[0], sA);
            }
#pragma unroll
            for (int ks = 1; ks < 4; ++ks) sA = MFMA32(kf[ks], qf[ks], sA);
        };
        auto step1 = [&](int i, f32x16& sA, f32x16& nA) {
            if (i + 2 < nmax) asm volatile("s_waitcnt vmcnt(4) lgkmcnt(0)" ::: "memory"); else asm volatile("s_waitcnt vmcnt(0) lgkmcnt(0)" ::: "memory");
            __builtin_amdgcn_s_barrier(); asm volatile("" ::: "memory");
            if (i + 3 < nmax) { dma_k(i + 3); dma_v(i + 3); }
            if (i < n) {
                qk1(nA, i + 1);
                const LAS unsigned char* Vt = vslot(i) + hw * 8192;
                float mx0 = max3f(sA[0], sA[1], sA[2]), mx1 = max3f(sA[3], sA[4], sA[5]);
#pragma unroll
                for (int k = 6; k < 14; k += 4) { mx0 = max3f(mx0, sA[k], sA[k + 1]); mx1 = max3f(mx1, sA[k + 2], sA[k + 3]); }
                float mx = max3f(mx0, mx1, sA[14]); mx = max3f(mx, sA[15], sA[15]); mx = xor32_max(mx);
                if (__any(mx > 6.0f)) {
                    const float dm = fmaxf(mx, 0.f), alpha = __builtin_amdgcn_exp2f(-dm);
                    mrun += dm; lrun *= alpha;
#pragma unroll
                    for (int k = 0; k < 16; ++k) { sA[k] -= dm; nA[k] -= dm; cb[k] -= dm; }
#pragma unroll
                    for (int d = 0; d < 4; ++d)
#pragma unroll
                        for (int k = 0; k < 16; ++k) O[d][k] *= alpha;
                }
                float ps = 0.f;
#pragma unroll
                for (int k = 0; k < 8; ++k) { sA[k] = __builtin_amdgcn_exp2f(sA[k]); ps += sA[k]; }
                const bf16x8 qA0 = pack_step(sA, 0);
                bf16x8 vf[4];
#pragma unroll
                for (int d = 0; d < 4; ++d) vf[d] = tr_pair(Vt + va[d], Vt + va[d] + 8 * 256);
#pragma unroll
                for (int d = 0; d < 4; ++d) O[d] = MFMA32(vf[d], qA0, O[d]);
#pragma unroll
                for (int k = 8; k < 16; ++k) { sA[k] = __builtin_amdgcn_exp2f(sA[k]); ps += sA[k]; }
                lrun += ps;
                const bf16x8 qA1 = pack_step(sA, 1);
#pragma unroll
                for (int d = 0; d < 4; ++d) vf[d] = tr_pair(Vt + va[d] + 16 * 256, Vt + va[d] + 24 * 256);
#pragma unroll
                for (int d = 0; d < 4; ++d) O[d] = MFMA32(vf[d], qA1, O[d]);
            }
        };
        qk1(s0A, 0);
#pragma unroll 1
        for (int it = 0; it < niter; it += 2) { step1(it, s0A, s1A); step1(it + 1, s1A, s0A); }
    } else {
    qk(s0A, s0B, 0);
#pragma unroll 1
    for (int it = 0; it < niter; it += 2) {
        step(it, s0A, s0B, s1A, s1B);
        step(it + 1, s1A, s1B, s0A, s0B);
    }
    }
    asm volatile("s_waitcnt vmcnt(0)" ::: "memory");
    LDS_BARRIER();
    LAS float* X = (LAS float*)lds;
    if (merge) {
        if (hw == 1) {
            LAS float* xp = X + wl * 66 * 64 + lane;
#pragma unroll
            for (int d = 0; d < 4; ++d)
#pragma unroll
                for (int i = 0; i < 16; ++i) xp[(16 * d + i) * 64] = O[d][i];
            xp[64 * 64] = mrun; xp[65 * 64] = lrun;
        }
        LDS_BARRIER();
        if (hw == 0) {
            const LAS float* xp = X + wl * 66 * 64 + lane;
            const float m2 = xp[64 * 64], l2 = xp[65 * 64];
            const float mn = fmaxf(mrun, m2), f1 = __builtin_amdgcn_exp2f(mrun - mn), f2 = __builtin_amdgcn_exp2f(m2 - mn);
#pragma unroll
            for (int d = 0; d < 4; ++d)
#pragma unroll
                for (int i = 0; i < 16; ++i) O[d][i] = O[d][i] * f1 + xp[(16 * d + i) * 64] * f2;
            lrun = lrun * f1 + l2 * f2; mrun = mn;
        }
        LDS_BARRIER();
    }
    const float ltot = xor32_sum(lrun);
    const float linv = 1.0f / ltot;
    LAS float* xb = (LAS float*)(lds + hw * AT_HALFB) + qh * 64 * 64 + lane;
    if (cbr == 1) {
#pragma unroll
        for (int d = 0; d < 4; ++d)
#pragma unroll
            for (int i = 0; i < 16; ++i) xb[(16 * d + i) * 64] = O[d][i] * linv;
    }
    LDS_BARRIER();
    if (cbr == 0 && !(merge && hw == 1)) {
        float ssq = 0.f;
#pragma unroll
        for (int d = 0; d < 4; ++d)
#pragma unroll
            for (int i = 0; i < 16; ++i) { const float v = O[d][i] * linv - lam * xb[(16 * d + i) * 64]; O[d][i] = v; ssq += v * v; }
        ssq = xor32_sum(ssq);
        const float rs = __builtin_amdgcn_rsqf(ssq * (1.0f / 128.0f) + EPS) * onem;
        bf16_t* op = HG + (size_t)(hp.qrow0 + 32 * qh + r) * D + hp.h * 128;
#pragma unroll
        for (int d = 0; d < 4; ++d)
#pragma unroll
            for (int g = 0; g < 4; ++g) { const int dv = 32 * d + 8 * g + 4 * hh; const f32x4 g4 = *(const LAS f32x4*)(hgain + dv);
                u32x2 o; o.x = pk2(O[d][4 * g] * rs * g4.x, O[d][4 * g + 1] * rs * g4.y); o.y = pk2(O[d][4 * g + 2] * rs * g4.z, O[d][4 * g + 3] * rs * g4.w);
                *(u32x2*)(op + dv) = o; }
    }
    LDS_BARRIER();
}
DI int rel_bucket(int rel) {
    const int n = rel < 0 ? -rel : rel; int b;
    if (n < 8) b = n; else { const int lg = 31 - __builtin_clz((unsigned)(n * n)); b = 2 + lg; if (b > 15) b = 15; }
    return (rel > 0 ? 16 : 0) + b;
}
DI void attn_phase(ArgsRef a, LAS unsigned char* lds, int j  , int vcu, int G, int tid, int wave, int lane) {
    LAS float* tbl = (LAS float*)(lds + AT_TBL);
    for (int i = tid; i < 8 * 256; i += 512) { const int h = i >> 8, rel = (i & 255) - 192; tbl[i] = a.in[I_RELB][rel_bucket(rel) * 8 + h] * LOG2E; }
    LAS float* misc = (LAS float*)(lds + AT_MISC);
    if (wave == 0) {
        const float* lp = a.in[I_LAM] + (size_t)j * 256;
        const float s1 = wave_sum(lp[lane] * lp[64 + lane]), s2 = wave_sum(lp[128 + lane] * lp[192 + lane]);
        if (lane == 0) misc[0] = expf(s1) - expf(s2);
    }
    LDS_BARRIER();
    const int l = 2 + j;
    const float lam_init = 0.8f - 0.6f * expf(-0.3f * (float)l);
    const float lam = misc[0] + lam_init, onem = 1.0f - lam_init;
    { LAS float* hgl = (LAS float*)(lds + AT_MISC + 64); if (tid < 128) hgl[tid] = a.in[I_AHG][(size_t)j * 128 + tid]; }
    const LAS float* hgain = (const LAS float*)(lds + AT_MISC + 64);
    const bf16_t* Q = (const bf16_t*)(a.ws + WS_PROJ);
    const bf16_t* KP = (const bf16_t*)(a.ws + WS_KP); const bf16_t* VP = (const bf16_t*)(a.ws + WS_VP);
    const bf16_t* KS = (const bf16_t*)(a.ws + WS_KS); const bf16_t* VS = (const bf16_t*)(a.ws + WS_VS);
    const int hw = wave >> 2;
#pragma unroll 1
    for (int v = vcu; v < 256; v += G) {
        const int xg = v >> 5, jj = v & 31;
        {
            const int b = v >> 3;
            AttnHalf hp; hp.Q = Q; hp.K = KS + (size_t)b * KSROWS * D; hp.V = VS + (size_t)b * KSROWS * D; hp.qrow0 = MP + b * 64; hp.h = v & 7; hp.qc = 64;
            hp.t0 = 0; hp.t1 = 65;
            for (int rep = 0; rep < REP_N(11); ++rep)
            attn_workunit<true, true>(a, lds, hp, 65, 65, true, lam, onem, hgain, tid, wave, lane);
        }
#pragma unroll 1
        for (int h = 0; h < 8; ++h) {
            const int c = (h & 1) ? 31 - jj : jj, qc = 2 * c + hw;
            AttnHalf hp; hp.Q = Q; hp.K = KP + (size_t)xg * 4096 * D; hp.V = VP + (size_t)xg * 4096 * D; hp.qrow0 = xg * 4096 + qc * 64; hp.h = h; hp.qc = qc;
            hp.t0 = 0; hp.t1 = qc + 1;
            for (int rep = 0; rep < REP_N(12); ++rep)
            attn_workunit<true>(a, lds, hp, 2 * c + 2, 2 * c + 2, false, lam, onem, hgain, tid, wave, lane);
        }
    }
}

constexpr int N_PHASES = 35;
__host__ __device__ constexpr bool phase_exists(int p) { return p == 0 || (((p - 1) % 9) < 7) || ((p - 1) / 9 == 1); }

__global__ void __launch_bounds__(NWAVES * 64, 2) yoco_fwd(Args args) {
    extern __shared__ __attribute__((aligned(16))) unsigned char lds_raw[];
    LAS unsigned char* lds = (LAS unsigned char*)lds_raw;
    volatile LAS unsigned* MISC = (volatile LAS unsigned*)(lds + MISC_OFF);
#define PH_IDS const int tid = opaque_tid(wv0), lane = tid & 63, wave = __builtin_amdgcn_readfirstlane(tid >> 6)
    const int G = gridDim.x; const int bx = blockIdx.x; const int vcu = (G % 8 == 0) ? (bx % 8) * (G / 8) + bx / 8 : bx;
    unsigned char* ws = args.ws;
    const int wv0 = __builtin_amdgcn_readfirstlane((int)threadIdx.x >> 6);
    if (threadIdx.x < 32) MISC[threadIdx.x] = 0u;
    __syncthreads();
    XcdBarrier bar; bar.bar = (unsigned*)(ws + WS_CTL) + 4096; bar.x = 0; bar.w0 = wv0; bar.st = nullptr;
#if MK_SINGLE_LAUNCH
    bar = xcd_barrier_post((unsigned*)(ws + WS_CTL) + 4096, wv0, MISC + 8);
#endif
    const int lo = args.ph_lo, hi = args.ph_hi;
#define IN(k) (lo <= (k) && (k) < hi)
#define REP_BEGIN(k) for (int rep = 0; rep < REP_N(k); ++rep) { if (rep) xcd_barrier(bar);
#define REP_END }
#if MK_SINGLE_LAUNCH
#define SEAM(k) do { if ((k) + 1 < hi) xcd_barrier(bar); } while (0)
#else
#define SEAM(k) do { } while (0)
#endif
#define PH_PTRS ArgsRef A = kargs(); unsigned char* ws = A.ws; float* X = A.out + OFF_Y; const float* mod = (const float*)(ws + WS_MOD); bf16_t* XB = (bf16_t*)(ws + WS_XB); \
    bf16_t* XM = (bf16_t*)(ws + WS_XM); bf16_t* HGb = (bf16_t*)(ws + WS_HG); bf16_t* PROJ = (bf16_t*)(ws + WS_PROJ); bf16_t* HID = (bf16_t*)(ws + WS_HID); \
    (void)X; (void)mod; (void)XB; (void)XM; (void)HGb; (void)PROJ; (void)HID
#define PH_LPTRS PH_PTRS; const float* modl = mod + (size_t)l * 40 * 6144; \
    const void* xP = l == 0 ? (const void*)A.in[I_XP] : (const void*)XB; const void* xS = l == 0 ? (const void*)A.in[I_XS] : (const void*)(XB + (size_t)MP * D); (void)modl; (void)xP; (void)xS

    if (PH_ON(0) && IN(0)) {
        PH_PTRS;
        PH_IDS;
        REP_BEGIN(0)
        prologue_weights(A, lds, vcu * NWAVES + wave, G * NWAVES, wave, lane, 0);
        __syncthreads();
        prologue_adaln(A, lds, vcu, G, tid, wave, lane);
        REP_END
        SEAM(0);
    }
#pragma unroll 1
    for (int l = 0; l < 4; ++l) {
        const int pb = 1 + 9 * l;
        if (PH_ON(1) && IN(pb + 0) && l != 2) {
            PH_LPTRS;
            PH_IDS;
            REP_BEGIN(1)
            if (l < 2) norm_phase<true, true>(A, lds, xP, xS, l != 0, A.in[I_NORMG] + (size_t)(l * 2 + 0) * D, modl, 0, 1024, A.in[I_WIN] + (size_t)l * 1024 * MIN + NPROJ, A.in[I_BG] + l * 16, vcu, G, tid, wave, lane);
            else norm_phase<true, false>(A, lds, xP, xS, 1, A.in[I_NORMG] + (size_t)(l * 2 + 0) * D, modl, 0, 1024, nullptr, nullptr, vcu, G, tid, wave, lane);
            REP_END
            SEAM(pb + 0);
        }
        if (IN(pb + 1) && l != 2) {
            PH_LPTRS;
            REP_BEGIN(2)
            if (!PH_ON(2)) {} else if (l < 2) {
                pg8::Gemm g{XM, (const bf16_t*)(ws + WS_WIN) + (size_t)l * NPROJ * 1024, M, NPROJ, 1024}; pg8::StaticOrder S; S.init(M, NPROJ, G, bx);
                EpiProj E{PROJ};
                pg8::gemm_phase<EpiProj, pg8::StaticOrder, true, true>(lds, g, S, E, wv0);
                {
                    const int nfull = ((M / 256) * (NPROJ / 256)) % G;
                    if (bx >= nfull) prologue_cache(A, (bx - nfull) * 512 + opaque_tid(wv0), (G - nfull) * 512, l == 0 ? 0L : CACHE_T0, l == 0 ? CACHE_T0 : CACHE_T1);
                }
            } else {
                pg8::Gemm g{XM, (const bf16_t*)(ws + WS_WQ) + (size_t)(l - 2) * 1048576, MP, 1024, 1024}; pg8::StaticOrder S; S.init(MP, 1024, G, bx);
                EpiQ E{PROJ, A.in[I_QG] + (l - 2) * 64, 0.125f * LOG2E};
                pg8::gemm_phase<EpiQ, pg8::StaticOrder, true, true>(lds, g, S, E, wv0);
                const int tid = opaque_tid(wv0), wave = __builtin_amdgcn_readfirstlane(tid >> 6), lane = tid & 63;
                EpiQSmall Es{PROJ + (size_t)MP * D, A.in[I_QG] + (l - 2) * 64, 0.125f * LOG2E, (LAS float*)(lds + 2 * GS_BUF)};
                gemm_small<EpiQSmall, true>(lds, XM + (size_t)MP * D, (const bf16_t*)(ws + WS_WQ) + (size_t)(l - 2) * 1048576, 32, 8, 1024, Es, vcu, G, tid, wave, lane);
            }
            REP_END
            SEAM(pb + 1);
        }
        if (IN(pb + 2)) {
            PH_LPTRS;
            PH_IDS;
            if (l < 2) { if (PH_ON(3)) for (int rep = 0; rep < REP_N(3); ++rep) { if (rep) xcd_barrier(bar);
                if ((ML3_MASK >> l) & 1) {
                    mlA_phase(A, lds, vcu, G, tid, wave, lane); xcd_barrier(bar);
                    mlB_phase(A, l, vcu, G, tid); xcd_barrier(bar);
                    mlC_phase(A, lds, l, vcu, G, tid, wave, lane);
                } else mlstm_phase(A, lds, l, vcu, G, tid, wave, lane); } }
            else if (PH_ON(4)) for (int rep = 0; rep < REP_N(4); ++rep) { if (rep) xcd_barrier(bar); attn_phase(A, lds, l - 2, vcu, G, tid, wave, lane); }
            SEAM(pb + 2);
        }
        if (PH_ON(5) && IN(pb + 3)) {
            PH_LPTRS;
            PH_IDS;
            REP_BEGIN(5)
            {
                pg8::Gemm g{HGb, (const bf16_t*)(ws + WS_WMO) + (size_t)l * 1048576, MP, 1024, 1024}; pg8::StaticOrder S; S.init(MP, 1024, G, bx);
                EpiRes E{xP, xS, (REP_N(5) == 2 && rep == 0) ? (void*)(ws + WS_HID) : (void*)XB, modl + 2048, l != 0, 1};
                pg8::gemm_phase<EpiRes, pg8::StaticOrder, true, true>(lds, g, S, E, wv0);
            }
            {
                bf16_t* Xs = ((REP_N(5) == 2 && rep == 0) ? (bf16_t*)(ws + WS_HID) : XB) + (size_t)MP * D;
                EpiResSmall E{xS, Xs, modl + 2048, l != 0, 1};
                gemm_small<EpiResSmall>(lds, HGb + (size_t)MP * D, (const bf16_t*)(ws + WS_WMO) + (size_t)l * 1048576, 32, 8, 1024, E, vcu, G, tid, wave, lane);
            }
            REP_END
            SEAM(pb + 3);
        }
        if (PH_ON(6) && IN(pb + 4)) {
            PH_LPTRS;
            PH_IDS;
            REP_BEGIN(6)
            norm_phase<true, false>(A, lds, XB, XB + (size_t)MP * D, 1, A.in[I_NORMG] + (size_t)(l * 2 + 1) * D, modl, 3072, 4096, nullptr, nullptr, vcu, G, tid, wave, lane);
            REP_END
            SEAM(pb + 4);
        }
        if (PH_ON(7) && IN(pb + 5)) {
            PH_LPTRS;
            pg8::Gemm g{XM, (const bf16_t*)(ws + WS_WGU) + (size_t)l * 5632 * 1024, M, 5632, 1024}; pg8::StaticOrder S; S.init(M, 5632, G, bx);
            REP_BEGIN(7)
            EpiSwiglu E{HID};
            pg8::gemm_phase<EpiSwiglu, pg8::StaticOrder, true, true>(lds, g, S, E, wv0);
            REP_END
            if (l < 2) {
                const int nfull = ((M / 256) * (5632 / 256)) % G;
                if (bx >= nfull) prologue_cache(A, (bx - nfull) * 512 + opaque_tid(wv0), (G - nfull) * 512, l == 0 ? CACHE_T1 : CACHE_T2, l == 0 ? CACHE_T2 : CACHE_T3);
            }
            SEAM(pb + 5);
        }
        if (PH_ON(8) && IN(pb + 6)) {
            PH_LPTRS;
            PH_IDS;
            REP_BEGIN(8)
            {
                pg8::Gemm g{HID, (const bf16_t*)(ws + WS_WD) + (size_t)l * 1024 * DFF, MP, 1024, DFF}; pg8::StaticOrder S; S.init(MP, 1024, G, bx);
                EpiRes E{XB, XB + (size_t)MP * D, (REP_N(8) == 2 && rep == 0) ? (void*)(ws + WS_PROJ) : (l == 3 ? (void*)X : (void*)XB), modl + 5120, 1, (REP_N(8) == 2 && rep == 0) ? 1 : (l != 3)};
                pg8::gemm_phase<EpiRes, pg8::StaticOrder, true, true>(lds, g, S, E, wv0);
            }
            {
                const int obf = (REP_N(8) == 2 && rep == 0) ? 1 : (l != 3);
                void* Xo = (REP_N(8) == 2 && rep == 0) ? (void*)((bf16_t*)(ws + WS_PROJ) + (size_t)MP * D) : (l == 3 ? (void*)(X + (size_t)MP * D) : (void*)(XB + (size_t)MP * D));
                EpiResSmall E{XB + (size_t)MP * D, Xo, modl + 5120, 1, obf};
                gemm_small<EpiResSmall>(lds, HID + (size_t)MP * DFF, (const bf16_t*)(ws + WS_WD) + (size_t)l * 1024 * DFF, 32, 8, DFF, E, vcu, G, tid, wave, lane);
            }
            REP_END
            SEAM(pb + 6);
        }
        if (l == 1) {
            if (PH_ON(9) && IN(pb + 7)) {
                PH_LPTRS;
                PH_IDS;
                REP_BEGIN(9)
                norm_dual_phase(A, XB, XM, (bf16_t*)(ws + WS_HID), A.in[I_KVG], A.in[I_NORMG] + (size_t)(2 * 2 + 0) * D, mod + (size_t)2 * 40 * 6144, 0, 1024, vcu, G, wave, lane);
                REP_END
                SEAM(pb + 7);
            }
            if (PH_ON(10) && IN(pb + 8)) {
                PH_LPTRS;
                pg8::Gemm g{XM, (const bf16_t*)(ws + WS_WKV), MP, 2048, 1024}; pg8::StaticOrder S; S.init(MP, 2048, G, bx);
                REP_BEGIN(10)
                EpiKV E{A.out, ws, A.in[I_KG]};
                pg8::gemm_phase<EpiKV, pg8::StaticOrder, true, true>(lds, g, S, E, wv0);
                REP_END
                {
                    pg8::Gemm gq{(const bf16_t*)(ws + WS_HID), (const bf16_t*)(ws + WS_WQ), MP, 1024, 1024}; pg8::StaticOrder Sq; Sq.init(MP, 1024, G, bx);
                    EpiQ Eq{PROJ, A.in[I_QG], 0.125f * LOG2E};
                    pg8::gemm_phase<EpiQ, pg8::StaticOrder, true, true>(lds, gq, Sq, Eq, wv0);
                }
                {
                    const int tid = opaque_tid(wv0), wave = __builtin_amdgcn_readfirstlane(tid >> 6), lane = tid & 63;
                    LAS float* Xn = (LAS float*)(lds + 2 * GS_BUF);
                    EpiKVSmall<true> Ek{A.out + OFF_SK, (bf16_t*)(ws + WS_KS), A.in[I_KG], Xn};
                    gemm_small<EpiKVSmall<true>, true>(lds, XM + (size_t)MP * D, (const bf16_t*)(ws + WS_WKV), 32, 8, 1024, Ek, vcu, G, tid, wave, lane);
                    EpiKVSmall<false> Ev{A.out + OFF_SV, (bf16_t*)(ws + WS_VS), nullptr, Xn};
                    gemm_small<EpiKVSmall<false>, false>(lds, XM + (size_t)MP * D, (const bf16_t*)(ws + WS_WKV) + 1048576, 32, 8, 1024, Ev, vcu, G, tid, wave, lane);
                    EpiQSmall Es{PROJ + (size_t)MP * D, A.in[I_QG], 0.125f * LOG2E, Xn};
                    gemm_small<EpiQSmall, true>(lds, (const bf16_t*)(ws + WS_HID) + (size_t)MP * D, (const bf16_t*)(ws + WS_WQ), 32, 8, 1024, Es, vcu, G, tid, wave, lane);
                }
                SEAM(pb + 8);
            }
        }
    }
#undef IN
#undef SEAM
}

extern "C" void kernel_launch(void* const* d_in, const int* in_sizes, int n_in, void* d_out, int out_size, void* d_ws, size_t ws_size, hipStream_t stream) {
    static int grid = 0;
    if (grid == 0) {
        if (n_in != 29 || out_size != OUT_TOTAL || ws_size < WS_END) { fprintf(stderr, "kernel_launch: unexpected shapes: n_in %d out %d ws %zu\n", n_in, out_size, ws_size); grid = -1; return; }
        int dev = 0, cus = 0, per_cu = 0;
        if (hipGetDevice(&dev) != hipSuccess || hipDeviceGetAttribute(&cus, hipDeviceAttributeMultiprocessorCount, dev) != hipSuccess) { grid = -1; return; }
        if (hipFuncSetAttribute((const void*)yoco_fwd, hipFuncAttributeMaxDynamicSharedMemorySize, LDS_BYTES) != hipSuccess) { fprintf(stderr, "kernel_launch: hipFuncSetAttribute failed\n"); grid = -1; return; }
        if (hipOccupancyMaxActiveBlocksPerMultiprocessor(&per_cu, (const void*)yoco_fwd, NWAVES * 64, LDS_BYTES) != hipSuccess || per_cu < 1)
            fprintf(stderr, "kernel_launch: note: occupancy query reports %d workgroups per CU\n", per_cu);
        (void)hipGetLastError();
        grid = cus;
    }
    if (grid < 0) return;
    if (hipMemsetAsync((char*)d_ws + WS_CTL, 0, CTL_ZERO_BYTES, stream) != hipSuccess) { fprintf(stderr, "kernel_launch: memset failed\n"); return; }
    Args a{};
    for (int i = 0; i < 29; ++i) a.in[i] = (const float*)d_in[i];
    a.out = (float*)d_out; a.ws = (unsigned char*)d_ws;
#if MK_SINGLE_LAUNCH
    a.ph_lo = 0; a.ph_hi = N_PHASES;
    hipLaunchKernelGGL(yoco_fwd, dim3(grid), dim3(NWAVES * 64), LDS_BYTES, stream, a);
#else
    for (int p = 0; p < N_PHASES; ++p) {
        if (!phase_exists(p)) continue;
        a.ph_lo = p; a.ph_hi = p + 1;
        hipLaunchKernelGGL(yoco_fwd, dim3(grid), dim3(NWAVES * 64), LDS_BYTES, stream, a);
    }
#endif
    const hipError_t le = hipPeekAtLastError();
    if (le != hipSuccess) fprintf(stderr, "kernel_launch: launch failed: %s\n", hipGetErrorName(le));
}
```

```cpp
#include <hip/hip_runtime.h>
#include <cstdio>
#include <cstdint>

#ifndef PH_MASK
#define PH_MASK 0xFFFF
#endif
#define PH_ON(k) (((PH_MASK) >> (k)) & 1)
#ifndef REP_MASK
#define REP_MASK 0
#endif
#define REP_N(k) ((((REP_MASK) >> (k)) & 1) ? 2 : 1)
#ifndef ML3_MASK
#define ML3_MASK 0x2
#endif
#ifndef MK_SINGLE_LAUNCH
#define MK_SINGLE_LAUNCH 1
#endif

#define DI __device__ __forceinline__
#define LAS __attribute__((address_space(3)))
#define GAS __attribute__((address_space(1)))

typedef unsigned short bf16_t;
typedef short bf16x8 __attribute__((ext_vector_type(8)));
typedef short v4i16 __attribute__((ext_vector_type(4)));
typedef float f32x2 __attribute__((ext_vector_type(2)));
typedef float f32x4 __attribute__((ext_vector_type(4)));
typedef float f32x16 __attribute__((ext_vector_type(16)));
typedef unsigned u32x2 __attribute__((ext_vector_type(2)));
typedef unsigned u32x4 __attribute__((ext_vector_type(4)));
typedef __bf16 bf16x2_t __attribute__((ext_vector_type(2)));

constexpr int D = 1024, MP = 32768, MS = 2048, M = MP + MS, NSEQ = 40;
constexpr int DFF = 2816, MIN = 3088, NPROJ = 3072;
constexpr int KSROWS = 4160;
constexpr float EPS = 1e-6f;
constexpr float LOG2E = 1.4426950408889634f;

constexpr int OFF_Y = 0, OFF_PC = 35651584, OFF_PN = 36700160, OFF_PM = 36708352, OFF_PK = 36708480, OFF_PV = 70262912,
              OFF_SC = 103817344, OFF_SN = 108011648, OFF_SM = 108044416, OFF_SK = 108044928, OFF_SV = 110142080, OUT_TOTAL = 112239232;

constexpr size_t MiB = 1u << 20;
constexpr size_t WS_CTL = 0, CTL_ZERO_BYTES = 1 * MiB;
constexpr size_t WS_MOD = 1 * MiB;
constexpr size_t WS_WIN = 5 * MiB;
constexpr size_t WS_WMO = 17 * MiB;
constexpr size_t WS_WQ = 25 * MiB;
constexpr size_t WS_WKV = 29 * MiB;
constexpr size_t WS_WGU = 33 * MiB;
constexpr size_t WS_WD = 77 * MiB;
constexpr size_t WS_GATES = 99 * MiB;
constexpr size_t WS_XM = 102 * MiB;
constexpr size_t WS_HG = 170 * MiB;
constexpr size_t WS_PROJ = 238 * MiB;
constexpr size_t WS_HID = 442 * MiB;
constexpr size_t WS_KP = 629 * MiB;
constexpr size_t WS_VP = 693 * MiB;
constexpr size_t WS_KS = 757 * MiB;
constexpr size_t WS_VS = 1017 * MiB;
constexpr size_t WS_XB = 1277 * MiB;
constexpr size_t WS_CL = 1345 * MiB;
constexpr size_t WS_CP = 1488 * MiB;
constexpr size_t WS_NL = 1616 * MiB;
constexpr size_t WS_TAB = 1618 * MiB;
constexpr size_t WS_NPREV = 1623 * MiB;
constexpr size_t WS_MPREV = 1625 * MiB;
constexpr size_t WS_END = 1626 * MiB;

constexpr int LDS_BYTES = 163840;
constexpr int MISC_OFF = 163840 - 256;
constexpr int NWAVES = 8;

DI unsigned pk2(float lo, float hi) { f32x2 v = {lo, hi}; bf16x2_t b = __builtin_convertvector(v, bf16x2_t); return __builtin_bit_cast(unsigned, b); }
DI float bf_lo(unsigned w) { return __uint_as_float(w << 16); }
DI float bf_hi(unsigned w) { return __uint_as_float(w & 0xffff0000u); }
DI u32x4 pack8f(const f32x4 a, const f32x4 b) { u32x4 r; r.x = pk2(a.x, a.y); r.y = pk2(a.z, a.w); r.z = pk2(b.x, b.y); r.w = pk2(b.z, b.w); return r; }
DI bf16x8 pack_step(const f32x16& x, int s) {
    u32x4 p; p.x = pk2(x[8 * s + 0], x[8 * s + 1]); p.y = pk2(x[8 * s + 2], x[8 * s + 3]); p.z = pk2(x[8 * s + 4], x[8 * s + 5]); p.w = pk2(x[8 * s + 6], x[8 * s + 7]);
    return __builtin_bit_cast(bf16x8, p);
}
DI int opaque_tid(int wv0) { int t; asm volatile("v_mbcnt_lo_u32_b32 %0, -1, 0\n\tv_mbcnt_hi_u32_b32 %0, -1, %0" : "=&v"(t)); t |= wv0 << 6; asm volatile("" : "+v"(t)); return t; }
DI float xor32_sum(float v) { const unsigned u = __float_as_uint(v); auto rr = __builtin_amdgcn_permlane32_swap(u, u, false, false); return __uint_as_float(rr[0]) + __uint_as_float(rr[1]); }
DI float xor32_max(float v) { const unsigned u = __float_as_uint(v); auto rr = __builtin_amdgcn_permlane32_swap(u, u, false, false); return fmaxf(__uint_as_float(rr[0]), __uint_as_float(rr[1])); }
DI float max3f(float a, float b, float c) { float r; asm("v_max3_f32 %0, %1, %2, %3" : "=v"(r) : "v"(a), "v"(b), "v"(c)); return r; }
DI int crow(int reg, int hh) { return (reg & 3) + 8 * (reg >> 2) + 4 * hh; }
DI float wave_sum(float v) {
#pragma unroll
    for (int o = 1; o < 64; o <<= 1) v += __shfl_xor(v, o);
    return v;
}
DI bf16x8 tr_pair(LAS const unsigned char* p0, LAS const unsigned char* p1) {
    v4i16 lo = __builtin_amdgcn_ds_read_tr16_b64_v4i16((LAS v4i16*)p0);
    v4i16 hi = __builtin_amdgcn_ds_read_tr16_b64_v4i16((LAS v4i16*)p1);
    return __builtin_shufflevector(lo, hi, 0, 1, 2, 3, 4, 5, 6, 7);
}
#define MFMA32(a, b, c) __builtin_amdgcn_mfma_f32_32x32x16_bf16((a), (b), (c), 0, 0, 0)
#define WG_BARRIER() do { asm volatile("s_waitcnt vmcnt(0) lgkmcnt(0)" ::: "memory"); __builtin_amdgcn_s_barrier(); asm volatile("" ::: "memory"); } while (0)
#define LDS_BARRIER() do { asm volatile("s_waitcnt lgkmcnt(0)" ::: "memory"); __builtin_amdgcn_s_barrier(); asm volatile("" ::: "memory"); } while (0)

namespace pg8 {
#define PG8_LAS __attribute__((address_space(3)))
constexpr int BM = 256, BK = 64, HALF = 128, HTB = HALF * BK * 2, STAGE_BYTES = 8 * HTB, NXCD = 8, WGM = 8;
__host__ __device__ __forceinline__ int lds_byte(int r, int c) { const int st = (r >> 4) * 2 + (c >> 5), rr = r & 15, cc = c & 31, ob = rr * 64 + cc * 2; return st * 1024 + (ob ^ (((ob >> 9) & 1) << 5)); }
__host__ __device__ __forceinline__ void stage_rc(int b, int& R, int& C) { const int st = b / 1024, sb = b % 1024, swz = sb ^ (((sb >> 9) & 1) << 5); R = (st >> 1) * 16 + swz / 64; C = (st & 1) * 32 + (swz % 64) / 2; }
__host__ __device__ __forceinline__ int perm32(int rho) { const int n = rho >> 4, i = rho & 15; return 8 * (i >> 2) + 4 * n + (i & 3); }
struct Unit { int pm, pn; };
struct Gemm { const bf16_t* A; const bf16_t* Bt; int M, N, K; };
struct StaticOrder {
    int nM, nN, nwg, G, c;
    __host__ __device__ void init(int M_, int N_, int G_, int c_) { nM = M_ / BM; nN = N_ / BM; nwg = nM * nN; G = G_; c = c_; }
    __host__ __device__ bool next(int i, Unit& u) const {
        const long L = (long)i * G + c; if (L >= nwg) return false;
        int wgid = (int)L; { const int q = nwg / NXCD, r = nwg % NXCD, xcd = wgid % NXCD, off = wgid / NXCD; wgid = (xcd < r ? xcd * (q + 1) : r * (q + 1) + (xcd - r) * q) + off; }
        const int nig = WGM * nN, gid = wgid / nig, fm = gid * WGM, gsz = (nM - fm) < WGM ? (nM - fm) : WGM;
        u.pm = fm + ((wgid % nig) % gsz); u.pn = (wgid % nig) / gsz; return true;
    }
    __device__ __forceinline__ void a_ready(const Unit&) const {}
    __device__ __forceinline__ void done(const Unit&) const {}
};

template <class Epi, class Sched, bool ALIGN_EPI = false, bool SP2 = false>
__device__ __forceinline__ void gemm_phase(PG8_LAS unsigned char* lds, const Gemm g, const Sched& S, const Epi& E, int wv0) {
    const int tid = opaque_tid(wv0), wid = __builtin_amdgcn_readfirstlane(tid >> 6), lane = tid & 63, wr = wid >> 2, wc = wid & 3, fr = lane & 15, fq = lane >> 4;
    const int K = g.K, nt = K / BK;
    unsigned voffA[2], voffB[2];
#pragma unroll
    for (int i = 0; i < 2; ++i) { int R, C; stage_rc(tid * 16 + i * 8192, R, C); const int Rb = Epi::PERM ? ((R & ~31) + perm32(R & 31)) : R;
        voffA[i] = (unsigned)(R * K + C) * 2u; voffB[i] = (unsigned)(Rb * K + C) * 2u; }
    const size_t kstep = (size_t)(BK * 2);
    const size_t hstep = (size_t)HALF * K * 2;
    const size_t tstep = 2 * hstep;
    const unsigned ldsw = (unsigned)wid * 1024u;
    const int aoff = lds_byte(wr * 64 + fr, fq * 8), boff = lds_byte(wc * 32 + fr, fq * 8);
#define PG8_SA(b, h) (((b) * 2 + (h)) * HTB)
#define PG8_SB(b, h) ((4 + (b) * 2 + (h)) * HTB)
#define PG8_STAGE(bufoff, gbase, voff) do { _Pragma("unroll") for (int _i = 0; _i < 2; ++_i) \
        __builtin_amdgcn_global_load_lds((const unsigned*)((const char*)(gbase) + (voff)[_i]), (PG8_LAS unsigned*)(lds + (bufoff) + ldsw + _i * 8192), 16, 0, 0); } while (0)
#define PG8_LDA(dst, b, h) do { _Pragma("unroll") for (int m = 0; m < 4; ++m) _Pragma("unroll") for (int k = 0; k < 2; ++k) dst[m][k] = *(const PG8_LAS bf16x8*)(lds + PG8_SA(b, h) + aoff + m * 2048 + k * 1024); } while (0)
#define PG8_LDB(dst, b, h) do { _Pragma("unroll") for (int n = 0; n < 2; ++n) _Pragma("unroll") for (int k = 0; k < 2; ++k) dst[n][k] = *(const PG8_LAS bf16x8*)(lds + PG8_SB(b, h) + boff + n * 2048 + k * 1024); } while (0)
#define PG8_MMA(ai, bj, At, Bt) do { __builtin_amdgcn_s_setprio(1); _Pragma("unroll") for (int m = 0; m < 4; ++m) _Pragma("unroll") for (int n = 0; n < 2; ++n) _Pragma("unroll") for (int k = 0; k < 2; ++k) \
        acc[ai][bj][m][n] = __builtin_amdgcn_mfma_f32_16x16x32_bf16(Bt[n][k], At[m][k], acc[ai][bj][m][n], 0, 0, 0); __builtin_amdgcn_s_setprio(0); } while (0)
#define PG8_WAIT_V(n) asm volatile("s_waitcnt vmcnt(" #n ")" ::: "memory")
#define PG8_WAIT_L(n) asm volatile("s_waitcnt lgkmcnt(" #n ")" ::: "memory")
#define PG8_BAR __builtin_amdgcn_s_barrier()
#define PG8_SCHED __builtin_amdgcn_sched_barrier(0)
    Unit cur, nxt; int ui = 0;
    if (!S.next(0, cur)) return;
    f32x4 acc[2][2][4][2];
#pragma unroll
    for (int a = 0; a < 2; ++a)
#pragma unroll
        for (int b = 0; b < 2; ++b)
#pragma unroll
            for (int m = 0; m < 4; ++m)
#pragma unroll
                for (int n = 0; n < 2; ++n) acc[a][b][m][n] = (f32x4){0.f, 0.f, 0.f, 0.f};
    bf16x8 At[4][2], B0[2][2], B1[2][2];
    const char* cA = (const char*)g.A + (size_t)cur.pm * tstep; const char* cB = (const char*)g.Bt + (size_t)cur.pn * tstep;
    S.a_ready(cur);
    if constexpr (SP2) {
        PG8_STAGE(PG8_SB(0, 0), cB, voffB); PG8_STAGE(PG8_SB(0, 1), cB + hstep, voffB); PG8_STAGE(PG8_SA(0, 0), cA, voffA); PG8_STAGE(PG8_SA(0, 1), cA + hstep, voffA);
        if (wr == 1) PG8_BAR;
        PG8_WAIT_V(2); PG8_BAR;
        PG8_STAGE(PG8_SB(1, 0), cB + kstep, voffB); PG8_STAGE(PG8_SA(1, 0), cA + kstep, voffA); PG8_STAGE(PG8_SB(1, 1), cB + hstep + kstep, voffB);
        PG8_WAIT_V(6); PG8_BAR;
    } else {
        PG8_STAGE(PG8_SB(0, 0), cB, voffB); PG8_STAGE(PG8_SA(0, 0), cA, voffA); PG8_STAGE(PG8_SB(0, 1), cB + hstep, voffB); PG8_STAGE(PG8_SA(0, 1), cA + hstep, voffA);
        if (wr == 1) PG8_BAR;
        PG8_WAIT_V(4); PG8_BAR;
        PG8_STAGE(PG8_SB(1, 0), cB + kstep, voffB); PG8_STAGE(PG8_SA(1, 0), cA + kstep, voffA); PG8_STAGE(PG8_SB(1, 1), cB + hstep + kstep, voffB);
        PG8_WAIT_V(6); PG8_BAR;
    }
    for (;;) {
        const bool has_next = S.next(ui + 1, nxt);
        const char* nA = has_next ? (const char*)g.A + (size_t)nxt.pm * tstep : cA; const char* nB = has_next ? (const char*)g.Bt + (size_t)nxt.pn * tstep : cB;
        for (int t = 0; t < nt; t += 2) {
            const bool last = (t == nt - 2);
            const char* a1 = cA + (size_t)(t + 1) * kstep;
            const char* a2 = last ? nA : cA + (size_t)(t + 2) * kstep; const char* b2 = last ? nB : cB + (size_t)(t + 2) * kstep;
            const char* a3 = a2 + kstep; const char* b3 = b2 + kstep;
            if (last && has_next) S.a_ready(nxt);
            if constexpr (SP2) {
            PG8_LDB(B0, 0, 0); PG8_LDB(B1, 0, 1); PG8_SCHED; PG8_LDA(At, 0, 0); PG8_STAGE(PG8_SA(1, 1), a1 + hstep, voffA);
            PG8_WAIT_V(8); PG8_WAIT_L(0); PG8_BAR; PG8_MMA(0, 0, At, B0); PG8_MMA(0, 1, At, B1); PG8_BAR; PG8_SCHED;
            PG8_LDA(At, 0, 1); PG8_STAGE(PG8_SB(0, 0), b2, voffB); PG8_STAGE(PG8_SB(0, 1), b2 + hstep, voffB); PG8_STAGE(PG8_SA(0, 0), a2, voffA);
            PG8_WAIT_V(8); PG8_WAIT_L(0); PG8_BAR; PG8_MMA(1, 0, At, B0); PG8_MMA(1, 1, At, B1); PG8_BAR; PG8_SCHED;
            PG8_LDB(B0, 1, 0); PG8_LDB(B1, 1, 1); PG8_SCHED; PG8_LDA(At, 1, 0); PG8_STAGE(PG8_SA(0, 1), a2 + hstep, voffA);
            PG8_WAIT_V(8); PG8_WAIT_L(0); PG8_BAR; PG8_MMA(0, 0, At, B0); PG8_MMA(0, 1, At, B1); PG8_BAR; PG8_SCHED;
            PG8_LDA(At, 1, 1); PG8_STAGE(PG8_SB(1, 0), b3, voffB); PG8_STAGE(PG8_SB(1, 1), b3 + hstep, voffB); PG8_STAGE(PG8_SA(1, 0), a3, voffA);
            PG8_WAIT_V(8); PG8_WAIT_L(0); PG8_BAR; PG8_MMA(1, 0, At, B0); PG8_MMA(1, 1, At, B1); PG8_BAR; PG8_SCHED;
            } else {
            PG8_LDB(B0, 0, 0); PG8_SCHED; PG8_LDA(At, 0, 0); PG8_STAGE(PG8_SA(1, 1), a1 + hstep, voffA);
            PG8_WAIT_L(8); PG8_BAR; PG8_WAIT_L(0); PG8_MMA(0, 0, At, B0); PG8_BAR; PG8_SCHED;
            PG8_LDB(B1, 0, 1); PG8_STAGE(PG8_SB(0, 0), b2, voffB);
            PG8_BAR; PG8_WAIT_L(0); PG8_MMA(0, 1, At, B1); PG8_BAR;
            PG8_LDA(At, 0, 1); PG8_STAGE(PG8_SA(0, 0), a2, voffA);
            PG8_BAR; PG8_WAIT_L(0); PG8_MMA(1, 0, At, B0); PG8_BAR; PG8_SCHED;
            PG8_STAGE(PG8_SB(0, 1), b2 + hstep, voffB);
            PG8_WAIT_V(6); PG8_BAR; PG8_MMA(1, 1, At, B1); PG8_BAR;
            PG8_LDB(B0, 1, 0); PG8_SCHED; PG8_LDA(At, 1, 0); PG8_STAGE(PG8_SA(0, 1), a2 + hstep, voffA);
            PG8_WAIT_L(8); PG8_BAR; PG8_WAIT_L(0); PG8_MMA(0, 0, At, B0); PG8_BAR; PG8_SCHED;
            PG8_LDB(B1, 1, 1); PG8_STAGE(PG8_SB(1, 0), b3, voffB);
            PG8_BAR; PG8_WAIT_L(0); PG8_MMA(0, 1, At, B1); PG8_BAR;
            PG8_LDA(At, 1, 1); PG8_STAGE(PG8_SA(1, 0), a3, voffA);
            PG8_BAR; PG8_WAIT_L(0); PG8_MMA(1, 0, At, B0); PG8_BAR; PG8_SCHED;
            PG8_STAGE(PG8_SB(1, 1), b3 + hstep, voffB);
            PG8_WAIT_V(6); PG8_BAR; PG8_MMA(1, 1, At, B1); PG8_BAR;
            }
        }
        if constexpr (ALIGN_EPI) { if (wr == 0) PG8_BAR; }
        E(acc, cur, wr, wc, fr, fq); S.done(cur);
        if (!has_next) break;
#pragma unroll
        for (int a = 0; a < 2; ++a)
#pragma unroll
            for (int b = 0; b < 2; ++b)
#pragma unroll
                for (int m = 0; m < 4; ++m)
#pragma unroll
                    for (int n = 0; n < 2; ++n) acc[a][b][m][n] = (f32x4){0.f, 0.f, 0.f, 0.f};
        cur = nxt; cA = nA; cB = nB; ++ui;
        if constexpr (ALIGN_EPI) { if (wr == 1) PG8_BAR; }
    }
    PG8_WAIT_V(0);
    if constexpr (!ALIGN_EPI) { if (wr == 0) PG8_BAR; }
    PG8_BAR;
#undef PG8_SA
#undef PG8_SB
#undef PG8_STAGE
#undef PG8_LDA
#undef PG8_LDB
#undef PG8_MMA
#undef PG8_WAIT_V
#undef PG8_WAIT_L
#undef PG8_BAR
#undef PG8_SCHED
}
}

typedef const f32x4 (&AccRef)[2][2][4][2];

struct EpiProj {
    static constexpr bool PERM = true, AFTER_DRAIN = false;
    bf16_t* O;
    DI void operator()(AccRef acc, const pg8::Unit& u, int wr, int wc, int fr, int fq) const {
        const int row0 = u.pm * 256 + wr * 64 + fr, colt = u.pn * 256, col0 = colt + wc * 32 + 8 * fq;
        const float sc = (colt >= 512 && colt < 1024) ? 0.125f : 1.0f;
#pragma unroll
        for (int ai = 0; ai < 2; ++ai)
#pragma unroll
            for (int m = 0; m < 4; ++m) { bf16_t* rowp = O + (size_t)(row0 + ai * 128 + m * 16) * NPROJ + col0;
#pragma unroll
                for (int bj = 0; bj < 2; ++bj) { *(u32x4*)(rowp + bj * 128) = pack8f(acc[ai][bj][m][0] * sc, acc[ai][bj][m][1] * sc); } }
    }
};
struct EpiSwiglu {
    static constexpr bool PERM = true, AFTER_DRAIN = false;
    bf16_t* H;
    DI void operator()(AccRef acc, const pg8::Unit& u, int wr, int wc, int fr, int fq) const {
        const int row0 = u.pm * 256 + wr * 64 + fr, col0 = u.pn * 128 + wc * 32 + 8 * fq;
#pragma unroll
        for (int ai = 0; ai < 2; ++ai)
#pragma unroll
            for (int m = 0; m < 4; ++m) {
                f32x4 h[2];
#pragma unroll
                for (int n = 0; n < 2; ++n) {
                    const f32x4 g = acc[ai][0][m][n], up = acc[ai][1][m][n];
#pragma unroll
                    for (int e = 0; e < 4; ++e) {
                        const float r = __builtin_amdgcn_rcpf(1.0f + __builtin_amdgcn_exp2f(g[e]));
                        h[n][e] = (g[e] * up[e]) * r; }
                }
                *(u32x4*)(H + (size_t)(row0 + ai * 128 + m * 16) * DFF + col0) = pack8f(h[0], h[1]);
            }
    }
};
DI f32x4 ld4(const void* base, size_t e, int bf) {
    if (bf) { const u32x2 w = *(const u32x2*)((const bf16_t*)base + e); return (f32x4){bf_lo(w.x), bf_hi(w.x), bf_lo(w.y), bf_hi(w.y)}; }
    return *(const f32x4*)((const float*)base + e);
}
DI void st4(void* base, size_t e, int bf, const f32x4 v) {
    if (bf) { u32x2 w; w.x = pk2(v[0], v[1]); w.y = pk2(v[2], v[3]); *(u32x2*)((bf16_t*)base + e) = w; }
    else *(f32x4*)((float*)base + e) = v;
}
struct EpiRes {
    static constexpr bool PERM = true, AFTER_DRAIN = false;
    const void* resP; const void* resS; void* out; const float* gate; int res_bf, out_bf;
    DI void operator()(AccRef acc, const pg8::Unit& u, int wr, int wc, int fr, int fq) const {
        const int col0 = u.pn * 256 + wc * 32 + 8 * fq;
#pragma unroll
        for (int ai = 0; ai < 2; ++ai) {
            const int rowb = u.pm * 256 + ai * 128 + wr * 64;
            const int seq = rowb < MP ? (rowb >> 12) : 8 + ((rowb - MP) >> 6);
            const float* gp = gate + (size_t)seq * 6144 + col0;
            const void* rb = rowb < MP ? resP : resS;
            const size_t re = (size_t)((rowb < MP ? rowb : rowb - MP) + fr) * D + col0, oe = (size_t)(rowb + fr) * D + col0;
            f32x4 gv[2][2];
#pragma unroll
            for (int bj = 0; bj < 2; ++bj)
#pragma unroll
                for (int n = 0; n < 2; ++n) gv[bj][n] = *(const f32x4*)(gp + bj * 128 + n * 4);
#pragma unroll
            for (int m = 0; m < 4; ++m) {
#pragma unroll
                for (int bj = 0; bj < 2; ++bj) {
                    const size_t e1 = re + m * 16 * D + bj * 128, e2 = oe + m * 16 * D + bj * 128;
                    f32x4 r0, r1;
                    if (res_bf) { const u32x4 w = *(const u32x4*)((const bf16_t*)rb + e1);
                        r0 = (f32x4){bf_lo(w.x), bf_hi(w.x), bf_lo(w.y), bf_hi(w.y)}; r1 = (f32x4){bf_lo(w.z), bf_hi(w.z), bf_lo(w.w), bf_hi(w.w)}; }
                    else { r0 = *(const f32x4*)((const float*)rb + e1); r1 = *(const f32x4*)((const float*)rb + e1 + 4); }
                    const f32x4 v0 = r0 + gv[bj][0] * acc[ai][bj][m][0], v1 = r1 + gv[bj][1] * acc[ai][bj][m][1];
                    if (out_bf) *(u32x4*)((bf16_t*)out + e2) = pack8f(v0, v1);
                    else { __builtin_nontemporal_store(v0, (f32x4*)((float*)out + e2)); __builtin_nontemporal_store(v1, (f32x4*)((float*)out + e2 + 4)); }
                }
                asm volatile("" ::: "memory");
            }
        }
    }
};
struct EpiQ {
    static constexpr bool PERM = true, AFTER_DRAIN = false;
    bf16_t* Q; const float* qg; float scale;
    DI void operator()(AccRef acc, const pg8::Unit& u, int wr, int wc, int fr, int fq) const {
        const int row0 = u.pm * 256 + wr * 64 + fr, colg = u.pn * 256 + wc * 64;
        f32x4 g4[2][2];
#pragma unroll
        for (int bj = 0; bj < 2; ++bj)
#pragma unroll
            for (int n = 0; n < 2; ++n) g4[bj][n] = *(const f32x4*)(qg + 32 * bj + 8 * fq + 4 * n);
#pragma unroll
        for (int ai = 0; ai < 2; ++ai)
#pragma unroll
            for (int m = 0; m < 4; ++m) {
                float ss = 0.f;
#pragma unroll
                for (int bj = 0; bj < 2; ++bj)
#pragma unroll
                    for (int n = 0; n < 2; ++n) { const f32x4 v = acc[ai][bj][m][n]; ss += (v[0] * v[0] + v[1] * v[1]) + (v[2] * v[2] + v[3] * v[3]); }
                ss += __shfl_xor(ss, 16); ss = xor32_sum(ss);
                const float rs = __builtin_amdgcn_rsqf(ss * (1.0f / 64.0f) + EPS) * scale;
                bf16_t* rowp = Q + (size_t)(row0 + ai * 128 + m * 16) * D + colg + 8 * fq;
#pragma unroll
                for (int bj = 0; bj < 2; ++bj) *(u32x4*)(rowp + 32 * bj) = pack8f(acc[ai][bj][m][0] * rs * g4[bj][0], acc[ai][bj][m][1] * rs * g4[bj][1]);
            }
    }
};
struct EpiKV {
    static constexpr bool PERM = true, AFTER_DRAIN = false;
    float* out; unsigned char* ws; const float* kg;
    DI void operator()(AccRef acc, const pg8::Unit& u, int wr, int wc, int fr, int fq) const {
        const bool isk = u.pn < 4;
        const int colb = isk ? (u.pn * 256 + wc * 64 + 8 * fq) : ((u.pn - 4) * 256 + wc * 32 + 8 * fq);
        const int cstep = isk ? 32 : 128;
        f32x4 g4[2][2];
#pragma unroll
        for (int bj = 0; bj < 2; ++bj)
#pragma unroll
            for (int n = 0; n < 2; ++n) g4[bj][n] = isk ? *(const f32x4*)(kg + 32 * bj + 8 * fq + 4 * n) : (f32x4){1.f, 1.f, 1.f, 1.f};
#pragma unroll
        for (int ai = 0; ai < 2; ++ai) {
            const int rowb = u.pm * 256 + ai * 128 + wr * 64;
            float* op; bf16_t* bp;
            if (rowb < MP) { const size_t oo = isk ? (size_t)OFF_PK : (size_t)OFF_PV, bo = isk ? WS_KP : WS_VP;
                op = out + oo + (size_t)(rowb + fr) * D + colb; bp = (bf16_t*)(ws + bo) + (size_t)(rowb + fr) * D + colb; }
            else { const int r2 = rowb - MP; const size_t oo = isk ? (size_t)OFF_SK : (size_t)OFF_SV, bo = isk ? WS_KS : WS_VS;
                op = out + oo + (size_t)(r2 + fr) * D + colb; bp = (bf16_t*)(ws + bo) + ((size_t)(r2 >> 6) * KSROWS + 4096 + fr) * D + colb; }
#pragma unroll
            for (int m = 0; m < 4; ++m) {
                float rs = 1.0f;
                if (isk) {
                    float ss = 0.f;
#pragma unroll
                    for (int bj = 0; bj < 2; ++bj)
#pragma unroll
                        for (int n = 0; n < 2; ++n) { const f32x4 v = acc[ai][bj][m][n]; ss += (v[0] * v[0] + v[1] * v[1]) + (v[2] * v[2] + v[3] * v[3]); }
                    ss += __shfl_xor(ss, 16); ss = xor32_sum(ss);
                    rs = __builtin_amdgcn_rsqf(ss * (1.0f / 64.0f) + EPS);
                }
#pragma unroll
                for (int bj = 0; bj < 2; ++bj) {
                    const f32x4 v0 = acc[ai][bj][m][0] * rs * g4[bj][0], v1 = acc[ai][bj][m][1] * rs * g4[bj][1];
                    float* o2 = op + m * 16 * D + bj * cstep; bf16_t* b2 = bp + m * 16 * D + bj * cstep;
                    __builtin_nontemporal_store(v0, (f32x4*)(o2)); __builtin_nontemporal_store(v1, (f32x4*)(o2 + 4));
                    *(u32x4*)(b2) = pack8f(v0, v1);
                }
                asm volatile("" ::: "memory");
            }
        }
    }
};

constexpr int GS_A = 0, GS_B = 17408, GS_BUF = 52224;
template <class Epi, bool BMAP1 = false>
DI void gemm_small(LAS unsigned char* lds, const bf16_t* A, const bf16_t* Bt, int nM, int nN, int K, const Epi& E, int vcu, int G, int tid, int wave, int lane) {
    const int wr = wave >> 2, wc = wave & 3, r = lane & 31, hh = lane >> 5;
    const int srow = tid >> 4, scc = tid & 15, nkt = K >> 7;
    struct Stage { u32x4 a0, a1, b0, b1, b2, b3; };
#pragma unroll 1
    for (int u = vcu; u < nM * nN; u += G) {
        const int pm = u / nN, pn = u % nN;
        const bf16_t* ga = A + (size_t)(pm * 64 + srow) * K + scc * 8;
        const bf16_t* gb = Bt + (size_t)((BMAP1 ? 256 * (pn >> 1) + 32 * ((2 * pn) & 3) : pn * 128) + srow) * K + scc * 8;
        constexpr int BR1 = BMAP1 ? 128 : 32, BR2 = BMAP1 ? 32 : 64, BR3 = BMAP1 ? 160 : 96;
        auto load = [&](Stage& st, int kt) {
            const bf16_t* pa = ga + kt * 128; const bf16_t* pb = gb + kt * 128;
            st.a0 = *(const u32x4*)pa; st.a1 = *(const u32x4*)(pa + (size_t)32 * K);
            st.b0 = *(const u32x4*)pb; st.b1 = *(const u32x4*)(pb + (size_t)BR1 * K); st.b2 = *(const u32x4*)(pb + (size_t)BR2 * K); st.b3 = *(const u32x4*)(pb + (size_t)BR3 * K);
        };
        auto store = [&](const Stage& st, LAS unsigned char* buf) {
            LAS unsigned char* pa = buf + GS_A + srow * 272 + scc * 16; LAS unsigned char* pb = buf + GS_B + srow * 272 + scc * 16;
            *(LAS u32x4*)pa = st.a0; *(LAS u32x4*)(pa + 32 * 272) = st.a1;
            *(LAS u32x4*)pb = st.b0; *(LAS u32x4*)(pb + 32 * 272) = st.b1; *(LAS u32x4*)(pb + 64 * 272) = st.b2; *(LAS u32x4*)(pb + 96 * 272) = st.b3;
        };
        f32x16 acc = f32x16{};
        auto compute = [&](const LAS unsigned char* buf) {
            const LAS unsigned char* pa = buf + GS_A + (32 * wr + r) * 272 + hh * 16; const LAS unsigned char* pb = buf + GS_B + (32 * wc + r) * 272 + hh * 16;
#pragma unroll
            for (int kh = 0; kh < 2; ++kh) {
                bf16x8 af[4], bfr[4];
#pragma unroll
                for (int ks = 0; ks < 4; ++ks) { af[ks] = *(const LAS bf16x8*)(pa + (4 * kh + ks) * 32); bfr[ks] = *(const LAS bf16x8*)(pb + (4 * kh + ks) * 32); }
#pragma unroll
                for (int ks = 0; ks < 4; ++ks) acc = MFMA32(af[ks], bfr[ks], acc);
            }
        };
        Stage s0, s1, s2, s3;
        load(s0, 0); load(s1, 1); if (2 < nkt) load(s2, 2); if (3 < nkt) load(s3, 3);
#pragma unroll 1
        for (int kt = 0; kt < nkt; kt += 4) {
            store(s0, lds); LDS_BARRIER(); if (kt + 4 < nkt) load(s0, kt + 4); compute(lds);
            if (kt + 1 < nkt) { store(s1, lds + GS_BUF); LDS_BARRIER(); if (kt + 5 < nkt) load(s1, kt + 5); compute(lds + GS_BUF); }
            if (kt + 2 < nkt) { store(s2, lds); LDS_BARRIER(); if (kt + 6 < nkt) load(s2, kt + 6); compute(lds); }
            if (kt + 3 < nkt) { store(s3, lds + GS_BUF); LDS_BARRIER(); if (kt + 7 < nkt) load(s3, kt + 7); compute(lds + GS_BUF); }
        }
        E(acc, pm, pn, wr, wc, r, hh);
        LDS_BARRIER();
    }
}
struct EpiResSmall {
    const void* res; void* out; const float* gate; int res_bf, out_bf;
    DI void operator()(const f32x16& acc, int pm, int pn, int wr, int wc, int r, int hh) const {
        const int col = pn * 128 + wc * 32 + r;
        const float g = gate[(size_t)(8 + pm) * 6144 + col];
        const size_t base = (size_t)(pm * 64 + 32 * wr + 4 * hh) * D + col;
#pragma unroll
        for (int i = 0; i < 16; ++i) { const size_t o = base + (size_t)((i & 3) + 8 * (i >> 2)) * D;
            const float rv = res_bf ? __uint_as_float((unsigned)((const bf16_t*)res)[o] << 16) : ((const float*)res)[o];
            const float v = rv + g * acc[i];
            if (out_bf) ((bf16_t*)out)[o] = (bf16_t)(pk2(v, 0.f) & 0xffffu); else ((float*)out)[o] = v; }
    }
};

struct EpiQSmall {
    bf16_t* Q; const float* qg; float scale; LAS float* X;
    DI void operator()(const f32x16& acc, int pm, int pn, int wr, int wc, int r, int hh) const {
        float ss[16];
#pragma unroll
        for (int i = 0; i < 16; ++i) { float v = acc[i] * acc[i];
#pragma unroll
            for (int o = 1; o < 32; o <<= 1) v += __shfl_xor(v, o);
            ss[i] = v; }
        const int w = wr * 4 + wc;
        if (r == 0) {
#pragma unroll
            for (int i = 0; i < 16; ++i) X[(w * 2 + hh) * 16 + i] = ss[i];
        }
        LDS_BARRIER();
        const int col = pn * 128 + wc * 32 + r;
        const float g = qg[(wc & 1) * 32 + r] * scale;
        bf16_t* qp = Q + (size_t)(pm * 64 + 32 * wr + 4 * hh) * D + col;
#pragma unroll
        for (int i = 0; i < 16; ++i) {
            const float tot = ss[i] + X[((w ^ 1) * 2 + hh) * 16 + i];
            const float rs = __builtin_amdgcn_rsqf(tot * (1.0f / 64.0f) + EPS);
            qp[(size_t)((i & 3) + 8 * (i >> 2)) * D] = (bf16_t)(pk2(acc[i] * rs * g, 0.f) & 0xffffu);
        }
    }
};

template <bool NORM>
struct EpiKVSmall {
    float* out; bf16_t* bc; const float* kg; LAS float* X;
    DI void operator()(const f32x16& acc, int pm, int pn, int wr, int wc, int r, int hh) const {
        const int col = pn * 128 + wc * 32 + r;
        float* op = out + (size_t)(pm * 64 + 32 * wr + 4 * hh) * D + col;
        bf16_t* bp = bc + ((size_t)pm * KSROWS + 4096 + 32 * wr + 4 * hh) * D + col;
        if constexpr (NORM) {
            float ss[16];
#pragma unroll
            for (int i = 0; i < 16; ++i) { float v = acc[i] * acc[i];
#pragma unroll
                for (int o = 1; o < 32; o <<= 1) v += __shfl_xor(v, o);
                ss[i] = v; }
            const int w = wr * 4 + wc;
            if (r == 0) {
#pragma unroll
                for (int i = 0; i < 16; ++i) X[(w * 2 + hh) * 16 + i] = ss[i];
            }
            LDS_BARRIER();
            const float g = kg[(wc & 1) * 32 + r];
#pragma unroll
            for (int i = 0; i < 16; ++i) {
                const float tot = ss[i] + X[((w ^ 1) * 2 + hh) * 16 + i];
                const float v = acc[i] * __builtin_amdgcn_rsqf(tot * (1.0f / 64.0f) + EPS) * g;
                const size_t o = (size_t)((i & 3) + 8 * (i >> 2)) * D;
                op[o] = v; bp[o] = (bf16_t)(pk2(v, 0.f) & 0xffffu);
            }
        } else {
#pragma unroll
            for (int i = 0; i < 16; ++i) { const size_t o = (size_t)((i & 3) + 8 * (i >> 2)) * D; op[o] = acc[i]; bp[o] = (bf16_t)(pk2(acc[i], 0.f) & 0xffffu); }
        }
    }
};

#define XB_TMO      128
#define XB_XCNT(j)  (256  + 64 * (j))
#define XB_XSUB(j)  (1280 + 64 * (j))
#define XB_XGEN(j)  (2304 + 64 * (j))
#define XB_TOP      3328
#define XB_TOPGEN   3392
#define XCD_BAR_WORDS 3456
#define XB_SPIN_CAP (1u << 22)
DI unsigned xb_ld(unsigned* p)              { return __hip_atomic_load(p, __ATOMIC_RELAXED, __HIP_MEMORY_SCOPE_AGENT); }
DI unsigned xb_add(unsigned* p, unsigned v) { return __hip_atomic_fetch_add(p, v, __ATOMIC_RELAXED, __HIP_MEMORY_SCOPE_AGENT); }
DI unsigned xb_xcc_id() { return (unsigned)__builtin_amdgcn_s_getreg((3 << 11) | 20) & 0xFu; }
#define XB_SPIN(cond, bar) do { unsigned _sp = 0; while (cond) { __builtin_amdgcn_s_sleep(1); \
    if ((++_sp & 255u) == 0u) { if (xb_ld(&(bar)[XB_TMO])) break; if (_sp > XB_SPIN_CAP) { atomicAdd(&(bar)[XB_TMO], 1u); break; } } } } while (0)
struct XcdBarrier { unsigned* bar; unsigned x; int w0; volatile LAS unsigned* st; };
DI bool xb_thread0(int w0) { return w0 == 0 && __builtin_amdgcn_mbcnt_hi(~0u, __builtin_amdgcn_mbcnt_lo(~0u, 0u)) == 0u; }
DI XcdBarrier xcd_barrier_post(unsigned* bar, int w0, volatile LAS unsigned* st) {
    XcdBarrier b; b.bar = bar; b.x = xb_xcc_id(); b.w0 = w0; b.st = st;
    if (xb_thread0(w0)) (void)xb_add(&bar[XB_XCNT(b.x)], 1u);
    return b;
}
DI void xcd_barrier_complete(unsigned* bar, unsigned x, unsigned& nloc, unsigned& nx) {
    const unsigned G = gridDim.x * gridDim.y * gridDim.z;
    unsigned sum, cnt, mine, sp = 0u;
    for (;;) {
        sum = 0u; cnt = 0u; mine = 0u;
#pragma unroll
        for (unsigned j = 0; j < 16; ++j) { const unsigned c = xb_ld(&bar[XB_XCNT(j)]); sum += c; cnt += (c > 0u) ? 1u : 0u; mine = (j == x) ? c : mine; }
        if (sum == G) break;
        __builtin_amdgcn_s_sleep(1);
        if ((++sp & 255u) == 0u) { if (xb_ld(&bar[XB_TMO])) break; if (sp > XB_SPIN_CAP) { atomicAdd(&bar[XB_TMO], 1u); break; } }
    }
    nloc = mine > 0u ? mine : 1u; nx = cnt > 0u ? cnt : 1u;
}
DI void xcd_barrier(const XcdBarrier& b) {
    asm volatile("s_waitcnt vmcnt(0)" ::: "memory");
    __syncthreads();
    if (xb_thread0(b.w0)) {
        unsigned* bar = b.bar;
        __builtin_amdgcn_s_waitcnt(0);
        unsigned nloc = b.st[0], nx = b.st[1];
        if (nloc == 0u) { xcd_barrier_complete(bar, b.x, nloc, nx); b.st[0] = nloc; b.st[1] = nx; }
        const unsigned old = xb_add(&bar[XB_XSUB(b.x)], 1u);
        const unsigned gen = old / nloc;
        if (old + 1u == (gen + 1u) * nloc) {
            __builtin_amdgcn_fence(__ATOMIC_RELEASE, "agent");
            asm volatile("s_waitcnt vmcnt(0)" ::: "memory");
            const unsigned og = xb_add(&bar[XB_TOP], 1u);
            const unsigned tg = og / nx;
            if (og + 1u == (tg + 1u) * nx) xb_add(&bar[XB_TOPGEN], 1u);
            else XB_SPIN(xb_ld(&bar[XB_TOPGEN]) == tg, bar);
            __builtin_amdgcn_fence(__ATOMIC_ACQUIRE, "agent");
            xb_add(&bar[XB_XGEN(b.x)], 1u);
            asm volatile("s_waitcnt vmcnt(0)" ::: "memory");
        } else {
            XB_SPIN(xb_ld(&bar[XB_XGEN(b.x)]) == gen, bar);
            __builtin_amdgcn_fence(__ATOMIC_ACQUIRE, "agent");
            asm volatile("s_waitcnt vmcnt(0)" ::: "memory");
        }
    }
    __syncthreads();
}

struct Args { const float* in[29]; float* out; unsigned char* ws; int ph_lo, ph_hi; };
typedef const __attribute__((address_space(4))) Args& ArgsRef;
DI ArgsRef kargs() { const __attribute__((address_space(4))) Args* p = (const __attribute__((address_space(4))) Args*)__builtin_amdgcn_kernarg_segment_ptr(); asm volatile("" : "+s"(p)); return *p; }
enum { I_XP = 0, I_XS, I_CP, I_CS, I_SC, I_SN, I_SM, I_CK, I_CV, I_ADAW, I_ADAB, I_NORMG, I_WIN, I_BG, I_MHG, I_WOUT, I_KVG, I_WK, I_WV, I_KG,
       I_WQ, I_QG, I_LAM, I_AHG, I_WO, I_RELB, I_WGATE, I_WUP, I_WDOWN };

constexpr long CACHE_CH = 2 * 16777216L, CACHE_T0 = 2097152L, CACHE_T1 = 2 * 2097152L, CACHE_T2 = CACHE_T1 + 1048576L, CACHE_T3 = CACHE_T2 + 1048576L;
DI int dst_row_map(int mode, int n) {
    if (mode == 1) return (n & ~255) | (((n >> 5) & 1) << 7) | (((n >> 6) & 3) << 5) | (n & 31);
    if (mode == 2) return 256 * (n >> 7) + (n & 127);
    if (mode == 3) return 256 * (n >> 7) + 128 + (n & 127);
    return n;
}
DI void transpose_item(const float* __restrict__ W, int ldw, int K, bf16_t* WT, int k0, int n0, int drow0, float wsc, LAS float* scr, int lane) {
    float wv[32];
#pragma unroll
    for (int i = 0; i < 32; ++i) { const int kk = 2 * i + (lane >> 5); wv[i] = __builtin_nontemporal_load(W + (size_t)(k0 + kk) * ldw + n0 + (lane & 31)); }
#pragma unroll
    for (int i = 0; i < 32; ++i) { const int kk = 2 * i + (lane >> 5); scr[kk * 33 + (lane & 31)] = wv[i]; }
    asm volatile("s_waitcnt lgkmcnt(0)" ::: "memory");
    const int c = lane & 7;
#pragma unroll
    for (int j = 0; j < 4; ++j) { const int n = (lane >> 3) + 8 * j; const LAS float* s = scr + (8 * c) * 33 + n;
        u32x4 o; o.x = pk2(s[0 * 33] * wsc, s[1 * 33] * wsc); o.y = pk2(s[2 * 33] * wsc, s[3 * 33] * wsc); o.z = pk2(s[4 * 33] * wsc, s[5 * 33] * wsc); o.w = pk2(s[6 * 33] * wsc, s[7 * 33] * wsc);
        *(u32x4*)(WT + (size_t)(drow0 + n) * K + k0 + 8 * c) = o; }
    asm volatile("s_waitcnt lgkmcnt(0)" ::: "memory");
}
DI void prologue_weights(ArgsRef a, LAS unsigned char* lds, int gw, int NGW, int wave, int lane, int sel) {
    LAS float* scr = (LAS float*)(lds + wave * 8448);
    unsigned char* ws = a.ws;
    constexpr int I_WINI = 16 * 96, I_SQ = 16 * 32, I_GU = 16 * 88, I_DN = 44 * 32;
    constexpr int NITEMS = 2 * I_WINI + 4 * I_SQ + 2 * I_SQ + 2 * I_SQ + 8 * I_GU + 4 * I_DN;
    for (int it = gw; it < NITEMS; it += NGW) {
        int r = it; const float* W; int ldw, K, nblk, mode; bf16_t* WT; int first = 0;
        if (r < 2 * I_WINI) { const int l = r / I_WINI; first = (l == 0); r -= l * I_WINI; W = a.in[I_WIN] + (size_t)l * 1024 * MIN; ldw = MIN; K = 1024; nblk = 96; mode = 0; WT = (bf16_t*)(ws + WS_WIN) + (size_t)l * NPROJ * 1024; }
        else { r -= 2 * I_WINI;
        if (r < 4 * I_SQ) { const int l = r / I_SQ; first = (l == 0); r -= l * I_SQ; W = (l < 2 ? a.in[I_WOUT] + (size_t)l * 1048576 : a.in[I_WO] + (size_t)(l - 2) * 1048576); ldw = 1024; K = 1024; nblk = 32; mode = 0; WT = (bf16_t*)(ws + WS_WMO) + (size_t)l * 1048576; }
        else { r -= 4 * I_SQ;
        if (r < 2 * I_SQ) { const int j = r / I_SQ; r -= j * I_SQ; W = a.in[I_WQ] + (size_t)j * 1048576; ldw = 1024; K = 1024; nblk = 32; mode = 1; WT = (bf16_t*)(ws + WS_WQ) + (size_t)j * 1048576; }
        else { r -= 2 * I_SQ;
        if (r < 2 * I_SQ) { const int j = r / I_SQ; r -= j * I_SQ; W = j ? a.in[I_WV] : a.in[I_WK]; ldw = 1024; K = 1024; nblk = 32; mode = j ? 0 : 1; WT = (bf16_t*)(ws + WS_WKV) + (size_t)j * 1048576; }
        else { r -= 2 * I_SQ;
        if (r < 8 * I_GU) { const int q = r / I_GU; r -= q * I_GU; const int l = q >> 1, up = q & 1; first = (l == 0); W = (up ? a.in[I_WUP] : a.in[I_WGATE]) + (size_t)l * 1024 * DFF; ldw = DFF; K = 1024; nblk = 88; mode = 2 + up; WT = (bf16_t*)(ws + WS_WGU) + (size_t)l * 5632 * 1024; }
        else { r -= 8 * I_GU; const int l = r / I_DN; first = (l == 0); r -= l * I_DN; W = a.in[I_WDOWN] + (size_t)l * DFF * 1024; ldw = 1024; K = DFF; nblk = 32; mode = 0; WT = (bf16_t*)(ws + WS_WD) + (size_t)l * 1024 * DFF; } } } } }
        if (first == sel) continue;
        const int kb = r / nblk, nb = r % nblk;
        const float wsc = mode == 2 ? -LOG2E : (mode == 3 ? -0.6931471805599453f : 1.0f);
        transpose_item(W, ldw, K, WT, 64 * kb, 32 * nb, dst_row_map(mode, 32 * nb), wsc, scr, lane);
    }
}
DI void prologue_cache(ArgsRef a, int gtid, int NT, long cbeg, long cend) {
    constexpr long NCH = 16777216L;
    const long len = cend - cbeg, step = 4L * NT;
    if (len <= 0) return;
    const int T = (int)((len + step - 1) / step);
    const int ib = (int)cbeg + gtid, ie = (int)cend, ilen = (int)len, istep = (int)step;
    auto ld = [&](f32x4 (&v)[4][2], int t) {
#pragma unroll
        for (int j = 0; j < 4; ++j) { int ci = ib + t * istep + j * NT; if (ci >= ie) ci -= ilen;
            const int which = ci >= (int)NCH; const unsigned c = (unsigned)(which ? ci - (int)NCH : ci);
            const float* src = (const float*)((const char*)(which ? a.in[I_CV] : a.in[I_CK]) + (size_t)(c * 32u));
            v[j][0] = __builtin_nontemporal_load((const f32x4*)src); v[j][1] = __builtin_nontemporal_load((const f32x4*)(src + 4)); }
    };
    auto st = [&](const f32x4 (&v)[4][2], int t) {
#pragma unroll
        for (int j = 0; j < 4; ++j) { int ci = ib + t * istep + j * NT; if (ci >= ie) ci -= ilen;
            const int which = ci >= (int)NCH; const unsigned c = (unsigned)(which ? ci - (int)NCH : ci);
            const unsigned b = c >> 19, rest = c & ((1u << 19) - 1u);
            bf16_t* dst = (bf16_t*)(a.ws + (which ? WS_VS : WS_KS) + (size_t)(b * (unsigned)(KSROWS * 2048) + rest * 16u));
            __builtin_nontemporal_store(pack8f(v[j][0], v[j][1]), (u32x4*)dst); }
    };
    f32x4 va[4][2], vb[4][2];
    int t = 0;
    ld(va, 0);
#pragma unroll 1
    while (t + 2 < T) { ld(vb, t + 1); st(va, t); ld(va, t + 2); st(vb, t + 1); t += 2; }
    if (t + 1 < T) { ld(vb, t + 1); st(va, t); st(vb, t + 1); } else st(va, t);
}
DI void prologue_adaln(ArgsRef a, LAS unsigned char* lds, int vcu, int G, int tid, int wave, int lane) {
    LAS float* sc = (LAS float*)lds;
    LAS float* red = (LAS float*)(lds + 81920);
    float* mod = (float*)(a.ws + WS_MOD);
    for (int it = vcu; it < 8 * 96; it += G) {
        const int l = it / 192, j0 = ((it % 192) >> 1) * 64;
        { const int p = it & 1;
            for (int i = tid; i < 1024; i += 512) {
#pragma unroll
                for (int s = 0; s < 20; ++s) { const int sq = 20 * p + s; const float c = sq < 8 ? a.in[I_CP][sq * 1024 + i] : a.in[I_CS][(sq - 8) * 1024 + i];
                    sc[i * 20 + s] = c / (1.0f + __expf(-c)); }
            }
            LDS_BARRIER();
            float acc[20];
#pragma unroll
            for (int s = 0; s < 20; ++s) acc[s] = 0.f;
            const float* wp = a.in[I_ADAW] + ((size_t)l * 1024 + wave * 128) * 6144 + j0 + lane;
#pragma unroll 1
            for (int i0 = 0; i0 < 128; i0 += 16) {
                float w16[16];
#pragma unroll
                for (int k = 0; k < 16; ++k) w16[k] = wp[(size_t)(i0 + k) * 6144];
#pragma unroll
                for (int k = 0; k < 16; ++k) {
                    const float w = w16[k];
                    const LAS f32x4* s4 = (const LAS f32x4*)(sc + (wave * 128 + i0 + k) * 20);
#pragma unroll
                    for (int q = 0; q < 5; ++q) { const f32x4 v = s4[q]; acc[4 * q] += v.x * w; acc[4 * q + 1] += v.y * w; acc[4 * q + 2] += v.z * w; acc[4 * q + 3] += v.w * w; }
                    if ((k & 3) == 3) asm volatile("" ::: "memory");
                }
            }
#pragma unroll
            for (int s = 0; s < 20; ++s) red[(wave * 20 + s) * 64 + lane] = acc[s];
            LDS_BARRIER();
            for (int o = tid; o < 1280; o += 512) { const int s = o >> 6, jj = o & 63; float v = a.in[I_ADAB][l * 6144 + j0 + jj];
#pragma unroll
                for (int w = 0; w < 8; ++w) v += red[(w * 20 + s) * 64 + jj];
                mod[((size_t)l * 40 + 20 * p + s) * 6144 + j0 + jj] = v; }
            LDS_BARRIER();
        }
    }
}

template <int CTRL, int ROWMASK> DI float dpp_f(float old, float src) {
    return __builtin_bit_cast(float, __builtin_amdgcn_update_dpp(__builtin_bit_cast(int, old), __builtin_bit_cast(int, src), CTRL, ROWMASK, 0xf, false));
}
DI float wave_scan_add(float v) {
    v += dpp_f<0x111, 0xf>(0.f, v); v += dpp_f<0x112, 0xf>(0.f, v); v += dpp_f<0x114, 0xf>(0.f, v); v += dpp_f<0x118, 0xf>(0.f, v);
    v += dpp_f<0x142, 0xa>(0.f, v); v += dpp_f<0x143, 0xc>(0.f, v); return v;
}
DI float wave_scan_max(float v) {
    const float ninf = -3.0e38f;
    v = fmaxf(v, dpp_f<0x111, 0xf>(ninf, v)); v = fmaxf(v, dpp_f<0x112, 0xf>(ninf, v)); v = fmaxf(v, dpp_f<0x114, 0xf>(ninf, v)); v = fmaxf(v, dpp_f<0x118, 0xf>(ninf, v));
    v = fmaxf(v, dpp_f<0x142, 0xa>(ninf, v)); v = fmaxf(v, dpp_f<0x143, 0xc>(ninf, v)); return v;
}

DI float wave_sum_u(float v) { v = wave_scan_add(v); return __builtin_bit_cast(float, __builtin_amdgcn_readlane(__builtin_bit_cast(int, v), 63)); }

DI int ncol(int lane, int q) { return 8 * lane + 512 * (q >> 1) + 4 * (q & 1); }
DI void ld8pair(const void* base, size_t e, int bf, f32x4& a0, f32x4& a1) {
    if (bf) { const u32x4 w = __builtin_nontemporal_load((const u32x4*)((const bf16_t*)base + e)); a0 = (f32x4){bf_lo(w.x), bf_hi(w.x), bf_lo(w.y), bf_hi(w.y)}; a1 = (f32x4){bf_lo(w.z), bf_hi(w.z), bf_lo(w.w), bf_hi(w.w)}; }
    else { a0 = *(const f32x4*)((const float*)base + e); a1 = *(const f32x4*)((const float*)base + e + 4); }
}
template <bool MODULATE, bool GATES>
DI void norm_phase(ArgsRef a, LAS unsigned char* lds, const void* xP, const void* xS, int in_bf, const float* g, const float* modl, int sh_off, int sc_off,
                   const float* Wg  , const float* bg, int vcu, int G, int tid, int wave, int lane) {
    bf16_t* XM = (bf16_t*)(a.ws + WS_XM);
    float* gates = (float*)(a.ws + WS_GATES);
    LAS float* wl = (LAS float*)lds;
    if (GATES) {
        for (int i = tid; i < 1024 * 16; i += 512) { const int r = i >> 4, c = i & 15; wl[c * 1024 + r] = Wg[(size_t)r * MIN + c]; }
        LDS_BARRIER();
    }
    f32x4 gv[4], shv[4], scv[4];
#pragma unroll
    for (int q = 0; q < 4; ++q) { gv[q] = *(const f32x4*)(g + ncol(lane, q)); shv[q] = (f32x4){0.f, 0.f, 0.f, 0.f}; scv[q] = shv[q]; }
    int cur_seq = -1;
    const float bgv = (GATES && lane < 16) ? bg[lane] : 0.f;
    const int NW = G * NWAVES, gw = vcu * NWAVES + wave;
    const int per = (M + NW - 1) / NW;
    const int r0 = gw * per, r1 = (r0 + per < M) ? r0 + per : M;
    f32x4 xn[4];
    auto load_row = [&](int row) {
        const void* xb = row < MP ? xP : xS; const size_t e0 = (size_t)(row < MP ? row : row - MP) * D + 8 * lane;
#pragma unroll
        for (int h2 = 0; h2 < 2; ++h2) ld8pair(xb, e0 + 512 * h2, in_bf, xn[2 * h2], xn[2 * h2 + 1]);
    };
    if (r0 < r1) load_row(r0);
    for (int row = r0; row < r1; ++row) {
        f32x4 x[4]; float ss = 0.f;
#pragma unroll
        for (int q = 0; q < 4; ++q) { x[q] = xn[q]; ss += (x[q][0] * x[q][0] + x[q][1] * x[q][1]) + (x[q][2] * x[q][2] + x[q][3] * x[q][3]); }
        if (row + 1 < r1) load_row(row + 1);
        if (MODULATE) {
            const int seq = row < MP ? (row >> 12) : 8 + ((row - MP) >> 6);
            if (seq != cur_seq) { cur_seq = seq; const float* mp = modl + (size_t)seq * 6144;
#pragma unroll
                for (int q = 0; q < 4; ++q) { shv[q] = *(const f32x4*)(mp + sh_off + ncol(lane, q)); scv[q] = *(const f32x4*)(mp + sc_off + ncol(lane, q)) + 1.0f; } }
        }
        ss = wave_sum_u(ss);
        const float rstd = __builtin_amdgcn_rsqf(ss * (1.0f / D) + EPS);
#pragma unroll
        for (int q = 0; q < 4; ++q) { x[q] = x[q] * rstd * gv[q]; if (MODULATE) x[q] = x[q] * scv[q] + shv[q]; }
        bf16_t* o = XM + (size_t)row * D + 8 * lane;
#pragma unroll
        for (int h2 = 0; h2 < 2; ++h2) *(u32x4*)(o + 512 * h2) = pack8f(x[2 * h2], x[2 * h2 + 1]);
        if (GATES) {
            float mine = 0.f;
#pragma unroll
            for (int c = 0; c < 16; ++c) {
                float acc = 0.f;
#pragma unroll
                for (int q = 0; q < 4; ++q) { const f32x4 w = *(const LAS f32x4*)(wl + c * 1024 + ncol(lane, q)); acc += (x[q][0] * w.x + x[q][1] * w.y) + (x[q][2] * w.z + x[q][3] * w.w); }
                const float t = wave_sum_u(acc); if (lane == c) mine = t;
                if (c & 1) asm volatile("" ::: "memory");
            }
            if (lane < 16) gates[(size_t)row * 16 + lane] = mine + bgv;
        }
    }
    if (GATES) LDS_BARRIER();
}

DI void norm_dual_phase(ArgsRef a, const bf16_t* XB, bf16_t* XM, bf16_t* XM2, const float* gkv, const float* g2, const float* modl2, int sh_off, int sc_off, int vcu, int G, int wave, int lane) {
    f32x4 gk[4], gv[4], shv[4], scv[4];
#pragma unroll
    for (int q = 0; q < 4; ++q) { gk[q] = *(const f32x4*)(gkv + ncol(lane, q)); gv[q] = *(const f32x4*)(g2 + ncol(lane, q)); shv[q] = (f32x4){0.f, 0.f, 0.f, 0.f}; scv[q] = shv[q]; }
    int cur_seq = -1;
    const int NW = G * NWAVES, gw = vcu * NWAVES + wave;
    const int per = (M + NW - 1) / NW;
    const int r0 = gw * per, r1 = (r0 + per < M) ? r0 + per : M;
    f32x4 xn[4];
    auto load_row = [&](int row) {
#pragma unroll
        for (int h2 = 0; h2 < 2; ++h2) ld8pair(XB, (size_t)row * D + 8 * lane + 512 * h2, 1, xn[2 * h2], xn[2 * h2 + 1]);
    };
    if (r0 < r1) load_row(r0);
    for (int row = r0; row < r1; ++row) {
        f32x4 x[4]; float ss = 0.f;
#pragma unroll
        for (int q = 0; q < 4; ++q) { x[q] = xn[q]; ss += (x[q][0] * x[q][0] + x[q][1] * x[q][1]) + (x[q][2] * x[q][2] + x[q][3] * x[q][3]); }
        if (row + 1 < r1) load_row(row + 1);
        const int seq = row < MP ? (row >> 12) : 8 + ((row - MP) >> 6);
        if (seq != cur_seq) { cur_seq = seq; const float* mp = modl2 + (size_t)seq * 6144;
#pragma unroll
            for (int q = 0; q < 4; ++q) { shv[q] = *(const f32x4*)(mp + sh_off + ncol(lane, q)); scv[q] = *(const f32x4*)(mp + sc_off + ncol(lane, q)) + 1.0f; } }
        ss = wave_sum_u(ss);
        const float rstd = __builtin_amdgcn_rsqf(ss * (1.0f / D) + EPS);
        bf16_t* o1 = XM + (size_t)row * D + 8 * lane; bf16_t* o2 = XM2 + (size_t)row * D + 8 * lane;
#pragma unroll
        for (int h2 = 0; h2 < 2; ++h2) {
            const f32x4 xa = x[2 * h2] * rstd, xb2 = x[2 * h2 + 1] * rstd;
            *(u32x4*)(o1 + 512 * h2) = pack8f(xa * gk[2 * h2], xb2 * gk[2 * h2 + 1]);
            *(u32x4*)(o2 + 512 * h2) = pack8f(xa * gv[2 * h2] * scv[2 * h2] + shv[2 * h2], xb2 * gv[2 * h2 + 1] * scv[2 * h2 + 1] + shv[2 * h2 + 1]);
        }
    }
}

constexpr int ML_Q = 0, ML_K = 9216, ML_KW = 18432, ML_V = 30720, ML_BUF = 51200;
constexpr int ML_SCR = 2 * ML_BUF;
constexpr int ML_RED = ML_SCR + 8 * 2048;
constexpr int ML_NP = ML_RED + 1024;
DI float logsigmoidf(float x) { return fminf(x, 0.f) - __logf(1.0f + __expf(-fabsf(x))); }
DI void mlstm_unit(ArgsRef a, LAS unsigned char* lds, int l, int seq, int h, int tid, int wave, int lane) {
    const bool isP = seq < 8; const int NC = isP ? 64 : 1;
    const int rowbase0 = isP ? seq * 4096 : MP + (seq - 8) * 64;
    const bf16_t* PROJ = (const bf16_t*)(a.ws + WS_PROJ);
    const float* GT = (const float*)(a.ws + WS_GATES);
    bf16_t* HG = (bf16_t*)(a.ws + WS_HG);
    const int dvs = wave & 3, th = wave >> 2;
    LAS float* scr = (LAS float*)(lds + ML_SCR + wave * 2048);
    LAS float* red = (LAS float*)(lds + ML_RED);
    LAS float* npart = (LAS float*)(lds + ML_NP);
    f32x16 Cst[2]; float nst, mprev;
    const int sidx = isP ? 0 : ((l * 32 + (seq - 8)) * 8 + h);
    if (isP) { Cst[0] = f32x16{}; Cst[1] = f32x16{}; nst = 0.f; mprev = 0.f; }
    else {
        const float* Cin = a.in[I_SC] + (size_t)sidx * 8192 + 32 * dvs + (lane & 31) + (lane >> 5) * 512;
#pragma unroll
        for (int kb = 0; kb < 2; ++kb)
#pragma unroll
            for (int i = 0; i < 16; ++i) Cst[kb][i] = Cin[(32 * kb + crow(i, 0)) * 128];
        nst = a.in[I_SN][(size_t)sidx * 64 + lane]; mprev = a.in[I_SM][sidx];
    }
    scr[448 + lane] = nst;
    const int srow = tid >> 3, scc = tid & 7;
    u32x4 pq, pk, pv0, pv1; u32x2 ogn[4]; float pig, pfg;
    auto issue_loads = [&](int c) {
        const size_t rb = (size_t)(rowbase0 + c * 64);
        const bf16_t* pr = PROJ + (rb + srow) * NPROJ;
        pq = *(const u32x4*)(pr + h * 64 + scc * 8);
        pk = *(const u32x4*)(pr + 512 + h * 64 + scc * 8);
        { const int idx = tid; const int vr = idx >> 4, vc = idx & 15; pv0 = *(const u32x4*)(PROJ + (rb + vr) * NPROJ + 1024 + h * 128 + vc * 8); }
        { const int idx = tid + 512; const int vr = idx >> 4, vc = idx & 15; pv1 = *(const u32x4*)(PROJ + (rb + vr) * NPROJ + 1024 + h * 128 + vc * 8); }
        pig = GT[(rb + lane) * 16 + h]; pfg = GT[(rb + lane) * 16 + 8 + h];
        const bf16_t* po = PROJ + (rb + 32 * th + (lane & 31)) * NPROJ + 2048 + h * 128 + 32 * dvs + 4 * (lane >> 5);
#pragma unroll
        for (int g = 0; g < 4; ++g) ogn[g] = *(const u32x2*)(po + 8 * g);
    };
    float bendN, A63N;
    auto gate_tables = [&](int par) {
        const float b = wave_scan_add(logsigmoidf(pfg));
        const float av = pig - b;
        const float cm = wave_scan_max(av);
        A63N = __builtin_bit_cast(float, __builtin_amdgcn_readlane(__builtin_bit_cast(int, cm), 63));
        bendN = __builtin_bit_cast(float, __builtin_amdgcn_readlane(__builtin_bit_cast(int, b), 63));
        scr[par * 64 + lane] = av; scr[128 + par * 64 + lane] = b; scr[256 + par * 64 + lane] = cm; scr[384 + lane] = __expf(av - A63N);
    };
    auto write_tiles = [&](int par) {
        LAS unsigned char* buf = lds + par * ML_BUF;
        *(LAS u32x4*)(buf + ML_Q + srow * 144 + scc * 16) = pq;
        *(LAS u32x4*)(buf + ML_K + srow * 144 + scc * 16) = pk;
        const float w = scr[384 + srow];
        u32x4 kw; kw.x = pk2(bf_lo(pk.x) * w, bf_hi(pk.x) * w); kw.y = pk2(bf_lo(pk.y) * w, bf_hi(pk.y) * w); kw.z = pk2(bf_lo(pk.z) * w, bf_hi(pk.z) * w); kw.w = pk2(bf_lo(pk.w) * w, bf_hi(pk.w) * w);
        *(LAS u32x4*)(buf + ML_KW + srow * 192 + scc * 16) = kw;
        { const int idx = tid; *(LAS u32x4*)(buf + ML_V + (idx >> 4) * 320 + (idx & 15) * 16) = pv0; }
        { const int idx = tid + 512; *(LAS u32x4*)(buf + ML_V + (idx >> 4) * 320 + (idx & 15) * 16) = pv1; }
    };
    issue_loads(0);
    gate_tables(0);
    asm volatile("s_waitcnt lgkmcnt(0)" ::: "memory");
    write_tiles(0);
    f32x4 hgr[4];
    { const float* hgv = a.in[I_MHG] + ((size_t)l * 8 + h) * 128 + 32 * dvs + 4 * (lane >> 5);
#pragma unroll
      for (int g = 0; g < 4; ++g) hgr[g] = *(const f32x4*)(hgv + 8 * g); }
    for (int c = 0; c < NC; ++c) {
        const int par = c & 1;
        LAS unsigned char* buf = lds + par * ML_BUF;
        LDS_BARRIER();
        int lo_ = lane; asm volatile("" : "+v"(lo_));
        const int r = lo_ & 31, hh = lo_ >> 5, q16 = (lo_ & 15) >> 2, p16 = lo_ & 3, g16 = (lo_ >> 4) & 1;
        const float bend = bendN, A63 = A63N;
        u32x2 og[4];
#pragma unroll
        for (int g = 0; g < 4; ++g) og[g] = ogn[g];
        if (c + 1 < NC) issue_loads(c + 1);
        const int t = 32 * th + r;
        const float bt = scr[128 + par * 64 + t], cmt = scr[256 + par * 64 + t];
        const float Mt = fmaxf(mprev, cmt), mt = bt + Mt, winter = __expf(mprev - Mt);
        const size_t rb = (size_t)(rowbase0 + c * 64);
        f32x16 sD = f32x16{}, sF = f32x16{};
        bf16x8 qf[4];
#pragma unroll
        for (int ks = 0; ks < 4; ++ks) {
            qf[ks] = *(const LAS bf16x8*)(buf + ML_Q + t * 144 + ks * 32 + hh * 16);
            const bf16x8 kD = *(const LAS bf16x8*)(buf + ML_K + t * 144 + ks * 32 + hh * 16);
            sD = MFMA32(kD, qf[ks], sD);
        }
        if (th == 1) {
#pragma unroll
            for (int ks = 0; ks < 4; ++ks) { const bf16x8 kF = *(const LAS bf16x8*)(buf + ML_K + r * 144 + ks * 32 + hh * 16); sF = MFMA32(kF, qf[ks], sF); }
        }
        f32x16 acc = f32x16{};
#pragma unroll
        for (int kb = 0; kb < 2; ++kb)
#pragma unroll
            for (int s = 0; s < 2; ++s) {
                const LAS unsigned char* qp = buf + ML_Q + t * 144 + (32 * kb + 16 * s + 4 * hh) * 2;
                const v4i16 lo = *(const LAS v4i16*)qp, hi = *(const LAS v4i16*)(qp + 16);
                const bf16x8 qb = __builtin_shufflevector(lo, hi, 0, 1, 2, 3, 4, 5, 6, 7);
                acc = MFMA32(pack_step(Cst[kb], s), qb, acc);
            }
        float psum = 0.f;
#pragma unroll
        for (int i = 0; i < 16; ++i) {
            const int s0 = crow(i, hh);
            const float w0 = __expf(scr[par * 64 + 32 * th + s0] - Mt);
            sD[i] = (s0 <= r) ? sD[i] * w0 : 0.f;
            psum += sD[i];
        }
        if (th == 1) {
#pragma unroll
            for (int i = 0; i < 16; ++i) { const float w1 = __expf(scr[par * 64 + crow(i, hh)] - Mt); sF[i] *= w1; psum += sF[i]; }
        }
        psum = xor32_sum(psum);
        float qn = 0.f;
#pragma unroll
        for (int ks = 0; ks < 4; ++ks) { const u32x4 qq = __builtin_bit_cast(u32x4, qf[ks]); const LAS float* np = scr + 448 + 16 * ks + 8 * hh;
            qn += bf_lo(qq.x) * np[0] + bf_hi(qq.x) * np[1] + bf_lo(qq.y) * np[2] + bf_hi(qq.y) * np[3] + bf_lo(qq.z) * np[4] + bf_hi(qq.z) * np[5] + bf_lo(qq.w) * np[6] + bf_hi(qq.w) * np[7]; }
        qn = xor32_sum(qn);
        const float den = winter * qn + psum;
        const float inv = __builtin_amdgcn_rcpf(fmaxf(fabsf(den), __expf(-mt)));
#pragma unroll
        for (int i = 0; i < 16; ++i) acc[i] *= winter;
        {
            const LAS unsigned char* vb = buf + ML_V + (4 * hh + q16) * 320 + (32 * dvs + 16 * g16 + 4 * p16) * 2;
            const LAS unsigned char* vd = vb + (32 * th) * 320;
#pragma unroll
            for (int s = 0; s < 2; ++s) { const bf16x8 vf = tr_pair(vd + (16 * s) * 320, vd + (16 * s + 8) * 320); acc = MFMA32(vf, pack_step(sD, s), acc); }
            asm volatile("" ::: "memory");
            if (th == 1) {
#pragma unroll
                for (int s = 0; s < 2; ++s) { const bf16x8 vf = tr_pair(vb + (16 * s) * 320, vb + (16 * s + 8) * 320); acc = MFMA32(vf, pack_step(sF, s), acc); }
            }
        }
        {
            float ps = 0.f;
#pragma unroll
            for (int i = 0; i < 8; ++i) { const unsigned short v = *(const LAS unsigned short*)(buf + ML_KW + (8 * wave + i) * 192 + lane * 2); ps += __uint_as_float((unsigned)v << 16); }
            npart[wave * 64 + lane] = ps;
        }
        float hs = 0.f;
#pragma unroll
        for (int i = 0; i < 16; ++i) { acc[i] *= inv; hs += acc[i] * acc[i]; }
        hs = xor32_sum(hs);
        if (hh == 0) red[(th * 4 + dvs) * 32 + r] = hs;
        f32x16 Cl[2]; Cl[0] = f32x16{}; Cl[1] = f32x16{};
        {
            const LAS unsigned char* vb = buf + ML_V + (8 * hh + q16) * 320 + (32 * dvs + 16 * g16 + 4 * p16) * 2;
            const LAS unsigned char* kb_ = buf + ML_KW + (8 * hh + q16) * 192 + (16 * g16 + 4 * p16) * 2;
#pragma unroll
            for (int ks = 0; ks < 4; ++ks) {
                const bf16x8 bfv = tr_pair(vb + (16 * ks) * 320, vb + (16 * ks + 4) * 320);
#pragma unroll
                for (int kb = 0; kb < 2; ++kb) { const bf16x8 af = tr_pair(kb_ + (16 * ks) * 192 + 64 * kb, kb_ + (16 * ks + 4) * 192 + 64 * kb); Cl[kb] = MFMA32(af, bfv, Cl[kb]); }
                asm volatile("" ::: "memory");
            }
        }
        const float mloc = bend + A63, mnew = fmaxf(bend + mprev, mloc);
        const float wo = __expf(bend + mprev - mnew), wn = __expf(mloc - mnew);
#pragma unroll
        for (int kb = 0; kb < 2; ++kb)
#pragma unroll
            for (int i = 0; i < 16; ++i) Cst[kb][i] = wo * Cst[kb][i] + wn * Cl[kb][i];
        mprev = mnew;
        if (c + 1 < NC) { gate_tables(par ^ 1); asm volatile("s_waitcnt lgkmcnt(0)" ::: "memory"); write_tiles(par ^ 1); }
        LDS_BARRIER();
        const float tot = red[(th * 4 + 0) * 32 + r] + red[(th * 4 + 1) * 32 + r] + red[(th * 4 + 2) * 32 + r] + red[(th * 4 + 3) * 32 + r];
        const float rstd = __builtin_amdgcn_rsqf(tot * (1.0f / 128.0f) + EPS);
#pragma unroll
        for (int g = 0; g < 4; ++g) {
            const f32x4 hg4 = hgr[g];
            const float o0 = bf_lo(og[g].x), o1 = bf_hi(og[g].x), o2 = bf_lo(og[g].y), o3 = bf_hi(og[g].y);
            const float v0 = acc[4 * g + 0] * rstd * hg4.x * __builtin_amdgcn_rcpf(1.0f + __expf(-o0)), v1 = acc[4 * g + 1] * rstd * hg4.y * __builtin_amdgcn_rcpf(1.0f + __expf(-o1));
            const float v2 = acc[4 * g + 2] * rstd * hg4.z * __builtin_amdgcn_rcpf(1.0f + __expf(-o2)), v3 = acc[4 * g + 3] * rstd * hg4.w * __builtin_amdgcn_rcpf(1.0f + __expf(-o3));
            u32x2 o; o.x = pk2(v0, v1); o.y = pk2(v2, v3);
            *(u32x2*)(HG + (rb + t) * D + h * 128 + 32 * dvs + 8 * g + 4 * hh) = o;
        }
        {
            float nl = 0.f;
#pragma unroll
            for (int w = 0; w < 8; ++w) nl += npart[w * 64 + lane];
            nst = wo * nst + wn * nl; scr[448 + lane] = nst;
        }
    }
    {
        float* out = a.out;
        const size_t oidx = isP ? (size_t)((l * 8 + seq) * 8 + h) : (size_t)sidx;
        float* Co = out + (isP ? OFF_PC : OFF_SC) + oidx * 8192 + 32 * dvs + (lane & 31) + (lane >> 5) * 512;
        if (th == 0) {
#pragma unroll
            for (int kb = 0; kb < 2; ++kb)
#pragma unroll
                for (int i = 0; i < 16; ++i) Co[(32 * kb + crow(i, 0)) * 128] = Cst[kb][i];
        }
        if (wave == 0) { out[(isP ? OFF_PN : OFF_SN) + oidx * 64 + lane] = nst; if (lane == 0) out[(isP ? OFF_PM : OFF_SM) + oidx] = mprev; }
    }
    WG_BARRIER();
}
DI void mlstm_phase(ArgsRef a, LAS unsigned char* lds, int l, int vcu, int G, int tid, int wave, int lane) {
    const int nrest = G > 64 ? G - 64 : G, first = G > 64 ? 64 : 0;
    int u = vcu; bool inP = true;
#pragma unroll 1
    for (;;) {
        int seq, h;
        if (inP) { if (u >= 64) { inP = false; u = vcu >= first ? vcu - first : 256; continue; } seq = u >> 3; h = u & 7; u += G; }
        else { if (u >= 256) break; seq = 8 + (u >> 3); h = u & 7; u += nrest; }
        mlstm_unit(a, lds, l, seq, h, tid, wave, lane);
    }
    if (l == 0 && vcu >= first) {
        prologue_weights(a, lds, (vcu - first) * NWAVES + wave, nrest * NWAVES, wave, lane, 1);
        prologue_cache(a, (vcu - first) * 512 + tid, nrest * 512, CACHE_T3, CACHE_CH);
    }
}

constexpr int ML_NUNITS = 4352;
DI void ml_unit_decode(int u, int& rowbase, int& h) {
    if (u < 4096) { rowbase = (u >> 9) * 4096 + (u & 63) * 64; h = (u >> 6) & 7; } else { const int us = u - 4096; rowbase = MP + (us >> 3) * 64; h = us & 7; }
}
constexpr int MA_KW = 0, MA_V = 12288, MA_BUF = 32768;
constexpr int MA_SCR = 2 * MA_BUF, MA_NP = MA_SCR + 8 * 256;
DI void mlA_phase(ArgsRef a, LAS unsigned char* lds, int vcu, int G, int tid, int wave, int lane) {
    const bf16_t* PROJ = (const bf16_t*)(a.ws + WS_PROJ);
    const float* GT = (const float*)(a.ws + WS_GATES);
    float* CL = (float*)(a.ws + WS_CL); float* NL = (float*)(a.ws + WS_NL); float* TAB = (float*)(a.ws + WS_TAB);
    const int per = (ML_NUNITS + G - 1) / G, u0 = vcu * per, u1 = (u0 + per < ML_NUNITS) ? u0 + per : ML_NUNITS;
    if (u0 >= u1) return;
    const int dvs = wave & 3, kb = wave >> 2;
    LAS float* wT = (LAS float*)(lds + MA_SCR + wave * 256);
    LAS float* npart = (LAS float*)(lds + MA_NP);
    const int srow = tid >> 3, scc = tid & 7;
    struct InA { u32x4 pk, pv0, pv1; float pig, pfg; };
    InA X, Y;
    auto issue_loads = [&](InA& in, int u) {
        int rb, h; ml_unit_decode(u, rb, h);
        in.pk = *(const u32x4*)(PROJ + (size_t)(rb + srow) * NPROJ + 512 + h * 64 + scc * 8);
        { const int idx = tid; in.pv0 = *(const u32x4*)(PROJ + (size_t)(rb + (idx >> 4)) * NPROJ + 1024 + h * 128 + (idx & 15) * 8); }
        { const int idx = tid + 512; in.pv1 = *(const u32x4*)(PROJ + (size_t)(rb + (idx >> 4)) * NPROJ + 1024 + h * 128 + (idx & 15) * 8); }
        in.pig = GT[(size_t)(rb + lane) * 16 + h]; in.pfg = GT[(size_t)(rb + lane) * 16 + 8 + h];
    };
    auto stage = [&](const InA& in, int u, int par) {
        const float b = wave_scan_add(logsigmoidf(in.pfg));
        const float av = in.pig - b;
        const float cm = wave_scan_max(av);
        const float A63 = __builtin_bit_cast(float, __builtin_amdgcn_readlane(__builtin_bit_cast(int, cm), 63));
        const float bend = __builtin_bit_cast(float, __builtin_amdgcn_readlane(__builtin_bit_cast(int, b), 63));
        wT[lane] = __expf(av - A63);
        if (wave == 0) { float* t = TAB + (size_t)u * 256; t[lane] = av; t[64 + lane] = b; t[128 + lane] = cm; if (lane == 0) { t[192] = bend; t[193] = bend + A63; } }
        asm volatile("s_waitcnt lgkmcnt(0)" ::: "memory");
        LAS unsigned char* buf = lds + par * MA_BUF;
        const float w = wT[srow]; const u32x4 pk = in.pk;
        u32x4 kw; kw.x = pk2(bf_lo(pk.x) * w, bf_hi(pk.x) * w); kw.y = pk2(bf_lo(pk.y) * w, bf_hi(pk.y) * w); kw.z = pk2(bf_lo(pk.z) * w, bf_hi(pk.z) * w); kw.w = pk2(bf_lo(pk.w) * w, bf_hi(pk.w) * w);
        *(LAS u32x4*)(buf + MA_KW + srow * 192 + scc * 16) = kw;
        { const int idx = tid; *(LAS u32x4*)(buf + MA_V + (idx >> 4) * 320 + (idx & 15) * 16) = in.pv0; }
        { const int idx = tid + 512; *(LAS u32x4*)(buf + MA_V + (idx >> 4) * 320 + (idx & 15) * 16) = in.pv1; }
    };
    auto body = [&](int u, int par, InA& nxt) {
        LAS unsigned char* buf = lds + par * MA_BUF;
        LDS_BARRIER();
        int lo_ = lane; asm volatile("" : "+v"(lo_));
        const int r = lo_ & 31, hh = lo_ >> 5, q16 = (lo_ & 15) >> 2, p16 = lo_ & 3, g16 = (lo_ >> 4) & 1;
        if (u + 1 < u1) stage(nxt, u + 1, par ^ 1);
        if (u + 3 < u1) issue_loads(nxt, u + 3);
        if (u > u0 && wave == 0) {
            float nl = 0.f;
#pragma unroll
            for (int w = 0; w < 8; ++w) nl += npart[((par ^ 1) * 8 + w) * 64 + lo_];
            NL[(size_t)(u - 1) * 64 + lo_] = nl;
        }
        {
            float ps = 0.f;
#pragma unroll
            for (int i = 0; i < 8; ++i) { const unsigned short v = *(const LAS unsigned short*)(buf + MA_KW + (8 * wave + i) * 192 + lo_ * 2); ps += __uint_as_float((unsigned)v << 16); }
            npart[(par * 8 + wave) * 64 + lo_] = ps;
        }
        f32x16 Cl = f32x16{};
        {
            const LAS unsigned char* vb = buf + MA_V + (8 * hh + q16) * 320 + (32 * dvs + 16 * g16 + 4 * p16) * 2;
            const LAS unsigned char* kp = buf + MA_KW + (8 * hh + q16) * 192 + (32 * kb + 16 * g16 + 4 * p16) * 2;
            bf16x8 af[4], bfv[4];
#pragma unroll
            for (int ks = 0; ks < 4; ++ks) { bfv[ks] = tr_pair(vb + (16 * ks) * 320, vb + (16 * ks + 4) * 320); af[ks] = tr_pair(kp + (16 * ks) * 192, kp + (16 * ks + 4) * 192); }
#pragma unroll
            for (int ks = 0; ks < 4; ++ks) Cl = MFMA32(af[ks], bfv[ks], Cl);
        }
        float* Co = CL + (size_t)u * 8192 + (size_t)((kb * 4 + dvs) * 64 + lo_) * 16;
#pragma unroll
        for (int g = 0; g < 4; ++g) *(f32x4*)(Co + 4 * g) = (f32x4){Cl[4 * g], Cl[4 * g + 1], Cl[4 * g + 2], Cl[4 * g + 3]};
    };
    issue_loads(X, u0); if (u0 + 1 < u1) issue_loads(Y, u0 + 1);
    stage(X, u0, 0);
    if (u0 + 2 < u1) issue_loads(X, u0 + 2);
#pragma unroll 1
    for (int u = u0; u < u1; u += 2) {
        body(u, 0, Y);
        if (u + 1 < u1) body(u + 1, 1, X);
    }
    LDS_BARRIER();
    if (wave == 0) { const int par = (u1 - 1 - u0) & 1; float nl = 0.f;
#pragma unroll
        for (int w = 0; w < 8; ++w) nl += npart[(par * 8 + w) * 64 + lane];
        NL[(size_t)(u1 - 1) * 64 + lane] = nl; }
    LDS_BARRIER();
}
DI void mlB_phase(ArgsRef a, int l, int vcu, int G, int tid) {
    const float* CL = (const float*)(a.ws + WS_CL); const float* NL = (const float*)(a.ws + WS_NL); const float* TAB = (const float*)(a.ws + WS_TAB);
    bf16_t* CP = (bf16_t*)(a.ws + WS_CP); float* NPREV = (float*)(a.ws + WS_NPREV); float* MPREV = (float*)(a.ws + WS_MPREV);
    float* out = a.out;
#pragma unroll 1
    for (int cp = vcu; cp < 256; cp += G) {
        const int chain = cp >> 2, part = cp & 3, e0 = part * 2048 + tid * 4;
        f32x4 C = (f32x4){0.f, 0.f, 0.f, 0.f}, n4 = C; float m = 0.f;
        const bool nthr = (part == 0 && tid < 16);
        const float* cl = CL + (size_t)chain * 64 * 8192 + e0; bf16_t* cpo = CP + (size_t)chain * 64 * 8192 + e0;
        const int nblk = e0 >> 10, nln = (e0 >> 4) & 63, ni0 = e0 & 15;
        const int nat0 = (32 * (nblk >> 2) + 8 * (ni0 >> 2) + 4 * (nln >> 5)) * 128 + 32 * (nblk & 3) + (nln & 31);
        float woL = 0.f, wnL = 0.f, mpL = 0.f;
        { const int ln = tid & 63; const float be = TAB[(size_t)(chain * 64 + ln) * 256 + 192], ml = TAB[(size_t)(chain * 64 + ln) * 256 + 193];
#pragma unroll 1
          for (int c = 0; c < 64; ++c) {
              const float b = __builtin_bit_cast(float, __builtin_amdgcn_readlane(__builtin_bit_cast(int, be), c)), q = __builtin_bit_cast(float, __builtin_amdgcn_readlane(__builtin_bit_cast(int, ml), c));
              const float mnew = fmaxf(b + m, q), wo = __expf(b + m - mnew), wn = __expf(q - mnew);
              if (ln == c) { woL = wo; wnL = wn; mpL = m; }
              m = mnew;
          } }
        f32x4 nb[8], nn[8];
        const float* nlp = NL + (size_t)chain * 64 * 64 + (nthr ? tid * 4 : 0);
#pragma unroll
        for (int j = 0; j < 8; ++j) { nb[j] = __builtin_nontemporal_load((const f32x4*)(cl + (size_t)j * 8192)); nn[j] = *(const f32x4*)(nlp + j * 64); }
#pragma unroll 1
        for (int cb = 0; cb < 8; ++cb) {
            f32x4 cb8[8], cn8[8];
#pragma unroll
            for (int j = 0; j < 8; ++j) { cb8[j] = nb[j]; cn8[j] = nn[j]; }
            if (cb + 1 < 8) {
#pragma unroll
                for (int j = 0; j < 8; ++j) { nb[j] = __builtin_nontemporal_load((const f32x4*)(cl + (size_t)(8 * (cb + 1) + j) * 8192)); nn[j] = *(const f32x4*)(nlp + (8 * (cb + 1) + j) * 64); }
            }
#pragma unroll
            for (int j = 0; j < 8; ++j) {
                const int c = 8 * cb + j, u = chain * 64 + c;
                const float wo = __builtin_bit_cast(float, __builtin_amdgcn_readlane(__builtin_bit_cast(int, woL), c)), wn = __builtin_bit_cast(float, __builtin_amdgcn_readlane(__builtin_bit_cast(int, wnL), c));
                { u32x2 w; w.x = pk2(C.x, C.y); w.y = pk2(C.z, C.w); *(u32x2*)(cpo + (size_t)c * 8192) = w; }
                C = C * wo + cb8[j] * wn;
                if (nthr) { *(f32x4*)(NPREV + (size_t)u * 64 + tid * 4) = n4; if (tid == 0) MPREV[u] = __builtin_bit_cast(float, __builtin_amdgcn_readlane(__builtin_bit_cast(int, mpL), c)); }
                n4 = n4 * wo + cn8[j] * wn;
            }
        }
        const size_t oidx = (size_t)(l * 64 + chain);
        { float* po = out + OFF_PC + oidx * 8192 + nat0; po[0] = C.x; po[128] = C.y; po[256] = C.z; po[384] = C.w; }
        if (nthr) { *(f32x4*)(out + OFF_PN + oidx * 64 + tid * 4) = n4; if (tid == 0) out[OFF_PM + oidx] = m; }
    }
    const int NT = G * 512, gt = vcu * 512 + tid;
    for (int i = gt; i < 256 * 2048; i += NT) {
        const int us = i >> 11, q = i & 2047, u = 4096 + us; const size_t sidx = (size_t)l * 256 + us;
        const float m = a.in[I_SM][sidx];
        const float bend = TAB[(size_t)u * 256 + 192], mloc = TAB[(size_t)u * 256 + 193];
        const float mnew = fmaxf(bend + m, mloc), wo = __expf(bend + m - mnew), wn = __expf(mloc - mnew);
        const int e = q * 4, sblk = e >> 10, sln = (e >> 4) & 63, si0 = e & 15;
        const int nat = (32 * (sblk >> 2) + 8 * (si0 >> 2) + 4 * (sln >> 5)) * 128 + 32 * (sblk & 3) + (sln & 31);
        const float* ci = a.in[I_SC] + sidx * 8192 + nat; float* co = out + OFF_SC + sidx * 8192 + nat;
        const f32x4 cl4 = *(const f32x4*)(CL + (size_t)u * 8192 + e);
        co[0] = ci[0] * wo + cl4.x * wn; co[128] = ci[128] * wo + cl4.y * wn; co[256] = ci[256] * wo + cl4.z * wn; co[384] = ci[384] * wo + cl4.w * wn;
        if (q < 16) { const f32x4 nin = *(const f32x4*)(a.in[I_SN] + sidx * 64 + q * 4), nl4 = *(const f32x4*)(NL + (size_t)u * 64 + q * 4);
            *(f32x4*)(out + OFF_SN + sidx * 64 + q * 4) = nin * wo + nl4 * wn; if (q == 0) out[OFF_SM + sidx] = mnew; }
    }
}
constexpr int MC_Q = 0, MC_K = 9216, MC_V = 18432, MC_BUF = 38912;
constexpr int MC_SCR = 2 * MC_BUF;
constexpr int MC_RED = MC_SCR + 8 * 2048, MC_HG = MC_RED + 1024;
DI void mlC_phase(ArgsRef a, LAS unsigned char* lds, int l, int vcu, int G, int tid, int wave, int lane) {
    const bf16_t* PROJ = (const bf16_t*)(a.ws + WS_PROJ);
    const float* TAB = (const float*)(a.ws + WS_TAB); const bf16_t* CP = (const bf16_t*)(a.ws + WS_CP);
    const float* NPREV = (const float*)(a.ws + WS_NPREV); const float* MPREV = (const float*)(a.ws + WS_MPREV);
    bf16_t* HG = (bf16_t*)(a.ws + WS_HG);
    const int per = (ML_NUNITS + G - 1) / G, u0 = vcu * per, u1 = (u0 + per < ML_NUNITS) ? u0 + per : ML_NUNITS;
    if (u0 >= u1) return;
    const int dvs = wave & 3, th = wave >> 2;
    LAS float* scr = (LAS float*)(lds + MC_SCR + wave * 2048);
    LAS float* red = (LAS float*)(lds + MC_RED);
    const int srow = tid >> 3, scc = tid & 7;
    LAS float* hgl = (LAS float*)(lds + MC_HG);
    for (int i = tid; i < 1024; i += 512) hgl[i] = a.in[I_MHG][(size_t)l * 1024 + i];
    struct InC { u32x4 pq, pk, pv0, pv1; float ta, tb, tc, tn; };
    InC X, Y; u32x2 ogn[4]; float mpn; bf16x8 Cn[2][2];
    auto issue_tiles = [&](InC& in, int u) {
        int rb, h; ml_unit_decode(u, rb, h);
        const bf16_t* pr = PROJ + (size_t)(rb + srow) * NPROJ;
        in.pq = *(const u32x4*)(pr + h * 64 + scc * 8);
        in.pk = *(const u32x4*)(pr + 512 + h * 64 + scc * 8);
        { const int idx = tid; in.pv0 = *(const u32x4*)(PROJ + (size_t)(rb + (idx >> 4)) * NPROJ + 1024 + h * 128 + (idx & 15) * 8); }
        { const int idx = tid + 512; in.pv1 = *(const u32x4*)(PROJ + (size_t)(rb + (idx >> 4)) * NPROJ + 1024 + h * 128 + (idx & 15) * 8); }
        const float* t = TAB + (size_t)u * 256; in.ta = t[lane]; in.tb = t[64 + lane]; in.tc = t[128 + lane];
        if (u < 4096) in.tn = NPREV[(size_t)u * 64 + lane]; else in.tn = a.in[I_SN][((size_t)l * 256 + (u - 4096)) * 64 + lane];
    };
    auto issue_regs = [&](int u) {
        int rb, h; ml_unit_decode(u, rb, h);
        const bf16_t* po = PROJ + (size_t)(rb + 32 * th + (lane & 31)) * NPROJ + 2048 + h * 128 + 32 * dvs + 4 * (lane >> 5);
#pragma unroll
        for (int g = 0; g < 4; ++g) ogn[g] = *(const u32x2*)(po + 8 * g);
        if (u < 4096) {
            mpn = MPREV[u];
#pragma unroll
            for (int kb = 0; kb < 2; ++kb) { const bf16_t* cp = CP + (size_t)u * 8192 + (size_t)((kb * 4 + dvs) * 64 + lane) * 16;
                Cn[kb][0] = *(const bf16x8*)cp; Cn[kb][1] = *(const bf16x8*)(cp + 8); }
        } else {
            const size_t sidx = (size_t)l * 256 + (u - 4096); mpn = a.in[I_SM][sidx];
            const float* Cin = a.in[I_SC] + sidx * 8192 + 32 * dvs + (lane & 31) + (lane >> 5) * 512;
#pragma unroll
            for (int kb = 0; kb < 2; ++kb) { f32x16 cf;
#pragma unroll
                for (int i = 0; i < 16; ++i) cf[i] = Cin[(32 * kb + (i & 3) + 8 * (i >> 2)) * 128];
                Cn[kb][0] = pack_step(cf, 0); Cn[kb][1] = pack_step(cf, 1); }
        }
    };
    auto stage = [&](const InC& in, int par) {
        LAS unsigned char* buf = lds + par * MC_BUF;
        *(LAS u32x4*)(buf + MC_Q + srow * 144 + scc * 16) = in.pq;
        *(LAS u32x4*)(buf + MC_K + srow * 144 + scc * 16) = in.pk;
        { const int idx = tid; *(LAS u32x4*)(buf + MC_V + (idx >> 4) * 320 + (idx & 15) * 16) = in.pv0; }
        { const int idx = tid + 512; *(LAS u32x4*)(buf + MC_V + (idx >> 4) * 320 + (idx & 15) * 16) = in.pv1; }
        scr[par * 64 + lane] = in.ta; scr[128 + par * 64 + lane] = in.tb; scr[256 + par * 64 + lane] = in.tc; scr[384 + par * 64 + lane] = in.tn;
    };
    issue_tiles(X, u0); issue_regs(u0); if (u0 + 1 < u1) issue_tiles(Y, u0 + 1);
    stage(X, 0);
    if (u0 + 2 < u1) issue_tiles(X, u0 + 2);
    LDS_BARRIER();
    auto body = [&](int u, int par, InC& nxt) {
        LAS unsigned char* buf = lds + par * MC_BUF;
        LDS_BARRIER();
        int lo_ = lane; asm volatile("" : "+v"(lo_));
        const int r = lo_ & 31, hh = lo_ >> 5, q16 = (lo_ & 15) >> 2, p16 = lo_ & 3, g16 = (lo_ >> 4) & 1;
        int rb, h; ml_unit_decode(u, rb, h);
        u32x2 og[4]; bf16x8 Cst[2][2]; const float mprev = mpn;
#pragma unroll
        for (int g = 0; g < 4; ++g) og[g] = ogn[g];
        Cst[0][0] = Cn[0][0]; Cst[0][1] = Cn[0][1]; Cst[1][0] = Cn[1][0]; Cst[1][1] = Cn[1][1];
        if (u + 1 < u1) { stage(nxt, par ^ 1); issue_regs(u + 1); }
        if (u + 3 < u1) issue_tiles(nxt, u + 3);
        const int t = 32 * th + r;
        const float bt = scr[128 + par * 64 + t], cmt = scr[256 + par * 64 + t];
        const float Mt = fmaxf(mprev, cmt), mt = bt + Mt, winter = __expf(mprev - Mt);
        f32x16 sD = f32x16{}, sF = f32x16{};
        bf16x8 qf[4];
#pragma unroll
        for (int ks = 0; ks < 4; ++ks) {
            qf[ks] = *(const LAS bf16x8*)(buf + MC_Q + t * 144 + ks * 32 + hh * 16);
            const bf16x8 kD = *(const LAS bf16x8*)(buf + MC_K + t * 144 + ks * 32 + hh * 16);
            sD = MFMA32(kD, qf[ks], sD);
        }
        if (th == 1) {
#pragma unroll
            for (int ks = 0; ks < 4; ++ks) { const bf16x8 kF = *(const LAS bf16x8*)(buf + MC_K + r * 144 + ks * 32 + hh * 16); sF = MFMA32(kF, qf[ks], sF); }
        }
        f32x16 acc = f32x16{};
#pragma unroll
        for (int kb = 0; kb < 2; ++kb)
#pragma unroll
            for (int s = 0; s < 2; ++s) {
                const LAS unsigned char* qp = buf + MC_Q + t * 144 + (32 * kb + 16 * s + 4 * hh) * 2;
                const v4i16 lo = *(const LAS v4i16*)qp, hi = *(const LAS v4i16*)(qp + 16);
                const bf16x8 qb = __builtin_shufflevector(lo, hi, 0, 1, 2, 3, 4, 5, 6, 7);
                acc = MFMA32(Cst[kb][s], qb, acc);
            }
        float psum = 0.f;
#pragma unroll
        for (int i = 0; i < 16; ++i) {
            const int s0 = crow(i, hh);
            const float w0 = __expf(scr[par * 64 + 32 * th + s0] - Mt);
            sD[i] = (s0 <= r) ? sD[i] * w0 : 0.f;
            psum += sD[i];
        }
        if (th == 1) {
#pragma unroll
            for (int i = 0; i < 16; ++i) { const float w1 = __expf(scr[par * 64 + crow(i, hh)] - Mt); sF[i] *= w1; psum += sF[i]; }
        }
        psum = xor32_sum(psum);
        float qn = 0.f;
#pragma unroll
        for (int ks = 0; ks < 4; ++ks) { const u32x4 qq = __builtin_bit_cast(u32x4, qf[ks]); const LAS float* np = scr + 384 + par * 64 + 16 * ks + 8 * hh;
            qn += bf_lo(qq.x) * np[0] + bf_hi(qq.x) * np[1] + bf_lo(qq.y) * np[2] + bf_hi(qq.y) * np[3] + bf_lo(qq.z) * np[4] + bf_hi(qq.z) * np[5] + bf_lo(qq.w) * np[6] + bf_hi(qq.w) * np[7]; }
        qn = xor32_sum(qn);
        const float den = winter * qn + psum;
        const float inv = __builtin_amdgcn_rcpf(fmaxf(fabsf(den), __expf(-mt)));
#pragma unroll
        for (int i = 0; i < 16; ++i) acc[i] *= winter;
        {
            const LAS unsigned char* vb = buf + MC_V + (4 * hh + q16) * 320 + (32 * dvs + 16 * g16 + 4 * p16) * 2;
            const LAS unsigned char* vd = vb + (32 * th) * 320;
#pragma unroll
            for (int s = 0; s < 2; ++s) { const bf16x8 vf = tr_pair(vd + (16 * s) * 320, vd + (16 * s + 8) * 320); acc = MFMA32(vf, pack_step(sD, s), acc); }
            asm volatile("" ::: "memory");
            if (th == 1) {
#pragma unroll
                for (int s = 0; s < 2; ++s) { const bf16x8 vf = tr_pair(vb + (16 * s) * 320, vb + (16 * s + 8) * 320); acc = MFMA32(vf, pack_step(sF, s), acc); }
            }
        }
        float hs = 0.f;
#pragma unroll
        for (int i = 0; i < 16; ++i) { acc[i] *= inv; hs += acc[i] * acc[i]; }
        hs = xor32_sum(hs);
        if (hh == 0) red[(th * 4 + dvs) * 32 + r] = hs;
        LDS_BARRIER();
        const float tot = red[(th * 4 + 0) * 32 + r] + red[(th * 4 + 1) * 32 + r] + red[(th * 4 + 2) * 32 + r] + red[(th * 4 + 3) * 32 + r];
        const float rstd = __builtin_amdgcn_rsqf(tot * (1.0f / 128.0f) + EPS);
#pragma unroll
        for (int g = 0; g < 4; ++g) {
            const f32x4 hgq = *(const LAS f32x4*)(hgl + h * 128 + 32 * dvs + 8 * g + 4 * hh);
            const float o0 = bf_lo(og[g].x), o1 = bf_hi(og[g].x), o2 = bf_lo(og[g].y), o3 = bf_hi(og[g].y);
            const float v0 = acc[4 * g + 0] * rstd * hgq.x * __builtin_amdgcn_rcpf(1.0f + __expf(-o0)), v1 = acc[4 * g + 1] * rstd * hgq.y * __builtin_amdgcn_rcpf(1.0f + __expf(-o1));
            const float v2 = acc[4 * g + 2] * rstd * hgq.z * __builtin_amdgcn_rcpf(1.0f + __expf(-o2)), v3 = acc[4 * g + 3] * rstd * hgq.w * __builtin_amdgcn_rcpf(1.0f + __expf(-o3));
            u32x2 o; o.x = pk2(v0, v1); o.y = pk2(v2, v3);
            *(u32x2*)(HG + (size_t)(rb + t) * D + h * 128 + 32 * dvs + 8 * g + 4 * hh) = o;
        }
    };
#pragma unroll 1
    for (int u = u0; u < u1; u += 2) {
        body(u, 0, Y);
        if (u + 1 < u1) body(u + 1, 1, X);
    }
    LDS_BARRIER();
}

constexpr int AT_HALFB = 65536;
constexpr int AT_TBL = 2 * AT_HALFB;
constexpr int AT_MISC = AT_TBL + 8192;
struct AttnHalf { const bf16_t* Q; const bf16_t* K; const bf16_t* V; int qrow0; int h, qc, t0, t1; };

template <bool SHARED, bool KSPLIT = false>
DI void attn_workunit(ArgsRef a, LAS unsigned char* lds, const AttnHalf hp, int niter, int nmax, bool merge, float lam, float onem, const LAS float* hgain,
                      int tid, int wave, int lane) {
    asm volatile("" : "+v"(lane));
    const int hw = wave >> 2, wl = wave & 3, cbr = wl >> 1, qh = wl & 1, r = lane & 31, hh = lane >> 5;
    const int q16 = (lane & 15) >> 2, p16 = lane & 3, g16 = (lane >> 4) & 1;
    LAS unsigned char* hb = lds + hw * AT_HALFB;
    const LAS float* tbl = (const LAS float*)(lds + AT_TBL) + hp.h * 256;
    bf16_t* HG = (bf16_t*)(a.ws + WS_HG);
    const int n = hp.t1 - hp.t0;
    const int wd = SHARED ? wave : wl;
    const int rowl = 4 * wd + (lane >> 4), pc = lane & 15;
    const int ck = pc ^ (rowl & 15);
    const int cv = (((pc >> 2) ^ ((lane >> 4) & 3)) << 2) | (pc & 3);
    const bf16_t* gk = hp.K + ((size_t)hp.t0 * 64 + rowl) * D + hp.h * 128 + ck * 8;
    const bf16_t* gv = hp.V + ((size_t)hp.t0 * 64 + rowl) * D + hp.h * 128 + cv * 8;
    auto kslot = [&](int j) -> LAS unsigned char* { if constexpr (SHARED) { int sj = j & 3; asm volatile("" : "+s"(sj)); return lds + sj * 32768; } else return hb + (j & 1) * 16384; };
    auto vslot = [&](int j) -> LAS unsigned char* { if constexpr (SHARED) { int sj = j & 3; asm volatile("" : "+s"(sj)); return lds + sj * 32768 + 16384; } else return hb + 32768 + (j & 1) * 16384; };
    auto dma_k = [&](int j) {
        LAS unsigned char* dst = kslot(j) + wd * 1024; const bf16_t* src = gk + (size_t)j * 64 * D;
        if constexpr (SHARED) {
#pragma unroll
            for (int q = 0; q < 2; ++q) __builtin_amdgcn_global_load_lds((const unsigned*)(src + q * 32 * D), (LAS unsigned*)(dst + q * 8192), 16, 0, KSPLIT ? 2 : 0);
        } else {
#pragma unroll
            for (int q = 0; q < 4; ++q) __builtin_amdgcn_global_load_lds((const unsigned*)(src + q * 16 * D), (LAS unsigned*)(dst + q * 4096), 16, 0, 0);
        }
    };
    auto dma_v = [&](int j) {
        LAS unsigned char* dst = vslot(j) + wd * 1024; const bf16_t* src = gv + (size_t)j * 64 * D;
        if constexpr (SHARED) {
#pragma unroll
            for (int q = 0; q < 2; ++q) __builtin_amdgcn_global_load_lds((const unsigned*)(src + q * 32 * D), (LAS unsigned*)(dst + q * 8192), 16, 0, KSPLIT ? 2 : 0);
        } else {
#pragma unroll
            for (int q = 0; q < 4; ++q) __builtin_amdgcn_global_load_lds((const unsigned*)(src + q * 16 * D), (LAS unsigned*)(dst + q * 4096), 16, 0, 0);
        }
    };
    int ka[4], va[4];
    { const int y = (cbr * 8 + hh) ^ (r & 15);
#pragma unroll
      for (int ks = 0; ks < 4; ++ks) ka[ks] = r * 256 + ((y ^ (2 * ks)) << 4);
#pragma unroll
      for (int d = 0; d < 4; ++d) va[d] = (4 * hh + q16) * 256 + ((d ^ q16) << 6) + 32 * g16 + 8 * p16; }
    if constexpr (SHARED) {
        if (nmax > 0) { dma_k(0); dma_v(0); }
        if (nmax > 1) { dma_k(1); dma_v(1); }
        if (nmax > 2) { dma_k(2); dma_v(2); }
    } else {
        if (n > 0) { dma_k(0); dma_v(0); }
        if (n > 1) dma_k(1);
    }
    bf16x8 qf[4];
    { const bf16_t* qp = hp.Q + (size_t)(hp.qrow0 + 32 * qh + r) * D + hp.h * 128 + cbr * 64 + 8 * hh;
#pragma unroll
      for (int ks = 0; ks < 4; ++ks) qf[ks] = *(const bf16x8*)(qp + 16 * ks); }
    f32x16 O[4]; O[0] = f32x16{}; O[1] = f32x16{}; O[2] = f32x16{}; O[3] = f32x16{};
    float mrun = 0.f, lrun = 0.f;
    const float c15 = tbl[0];
    f32x16 cb;
#pragma unroll
    for (int i = 0; i < 16; ++i) cb[i] = c15;
    const int qq = 32 * qh + r;
    auto qk = [&](f32x16& sA, f32x16& sB, int j) {
        const LAS unsigned char* Kt = kslot(j);
        const int dt = hp.qc - (hp.t0 + j);
        bf16x8 kf[8];
#pragma unroll
        for (int ks = 0; ks < 4; ++ks) { kf[2 * ks] = *(const LAS bf16x8*)(Kt + ka[ks]); kf[2 * ks + 1] = *(const LAS bf16x8*)(Kt + ka[ks] + 8192); }
        if (dt >= 3) {
            sA = MFMA32(kf[0], qf[0], cb); sB = MFMA32(kf[1], qf[0], cb);
        } else {
            const int base = 192 - 64 * dt - qq;
#pragma unroll
            for (int i = 0; i < 16; ++i) { sA[i] = tbl[base + crow(i, hh)] - mrun; sB[i] = tbl[base + 32 + crow(i, hh)] - mrun; }
            sA = MFMA32(kf[0], qf[0], sA); sB = MFMA32(kf[1], qf[0], sB);
        }
#pragma unroll
        for (int ks = 1; ks < 4; ++ks) { sA = MFMA32(kf[2 * ks], qf[ks], sA); sB = MFMA32(kf[2 * ks + 1], qf[ks], sB); }
    };
    auto step = [&](int i, f32x16& sA, f32x16& sB, f32x16& nA, f32x16& nB) {
        if constexpr (SHARED) {
            if (i + 2 < nmax) asm volatile("s_waitcnt vmcnt(4) lgkmcnt(0)" ::: "memory"); else asm volatile("s_waitcnt vmcnt(0) lgkmcnt(0)" ::: "memory");
            __builtin_amdgcn_s_barrier(); asm volatile("" ::: "memory");
            if (i + 3 < nmax) { dma_k(i + 3); dma_v(i + 3); }
        } else {
            asm volatile("s_waitcnt vmcnt(0) lgkmcnt(0)" ::: "memory");
            __builtin_amdgcn_s_barrier(); asm volatile("" ::: "memory");
            if (i + 2 < n) dma_k(i + 2);
            if (i + 1 < n) dma_v(i + 1);
        }
        if (i < n) {
            qk(nA, nB, i + 1);
            const LAS unsigned char* Vt = vslot(i);
            float mx0 = max3f(sA[0], sB[0], sA[1]), mx1 = max3f(sB[1], sA[2], sB[2]);
#pragma unroll
            for (int k = 3; k < 15; k += 2) { mx0 = max3f(mx0, sA[k], sB[k]); mx1 = max3f(mx1, sA[k + 1], sB[k + 1]); }
            float mx = max3f(mx0, mx1, sA[15]); mx = max3f(mx, sB[15], sB[15]); mx = xor32_max(mx);
            if (__any(mx > 6.0f)) {
                const float dm = fmaxf(mx, 0.f), alpha = __builtin_amdgcn_exp2f(-dm);
                mrun += dm; lrun *= alpha;
#pragma unroll
                for (int k = 0; k < 16; ++k) { sA[k] -= dm; sB[k] -= dm; nA[k] -= dm; nB[k] -= dm; cb[k] -= dm; }
#pragma unroll
                for (int d = 0; d < 4; ++d)
#pragma unroll
                    for (int k = 0; k < 16; ++k) O[d][k] *= alpha;
            }
            float ps = lrun;
#pragma unroll
            for (int k = 0; k < 8; ++k) { sA[k] = __builtin_amdgcn_exp2f(sA[k]); sB[k] = __builtin_amdgcn_exp2f(sB[k]); ps = ps + sA[k]; ps = ps + sB[k]; }
            const bf16x8 pA0 = pack_step(sA, 0), pB0 = pack_step(sB, 0);
            bf16x8 vf[4];
#pragma unroll
            for (int dh = 0; dh < 2; ++dh) {
#pragma unroll
                for (int d2 = 0; d2 < 2; ++d2) { const int d = 2 * dh + d2; vf[2 * d2] = tr_pair(Vt + va[d], Vt + va[d] + 8 * 256); vf[2 * d2 + 1] = tr_pair(Vt + va[d] + 32 * 256, Vt + va[d] + 40 * 256); }
#pragma unroll
                for (int d2 = 0; d2 < 2; ++d2) { const int d = 2 * dh + d2; O[d] = MFMA32(vf[2 * d2], pA0, O[d]); O[d] = MFMA32(vf[2 * d2 + 1], pB0, O[d]); }
            }
#pragma unroll
            for (int k = 8; k < 16; ++k) { sA[k] = __builtin_amdgcn_exp2f(sA[k]); sB[k] = __builtin_amdgcn_exp2f(sB[k]); ps = ps + sA[k]; ps = ps + sB[k]; }
            lrun = ps;
            const bf16x8 pA1 = pack_step(sA, 1), pB1 = pack_step(sB, 1);
#pragma unroll
            for (int dh = 0; dh < 2; ++dh) {
#pragma unroll
                for (int d2 = 0; d2 < 2; ++d2) { const int d = 2 * dh + d2; vf[2 * d2] = tr_pair(Vt + va[d] + 16 * 256, Vt + va[d] + 24 * 256); vf[2 * d2 + 1] = tr_pair(Vt + va[d] + 48 * 256, Vt + va[d] + 56 * 256); }
#pragma unroll
                for (int d2 = 0; d2 < 2; ++d2) { const int d = 2 * dh + d2; O[d] = MFMA32(vf[2 * d2], pA1, O[d]); O[d] = MFMA32(vf[2 * d2 + 1], pB1, O[d]); }
            }
        }
    };
    f32x16 s0A, s0B, s1A, s1B;
    asm volatile("s_waitcnt vmcnt(0) lgkmcnt(0)" ::: "memory");
    __builtin_amdgcn_s_barrier(); asm volatile("" ::: "memory");
    if constexpr (KSPLIT) {
        auto qk1 = [&](f32x16& sA, int j) {
            const LAS unsigned char* Kt = kslot(j) + hw * 8192;
            const int dt = hp.qc - (hp.t0 + j);
            bf16x8 kf[4];
#pragma unroll
            for (int ks = 0; ks < 4; ++ks) kf[ks] = *(const LAS bf16x8*)(Kt + ka[ks]);
            if (dt >= 3) {
                sA = MFMA32(kf[0], qf[0], cb);
            } else {
                const int base = 192 - 64 * dt - qq + 32 * hw;
#pragma unroll
                for (int i = 0; i < 16; ++i) sA[i] = tbl[base + crow(i, hh)] - mrun;
                sA = MFMA32(kf[0], qf[0], sA);
            }
#pragma unroll
            for (int ks = 1; ks < 4; ++ks) sA = MFMA32(kf[ks], qf[ks], sA);
        };
        auto step1 = [&](int i, f32x16& sA, f32x16& nA) {
            if (i + 2 < nmax) asm volatile("s_waitcnt vmcnt(4) lgkmcnt(0)" ::: "memory"); else asm volatile("s_waitcnt vmcnt(0) lgkmcnt(0)" ::: "memory");
            __builtin_amdgcn_s_barrier(); asm volatile("" ::: "memory");
            if (i + 3 < nmax) { dma_k(i + 3); dma_v(i + 3); }
            if (i < n) {
                qk1(nA, i + 1);
                const LAS unsigned char* Vt = vslot(i) + hw * 8192;
                float mx0 = max3f(sA[0], sA[1], sA[2]), mx1 = max3f(sA[3], sA[4], sA[5]);
#pragma unroll
                for (int k = 6; k < 14; k += 4) { mx0 = max3f(mx0, sA[k], sA[k + 1]); mx1 = max3f(mx1, sA[k + 2], sA[k + 3]); }
                float mx = max3f(mx0, mx1, sA[14]); mx = max3f(mx, sA[15], sA[15]); mx = xor32_max(mx);
                if (__any(mx > 6.0f)) {
                    const float dm = fmaxf(mx, 0.f), alpha = __builtin_amdgcn_exp2f(-dm);
                    mrun += dm; lrun *= alpha;
#pragma unroll
                    for (int k = 0; k < 16; ++k) { sA[k] -= dm; nA[k] -= dm; cb[k] -= dm; }
#pragma unroll
                    for (int d = 0; d < 4; ++d)
#pragma unroll
                        for (int k = 0; k < 16; ++k) O[d][k] *= alpha;
                }
                float ps = 0.f;
#pragma unroll
                for (int k = 0; k < 8; ++k) { sA[k] = __builtin_amdgcn_exp2f(sA[k]); ps += sA[k]; }
                const bf16x8 qA0 = pack_step(sA, 0);
                bf16x8 vf[4];
#pragma unroll
                for (int d = 0; d < 4; ++d) vf[d] = tr_pair(Vt + va[d], Vt + va[d] + 8 * 256);
#pragma unroll
                for (int d = 0; d < 4; ++d) O[d] = MFMA32(vf[d], qA0, O[d]);
#pragma unroll
                for (int k = 8; k < 16; ++k) { sA[k] = __builtin_amdgcn_exp2f(sA[k]); ps += sA[k]; }
                lrun += ps;
                const bf16x8 qA1 = pack_step(sA, 1);
#pragma unroll
                for (int d = 0; d < 4; ++d) vf[d] = tr_pair(Vt + va[d] + 16 * 256, Vt + va[d] + 24 * 256);
#pragma unroll
                for (int d = 0; d < 4; ++d) O[d] = MFMA32(vf[d], qA1, O[d]);
            }
        };
        qk1(s0A, 0);
#pragma unroll 1
        for (int it = 0; it < niter; it += 2) { step1(it, s0A, s1A); step1(it + 1, s1A, s0A); }
    } else {
    qk(s0A, s0B, 0);
#pragma unroll 1
    for (int it = 0; it < niter; it += 2) {
        step(it, s0A, s0B, s1A, s1B);
        step(it + 1, s1A, s1B, s0A, s0B);
    }
    }
    asm volatile("s_waitcnt vmcnt(0)" ::: "memory");
    LDS_BARRIER();
    LAS float* X = (LAS float*)lds;
    if (merge) {
        if (hw == 1) {
            LAS float* xp = X + wl * 66 * 64 + lane;
#pragma unroll
            for (int d = 0; d < 4; ++d)
#pragma unroll
                for (int i = 0; i < 16; ++i) xp[(16 * d + i) * 64] = O[d][i];
            xp[64 * 64] = mrun; xp[65 * 64] = lrun;
        }
        LDS_BARRIER();
        if (hw == 0) {
            const LAS float* xp = X + wl * 66 * 64 + lane;
            const float m2 = xp[64 * 64], l2 = xp[65 * 64];
            const float mn = fmaxf(mrun, m2), f1 = __builtin_amdgcn_exp2f(mrun - mn), f2 = __builtin_amdgcn_exp2f(m2 - mn);
#pragma unroll
            for (int d = 0; d < 4; ++d)
#pragma unroll
                for (int i = 0; i < 16; ++i) O[d][i] = O[d][i] * f1 + xp[(16 * d + i) * 64] * f2;
            lrun = lrun * f1 + l2 * f2; mrun = mn;
        }
        LDS_BARRIER();
    }
    const float ltot = xor32_sum(lrun);
    const float linv = 1.0f / ltot;
    LAS float* xb = (LAS float*)(lds + hw * AT_HALFB) + qh * 64 * 64 + lane;
    if (cbr == 1) {
#pragma unroll
        for (int d = 0; d < 4; ++d)
#pragma unroll
            for (int i = 0; i < 16; ++i) xb[(16 * d + i) * 64] = O[d][i] * linv;
    }
    LDS_BARRIER();
    if (cbr == 0 && !(merge && hw == 1)) {
        float ssq = 0.f;
#pragma unroll
        for (int d = 0; d < 4; ++d)
#pragma unroll
            for (int i = 0; i < 16; ++i) { const float v = O[d][i] * linv - lam * xb[(16 * d + i) * 64]; O[d][i] = v; ssq += v * v; }
        ssq = xor32_sum(ssq);
        const float rs = __builtin_amdgcn_rsqf(ssq * (1.0f / 128.0f) + EPS) * onem;
        bf16_t* op = HG + (size_t)(hp.qrow0 + 32 * qh + r) * D + hp.h * 128;
#pragma unroll
        for (int d = 0; d < 4; ++d)
#pragma unroll
            for (int gp = 0; gp < 2; ++gp) {
                u32x2 o[2];
#pragma unroll
                for (int q = 0; q < 2; ++q) { const int g = 2 * gp + q; const f32x4 g4 = *(const LAS f32x4*)(hgain + 32 * d + 8 * g + 4 * hh);
                    o[q].x = pk2(O[d][4 * g] * rs * g4.x, O[d][4 * g + 1] * rs * g4.y); o[q].y = pk2(O[d][4 * g + 2] * rs * g4.z, O[d][4 * g + 3] * rs * g4.w); }
                const auto sx = __builtin_amdgcn_permlane32_swap(o[0].x, o[1].x, false, false), sy = __builtin_amdgcn_permlane32_swap(o[0].y, o[1].y, false, false);
                u32x4 w; w.x = sx[0]; w.y = sy[0]; w.z = sx[1]; w.w = sy[1];
                *(u32x4*)(op + 32 * d + 16 * gp + 8 * hh) = w;
            }
    }
    LDS_BARRIER();
}
DI int rel_bucket(int rel) {
    const int n = rel < 0 ? -rel : rel; int b;
    if (n < 8) b = n; else { const int lg = 31 - __builtin_clz((unsigned)(n * n)); b = 2 + lg; if (b > 15) b = 15; }
    return (rel > 0 ? 16 : 0) + b;
}
DI void attn_phase(ArgsRef a, LAS unsigned char* lds, int j  , int vcu, int G, int tid, int wave, int lane) {
    LAS float* tbl = (LAS float*)(lds + AT_TBL);
    for (int i = tid; i < 8 * 256; i += 512) { const int h = i >> 8, rel = (i & 255) - 192; tbl[i] = a.in[I_RELB][rel_bucket(rel) * 8 + h] * LOG2E; }
    LAS float* misc = (LAS float*)(lds + AT_MISC);
    if (wave == 0) {
        const float* lp = a.in[I_LAM] + (size_t)j * 256;
        const float s1 = wave_sum(lp[lane] * lp[64 + lane]), s2 = wave_sum(lp[128 + lane] * lp[192 + lane]);
        if (lane == 0) misc[0] = expf(s1) - expf(s2);
    }
    LDS_BARRIER();
    const int l = 2 + j;
    const float lam_init = 0.8f - 0.6f * expf(-0.3f * (float)l);
    const float lam = misc[0] + lam_init, onem = 1.0f - lam_init;
    { LAS float* hgl = (LAS float*)(lds + AT_MISC + 64); if (tid < 128) hgl[tid] = a.in[I_AHG][(size_t)j * 128 + tid]; }
    const LAS float* hgain = (const LAS float*)(lds + AT_MISC + 64);
    const bf16_t* Q = (const bf16_t*)(a.ws + WS_PROJ);
    const bf16_t* KP = (const bf16_t*)(a.ws + WS_KP); const bf16_t* VP = (const bf16_t*)(a.ws + WS_VP);
    const bf16_t* KS = (const bf16_t*)(a.ws + WS_KS); const bf16_t* VS = (const bf16_t*)(a.ws + WS_VS);
    const int hw = wave >> 2;
#pragma unroll 1
    for (int v = vcu; v < 256; v += G) {
        const int xg = v >> 5, jj = v & 31;
        {
            const int b = v >> 3;
            AttnHalf hp; hp.Q = Q; hp.K = KS + (size_t)b * KSROWS * D; hp.V = VS + (size_t)b * KSROWS * D; hp.qrow0 = MP + b * 64; hp.h = v & 7; hp.qc = 64;
            hp.t0 = 0; hp.t1 = 65;
            for (int rep = 0; rep < REP_N(11); ++rep)
            attn_workunit<true, true>(a, lds, hp, 65, 65, true, lam, onem, hgain, tid, wave, lane);
        }
#pragma unroll 1
        for (int h = 0; h < 8; ++h) {
            const int c = (h & 1) ? 31 - jj : jj, qc = 2 * c + hw;
            AttnHalf hp; hp.Q = Q; hp.K = KP + (size_t)xg * 4096 * D; hp.V = VP + (size_t)xg * 4096 * D; hp.qrow0 = xg * 4096 + qc * 64; hp.h = h; hp.qc = qc;
            hp.t0 = 0; hp.t1 = qc + 1;
            for (int rep = 0; rep < REP_N(12); ++rep)
            attn_workunit<true>(a, lds, hp, 2 * c + 2, 2 * c + 2, false, lam, onem, hgain, tid, wave, lane);
        }
    }
}

constexpr int N_PHASES = 35;
__host__ __device__ constexpr bool phase_exists(int p) { return p == 0 || (((p - 1) % 9) < 7) || ((p - 1) / 9 == 1); }

__global__ void __launch_bounds__(NWAVES * 64, 2) yoco_fwd(Args args) {
    extern __shared__ __attribute__((aligned(16))) unsigned char lds_raw[];
    LAS unsigned char* lds = (LAS unsigned char*)lds_raw;
    volatile LAS unsigned* MISC = (volatile LAS unsigned*)(lds + MISC_OFF);
#define PH_IDS const int tid = opaque_tid(wv0), lane = tid & 63, wave = __builtin_amdgcn_readfirstlane(tid >> 6)
    const int G = gridDim.x; const int bx = blockIdx.x; const int vcu = (G % 8 == 0) ? (bx % 8) * (G / 8) + bx / 8 : bx;
    unsigned char* ws = args.ws;
    const int wv0 = __builtin_amdgcn_readfirstlane((int)threadIdx.x >> 6);
    if (threadIdx.x < 32) MISC[threadIdx.x] = 0u;
    __syncthreads();
    XcdBarrier bar; bar.bar = (unsigned*)(ws + WS_CTL) + 4096; bar.x = 0; bar.w0 = wv0; bar.st = nullptr;
#if MK_SINGLE_LAUNCH
    bar = xcd_barrier_post((unsigned*)(ws + WS_CTL) + 4096, wv0, MISC + 8);
#endif
    const int lo = args.ph_lo, hi = args.ph_hi;
#define IN(k) (lo <= (k) && (k) < hi)
#define REP_BEGIN(k) for (int rep = 0; rep < REP_N(k); ++rep) { if (rep) xcd_barrier(bar);
#define REP_END }
#if MK_SINGLE_LAUNCH
#define SEAM(k) do { if ((k) + 1 < hi) xcd_barrier(bar); } while (0)
#else
#define SEAM(k) do { } while (0)
#endif
#define PH_PTRS ArgsRef A = kargs(); unsigned char* ws = A.ws; float* X = A.out + OFF_Y; const float* mod = (const float*)(ws + WS_MOD); bf16_t* XB = (bf16_t*)(ws + WS_XB); \
    bf16_t* XM = (bf16_t*)(ws + WS_XM); bf16_t* HGb = (bf16_t*)(ws + WS_HG); bf16_t* PROJ = (bf16_t*)(ws + WS_PROJ); bf16_t* HID = (bf16_t*)(ws + WS_HID); \
    (void)X; (void)mod; (void)XB; (void)XM; (void)HGb; (void)PROJ; (void)HID
#define PH_LPTRS PH_PTRS; const float* modl = mod + (size_t)l * 40 * 6144; \
    const void* xP = l == 0 ? (const void*)A.in[I_XP] : (const void*)XB; const void* xS = l == 0 ? (const void*)A.in[I_XS] : (const void*)(XB + (size_t)MP * D); (void)modl; (void)xP; (void)xS

    if (PH_ON(0) && IN(0)) {
        PH_PTRS;
        PH_IDS;
        REP_BEGIN(0)
        prologue_weights(A, lds, vcu * NWAVES + wave, G * NWAVES, wave, lane, 0);
        __syncthreads();
        prologue_adaln(A, lds, vcu, G, tid, wave, lane);
        REP_END
        SEAM(0);
    }
#pragma unroll 1
    for (int l = 0; l < 4; ++l) {
        const int pb = 1 + 9 * l;
        if (PH_ON(1) && IN(pb + 0) && l != 2) {
            PH_LPTRS;
            PH_IDS;
            REP_BEGIN(1)
            if (l < 2) norm_phase<true, true>(A, lds, xP, xS, l != 0, A.in[I_NORMG] + (size_t)(l * 2 + 0) * D, modl, 0, 1024, A.in[I_WIN] + (size_t)l * 1024 * MIN + NPROJ, A.in[I_BG] + l * 16, vcu, G, tid, wave, lane);
            else norm_phase<true, false>(A, lds, xP, xS, 1, A.in[I_NORMG] + (size_t)(l * 2 + 0) * D, modl, 0, 1024, nullptr, nullptr, vcu, G, tid, wave, lane);
            REP_END
            SEAM(pb + 0);
        }
        if (IN(pb + 1) && l != 2) {
            PH_LPTRS;
            REP_BEGIN(2)
            if (!PH_ON(2)) {} else if (l < 2) {
                pg8::Gemm g{XM, (const bf16_t*)(ws + WS_WIN) + (size_t)l * NPROJ * 1024, M, NPROJ, 1024}; pg8::StaticOrder S; S.init(M, NPROJ, G, bx);
                EpiProj E{PROJ};
                pg8::gemm_phase<EpiProj, pg8::StaticOrder, true, true>(lds, g, S, E, wv0);
                {
                    const int nfull = ((M / 256) * (NPROJ / 256)) % G;
                    if (bx >= nfull) prologue_cache(A, (bx - nfull) * 512 + opaque_tid(wv0), (G - nfull) * 512, l == 0 ? 0L : CACHE_T0, l == 0 ? CACHE_T0 : CACHE_T1);
                }
            } else {
                pg8::Gemm g{XM, (const bf16_t*)(ws + WS_WQ) + (size_t)(l - 2) * 1048576, MP, 1024, 1024}; pg8::StaticOrder S; S.init(MP, 1024, G, bx);
                EpiQ E{PROJ, A.in[I_QG] + (l - 2) * 64, 0.125f * LOG2E};
                pg8::gemm_phase<EpiQ, pg8::StaticOrder, true, true>(lds, g, S, E, wv0);
                const int tid = opaque_tid(wv0), wave = __builtin_amdgcn_readfirstlane(tid >> 6), lane = tid & 63;
                EpiQSmall Es{PROJ + (size_t)MP * D, A.in[I_QG] + (l - 2) * 64, 0.125f * LOG2E, (LAS float*)(lds + 2 * GS_BUF)};
                gemm_small<EpiQSmall, true>(lds, XM + (size_t)MP * D, (const bf16_t*)(ws + WS_WQ) + (size_t)(l - 2) * 1048576, 32, 8, 1024, Es, vcu, G, tid, wave, lane);
            }
            REP_END
            SEAM(pb + 1);
        }
        if (IN(pb + 2)) {
            PH_LPTRS;
            PH_IDS;
            if (l < 2) { if (PH_ON(3)) for (int rep = 0; rep < REP_N(3); ++rep) { if (rep) xcd_barrier(bar);
                if ((ML3_MASK >> l) & 1) {
                    mlA_phase(A, lds, vcu, G, tid, wave, lane); xcd_barrier(bar);
                    mlB_phase(A, l, vcu, G, tid); xcd_barrier(bar);
                    mlC_phase(A, lds, l, vcu, G, tid, wave, lane);
                } else mlstm_phase(A, lds, l, vcu, G, tid, wave, lane); } }
            else if (PH_ON(4)) for (int rep = 0; rep < REP_N(4); ++rep) { if (rep) xcd_barrier(bar); attn_phase(A, lds, l - 2, vcu, G, tid, wave, lane); }
            SEAM(pb + 2);
        }
        if (PH_ON(5) && IN(pb + 3)) {
            PH_LPTRS;
            PH_IDS;
            REP_BEGIN(5)
            {
                pg8::Gemm g{HGb, (const bf16_t*)(ws + WS_WMO) + (size_t)l * 1048576, MP, 1024, 1024}; pg8::StaticOrder S; S.init(MP, 1024, G, bx);
                EpiRes E{xP, xS, (REP_N(5) == 2 && rep == 0) ? (void*)(ws + WS_HID) : (void*)XB, modl + 2048, l != 0, 1};
                pg8::gemm_phase<EpiRes, pg8::StaticOrder, true, true>(lds, g, S, E, wv0);
            }
            {
                bf16_t* Xs = ((REP_N(5) == 2 && rep == 0) ? (bf16_t*)(ws + WS_HID) : XB) + (size_t)MP * D;
                EpiResSmall E{xS, Xs, modl + 2048, l != 0, 1};
                gemm_small<EpiResSmall>(lds, HGb + (size_t)MP * D, (const bf16_t*)(ws + WS_WMO) + (size_t)l * 1048576, 32, 8, 1024, E, vcu, G, tid, wave, lane);
            }
            REP_END
            SEAM(pb + 3);
        }
        if (PH_ON(6) && IN(pb + 4)) {
            PH_LPTRS;
            PH_IDS;
            REP_BEGIN(6)
            norm_phase<true, false>(A, lds, XB, XB + (size_t)MP * D, 1, A.in[I_NORMG] + (size_t)(l * 2 + 1) * D, modl, 3072, 4096, nullptr, nullptr, vcu, G, tid, wave, lane);
            REP_END
            SEAM(pb + 4);
        }
        if (PH_ON(7) && IN(pb + 5)) {
            PH_LPTRS;
            pg8::Gemm g{XM, (const bf16_t*)(ws + WS_WGU) + (size_t)l * 5632 * 1024, M, 5632, 1024}; pg8::StaticOrder S; S.init(M, 5632, G, bx);
            REP_BEGIN(7)
            EpiSwiglu E{HID};
            pg8::gemm_phase<EpiSwiglu, pg8::StaticOrder, true, true>(lds, g, S, E, wv0);
            REP_END
            if (l < 2) {
                const int nfull = ((M / 256) * (5632 / 256)) % G;
                if (bx >= nfull) prologue_cache(A, (bx - nfull) * 512 + opaque_tid(wv0), (G - nfull) * 512, l == 0 ? CACHE_T1 : CACHE_T2, l == 0 ? CACHE_T2 : CACHE_T3);
            }
            SEAM(pb + 5);
        }
        if (PH_ON(8) && IN(pb + 6)) {
            PH_LPTRS;
            PH_IDS;
            REP_BEGIN(8)
            {
                pg8::Gemm g{HID, (const bf16_t*)(ws + WS_WD) + (size_t)l * 1024 * DFF, MP, 1024, DFF}; pg8::StaticOrder S; S.init(MP, 1024, G, bx);
                EpiRes E{XB, XB + (size_t)MP * D, (REP_N(8) == 2 && rep == 0) ? (void*)(ws + WS_PROJ) : (l == 3 ? (void*)X : (void*)XB), modl + 5120, 1, (REP_N(8) == 2 && rep == 0) ? 1 : (l != 3)};
                pg8::gemm_phase<EpiRes, pg8::StaticOrder, true, true>(lds, g, S, E, wv0);
            }
            {
                const int obf = (REP_N(8) == 2 && rep == 0) ? 1 : (l != 3);
                void* Xo = (REP_N(8) == 2 && rep == 0) ? (void*)((bf16_t*)(ws + WS_PROJ) + (size_t)MP * D) : (l == 3 ? (void*)(X + (size_t)MP * D) : (void*)(XB + (size_t)MP * D));
                EpiResSmall E{XB + (size_t)MP * D, Xo, modl + 5120, 1, obf};
                gemm_small<EpiResSmall>(lds, HID + (size_t)MP * DFF, (const bf16_t*)(ws + WS_WD) + (size_t)l * 1024 * DFF, 32, 8, DFF, E, vcu, G, tid, wave, lane);
            }
            REP_END
            SEAM(pb + 6);
        }
        if (l == 1) {
            if (PH_ON(9) && IN(pb + 7)) {
                PH_LPTRS;
                PH_IDS;
                REP_BEGIN(9)
                norm_dual_phase(A, XB, XM, (bf16_t*)(ws + WS_HID), A.in[I_KVG], A.in[I_NORMG] + (size_t)(2 * 2 + 0) * D, mod + (size_t)2 * 40 * 6144, 0, 1024, vcu, G, wave, lane);
                REP_END
                SEAM(pb + 7);
            }
            if (PH_ON(10) && IN(pb + 8)) {
                PH_LPTRS;
                pg8::Gemm g{XM, (const bf16_t*)(ws + WS_WKV), MP, 2048, 1024}; pg8::StaticOrder S; S.init(MP, 2048, G, bx);
                REP_BEGIN(10)
                EpiKV E{A.out, ws, A.in[I_KG]};
                pg8::gemm_phase<EpiKV, pg8::StaticOrder, true, true>(lds, g, S, E, wv0);
                REP_END
                {
                    pg8::Gemm gq{(const bf16_t*)(ws + WS_HID), (const bf16_t*)(ws + WS_WQ), MP, 1024, 1024}; pg8::StaticOrder Sq; Sq.init(MP, 1024, G, bx);
                    EpiQ Eq{PROJ, A.in[I_QG], 0.125f * LOG2E};
                    pg8::gemm_phase<EpiQ, pg8::StaticOrder, true, true>(lds, gq, Sq, Eq, wv0);
                }
                {
                    const int tid = opaque_tid(wv0), wave = __builtin_amdgcn_readfirstlane(tid >> 6), lane = tid & 63;
                    LAS float* Xn = (LAS float*)(lds + 2 * GS_BUF);
                    EpiKVSmall<true> Ek{A.out + OFF_SK, (bf16_t*)(ws + WS_KS), A.in[I_KG], Xn};
                    gemm_small<EpiKVSmall<true>, true>(lds, XM + (size_t)MP * D, (const bf16_t*)(ws + WS_WKV), 32, 8, 1024, Ek, vcu, G, tid, wave, lane);
                    EpiKVSmall<false> Ev{A.out + OFF_SV, (bf16_t*)(ws + WS_VS), nullptr, Xn};
                    gemm_small<EpiKVSmall<false>, false>(lds, XM + (size_t)MP * D, (const bf16_t*)(ws + WS_WKV) + 1048576, 32, 8, 1024, Ev, vcu, G, tid, wave, lane);
                    EpiQSmall Es{PROJ + (size_t)MP * D, A.in[I_QG], 0.125f * LOG2E, Xn};
                    gemm_small<EpiQSmall, true>(lds, (const bf16_t*)(ws + WS_HID) + (size_t)MP * D, (const bf16_t*)(ws + WS_WQ), 32, 8, 1024, Es, vcu, G, tid, wave, lane);
                }
                SEAM(pb + 8);
            }
        }
    }
#undef IN
#undef SEAM
}

extern "C" void kernel_launch(void* const* d_in, const int* in_sizes, int n_in, void* d_out, int out_size, void* d_ws, size_t ws_size, hipStream_t stream) {
    static int grid = 0;
    if (grid == 0) {
        if (n_in != 29 || out_size != OUT_TOTAL || ws_size < WS_END) { fprintf(stderr, "kernel_launch: unexpected shapes: n_in %d out %d ws %zu\n", n_in, out_size, ws_size); grid = -1; return; }
        int dev = 0, cus = 0, per_cu = 0;
        if (hipGetDevice(&dev) != hipSuccess || hipDeviceGetAttribute(&cus, hipDeviceAttributeMultiprocessorCount, dev) != hipSuccess) { grid = -1; return; }
        if (hipFuncSetAttribute((const void*)yoco_fwd, hipFuncAttributeMaxDynamicSharedMemorySize, LDS_BYTES) != hipSuccess) { fprintf(stderr, "kernel_launch: hipFuncSetAttribute failed\n"); grid = -1; return; }
        if (hipOccupancyMaxActiveBlocksPerMultiprocessor(&per_cu, (const void*)yoco_fwd, NWAVES * 64, LDS_BYTES) != hipSuccess || per_cu < 1)
            fprintf(stderr, "kernel_launch: note: occupancy query reports %d workgroups per CU\n", per_cu);
        (void)hipGetLastError();
        grid = cus;
    }
    if (grid < 0) return;
    if (hipMemsetAsync((char*)d_ws + WS_CTL, 0, CTL_ZERO_BYTES, stream) != hipSuccess) { fprintf(stderr, "kernel_launch: memset failed\n"); return; }
    Args a{};
    for (int i = 0; i < 29; ++i) a.in[i] = (const float*)d_in[i];
    a.out = (float*)d_out; a.ws = (unsigned char*)d_ws;
#if MK_SINGLE_LAUNCH
    a.ph_lo = 0; a.ph_hi = N_PHASES;
    hipLaunchKernelGGL(yoco_fwd, dim3(grid), dim3(NWAVES * 64), LDS_BYTES, stream, a);
#else
    for (int p = 0; p < N_PHASES; ++p) {
        if (!phase_exists(p)) continue;
        a.ph_lo = p; a.ph_hi = p + 1;
        hipLaunchKernelGGL(yoco_fwd, dim3(grid), dim3(NWAVES * 64), LDS_BYTES, stream, a);
    }
#endif
    const hipError_t le = hipPeekAtLastError();
    if (le != hipSuccess) fprintf(stderr, "kernel_launch: launch failed: %s\n", hipGetErrorName(le));
}
```

```cpp
#include <hip/hip_runtime.h>
#include <cstdio>
#include <cstdint>

#ifndef PH_MASK
#define PH_MASK 0xFFFF
#endif
#define PH_ON(k) (((PH_MASK) >> (k)) & 1)
#ifndef REP_MASK
#define REP_MASK 0
#endif
#define REP_N(k) ((((REP_MASK) >> (k)) & 1) ? 2 : 1)
#ifndef ML3_MASK
#define ML3_MASK 0x2
#endif
#ifndef MK_SINGLE_LAUNCH
#define MK_SINGLE_LAUNCH 1
#endif

#define DI __device__ __forceinline__
#define LAS __attribute__((address_space(3)))
#define GAS __attribute__((address_space(1)))

typedef unsigned short bf16_t;
typedef short bf16x8 __attribute__((ext_vector_type(8)));
typedef short v4i16 __attribute__((ext_vector_type(4)));
typedef float f32x2 __attribute__((ext_vector_type(2)));
typedef float f32x4 __attribute__((ext_vector_type(4)));
typedef float f32x16 __attribute__((ext_vector_type(16)));
typedef unsigned u32x2 __attribute__((ext_vector_type(2)));
typedef unsigned u32x4 __attribute__((ext_vector_type(4)));
typedef __bf16 bf16x2_t __attribute__((ext_vector_type(2)));

constexpr int D = 1024, MP = 32768, MS = 2048, M = MP + MS, NSEQ = 40;
constexpr int DFF = 2816, MIN = 3088, NPROJ = 3072;
constexpr int KSROWS = 4160;
constexpr float EPS = 1e-6f;
constexpr float LOG2E = 1.4426950408889634f;

constexpr int OFF_Y = 0, OFF_PC = 35651584, OFF_PN = 36700160, OFF_PM = 36708352, OFF_PK = 36708480, OFF_PV = 70262912,
              OFF_SC = 103817344, OFF_SN = 108011648, OFF_SM = 108044416, OFF_SK = 108044928, OFF_SV = 110142080, OUT_TOTAL = 112239232;

constexpr size_t MiB = 1u << 20;
constexpr size_t WS_CTL = 0, CTL_ZERO_BYTES = 1 * MiB;
constexpr size_t WS_MOD = 1 * MiB;
constexpr size_t WS_WIN = 5 * MiB;
constexpr size_t WS_WMO = 17 * MiB;
constexpr size_t WS_WQ = 25 * MiB;
constexpr size_t WS_WKV = 29 * MiB;
constexpr size_t WS_WGU = 33 * MiB;
constexpr size_t WS_WD = 77 * MiB;
constexpr size_t WS_GATES = 99 * MiB;
constexpr size_t WS_XM = 102 * MiB;
constexpr size_t WS_HG = 170 * MiB;
constexpr size_t WS_PROJ = 238 * MiB;
constexpr size_t WS_HID = 442 * MiB;
constexpr size_t WS_KP = 629 * MiB;
constexpr size_t WS_VP = 693 * MiB;
constexpr size_t WS_KS = 757 * MiB;
constexpr size_t WS_VS = 1017 * MiB;
constexpr size_t WS_XB = 1277 * MiB;
constexpr size_t WS_CL = 1345 * MiB;
constexpr size_t WS_CP = 1488 * MiB;
constexpr size_t WS_NL = 1616 * MiB;
constexpr size_t WS_TAB = 1618 * MiB;
constexpr size_t WS_NPREV = 1623 * MiB;
constexpr size_t WS_MPREV = 1625 * MiB;
constexpr size_t WS_END = 1626 * MiB;

constexpr int LDS_BYTES = 163840;
constexpr int MISC_OFF = 163840 - 256;
constexpr int NWAVES = 8;

DI unsigned pk2(float lo, float hi) { f32x2 v = {lo, hi}; bf16x2_t b = __builtin_convertvector(v, bf16x2_t); return __builtin_bit_cast(unsigned, b); }
DI float bf_lo(unsigned w) { return __uint_as_float(w << 16); }
DI float bf_hi(unsigned w) { return __uint_as_float(w & 0xffff0000u); }
DI u32x4 pack8f(const f32x4 a, const f32x4 b) { u32x4 r; r.x = pk2(a.x, a.y); r.y = pk2(a.z, a.w); r.z = pk2(b.x, b.y); r.w = pk2(b.z, b.w); return r; }
DI bf16x8 pack_step(const f32x16& x, int s) {
    u32x4 p; p.x = pk2(x[8 * s + 0], x[8 * s + 1]); p.y = pk2(x[8 * s + 2], x[8 * s + 3]); p.z = pk2(x[8 * s + 4], x[8 * s + 5]); p.w = pk2(x[8 * s + 6], x[8 * s + 7]);
    return __builtin_bit_cast(bf16x8, p);
}
DI int opaque_tid(int wv0) { int t; asm volatile("v_mbcnt_lo_u32_b32 %0, -1, 0\n\tv_mbcnt_hi_u32_b32 %0, -1, %0" : "=&v"(t)); t |= wv0 << 6; asm volatile("" : "+v"(t)); return t; }
DI float xor32_sum(float v) { const unsigned u = __float_as_uint(v); auto rr = __builtin_amdgcn_permlane32_swap(u, u, false, false); return __uint_as_float(rr[0]) + __uint_as_float(rr[1]); }
DI float xor32_max(float v) { const unsigned u = __float_as_uint(v); auto rr = __builtin_amdgcn_permlane32_swap(u, u, false, false); return fmaxf(__uint_as_float(rr[0]), __uint_as_float(rr[1])); }
DI float max3f(float a, float b, float c) { float r; asm("v_max3_f32 %0, %1, %2, %3" : "=v"(r) : "v"(a), "v"(b), "v"(c)); return r; }
DI int crow(int reg, int hh) { return (reg & 3) + 8 * (reg >> 2) + 4 * hh; }
DI float wave_sum(float v) {
#pragma unroll
    for (int o = 1; o < 64; o <<= 1) v += __shfl_xor(v, o);
    return v;
}
DI bf16x8 tr_pair(LAS const unsigned char* p0, LAS const unsigned char* p1) {
    v4i16 lo = __builtin_amdgcn_ds_read_tr16_b64_v4i16((LAS v4i16*)p0);
    v4i16 hi = __builtin_amdgcn_ds_read_tr16_b64_v4i16((LAS v4i16*)p1);
    return __builtin_shufflevector(lo, hi, 0, 1, 2, 3, 4, 5, 6, 7);
}
#define MFMA32(a, b, c) __builtin_amdgcn_mfma_f32_32x32x16_bf16((a), (b), (c), 0, 0, 0)
#define WG_BARRIER() do { asm volatile("s_waitcnt vmcnt(0) lgkmcnt(0)" ::: "memory"); __builtin_amdgcn_s_barrier(); asm volatile("" ::: "memory"); } while (0)
#define LDS_BARRIER() do { asm volatile("s_waitcnt lgkmcnt(0)" ::: "memory"); __builtin_amdgcn_s_barrier(); asm volatile("" ::: "memory"); } while (0)

namespace pg8 {
#define PG8_LAS __attribute__((address_space(3)))
constexpr int BM = 256, BK = 64, HALF = 128, HTB = HALF * BK * 2, STAGE_BYTES = 8 * HTB, NXCD = 8, WGM = 8;
__host__ __device__ __forceinline__ int lds_byte(int r, int c) { const int st = (r >> 4) * 2 + (c >> 5), rr = r & 15, cc = c & 31, ob = rr * 64 + cc * 2; return st * 1024 + (ob ^ (((ob >> 9) & 1) << 5)); }
__host__ __device__ __forceinline__ void stage_rc(int b, int& R, int& C) { const int st = b / 1024, sb = b % 1024, swz = sb ^ (((sb >> 9) & 1) << 5); R = (st >> 1) * 16 + swz / 64; C = (st & 1) * 32 + (swz % 64) / 2; }
__host__ __device__ __forceinline__ int perm32(int rho) { const int n = rho >> 4, i = rho & 15; return 8 * (i >> 2) + 4 * n + (i & 3); }
struct Unit { int pm, pn; };
struct Gemm { const bf16_t* A; const bf16_t* Bt; int M, N, K; };
struct StaticOrder {
    int nM, nN, nwg, G, c;
    __host__ __device__ void init(int M_, int N_, int G_, int c_) { nM = M_ / BM; nN = N_ / BM; nwg = nM * nN; G = G_; c = c_; }
    __host__ __device__ bool next(int i, Unit& u) const {
        const long L = (long)i * G + c; if (L >= nwg) return false;
        int wgid = (int)L; { const int q = nwg / NXCD, r = nwg % NXCD, xcd = wgid % NXCD, off = wgid / NXCD; wgid = (xcd < r ? xcd * (q + 1) : r * (q + 1) + (xcd - r) * q) + off; }
        const int nig = WGM * nN, gid = wgid / nig, fm = gid * WGM, gsz = (nM - fm) < WGM ? (nM - fm) : WGM;
        u.pm = fm + ((wgid % nig) % gsz); u.pn = (wgid % nig) / gsz; return true;
    }
    __device__ __forceinline__ void a_ready(const Unit&) const {}
    __device__ __forceinline__ void done(const Unit&) const {}
};

template <class Epi, class Sched, bool ALIGN_EPI = false, bool SP2 = false>
__device__ __forceinline__ void gemm_phase(PG8_LAS unsigned char* lds, const Gemm g, const Sched& S, const Epi& E, int wv0) {
    const int tid = opaque_tid(wv0), wid = __builtin_amdgcn_readfirstlane(tid >> 6), lane = tid & 63, wr = wid >> 2, wc = wid & 3, fr = lane & 15, fq = lane >> 4;
    const int K = g.K, nt = K / BK;
    unsigned voffA[2], voffB[2];
#pragma unroll
    for (int i = 0; i < 2; ++i) { int R, C; stage_rc(tid * 16 + i * 8192, R, C); const int Rb = Epi::PERM ? ((R & ~31) + perm32(R & 31)) : R;
        voffA[i] = (unsigned)(R * K + C) * 2u; voffB[i] = (unsigned)(Rb * K + C) * 2u; }
    const size_t kstep = (size_t)(BK * 2);
    const size_t hstep = (size_t)HALF * K * 2;
    const size_t tstep = 2 * hstep;
    const unsigned ldsw = (unsigned)wid * 1024u;
    const int aoff = lds_byte(wr * 64 + fr, fq * 8), boff = lds_byte(wc * 32 + fr, fq * 8);
#define PG8_SA(b, h) (((b) * 2 + (h)) * HTB)
#define PG8_SB(b, h) ((4 + (b) * 2 + (h)) * HTB)
#define PG8_STAGE(bufoff, gbase, voff) do { _Pragma("unroll") for (int _i = 0; _i < 2; ++_i) \
        __builtin_amdgcn_global_load_lds((const unsigned*)((const char*)(gbase) + (voff)[_i]), (PG8_LAS unsigned*)(lds + (bufoff) + ldsw + _i * 8192), 16, 0, 0); } while (0)
#define PG8_LDA(dst, b, h) do { _Pragma("unroll") for (int m = 0; m < 4; ++m) _Pragma("unroll") for (int k = 0; k < 2; ++k) dst[m][k] = *(const PG8_LAS bf16x8*)(lds + PG8_SA(b, h) + aoff + m * 2048 + k * 1024); } while (0)
#define PG8_LDB(dst, b, h) do { _Pragma("unroll") for (int n = 0; n < 2; ++n) _Pragma("unroll") for (int k = 0; k < 2; ++k) dst[n][k] = *(const PG8_LAS bf16x8*)(lds + PG8_SB(b, h) + boff + n * 2048 + k * 1024); } while (0)
#define PG8_MMA(ai, bj, At, Bt) do { __builtin_amdgcn_s_setprio(1); _Pragma("unroll") for (int m = 0; m < 4; ++m) _Pragma("unroll") for (int n = 0; n < 2; ++n) _Pragma("unroll") for (int k = 0; k < 2; ++k) \
        acc[ai][bj][m][n] = __builtin_amdgcn_mfma_f32_16x16x32_bf16(Bt[n][k], At[m][k], acc[ai][bj][m][n], 0, 0, 0); __builtin_amdgcn_s_setprio(0); } while (0)
#define PG8_WAIT_V(n) asm volatile("s_waitcnt vmcnt(" #n ")" ::: "memory")
#define PG8_WAIT_L(n) asm volatile("s_waitcnt lgkmcnt(" #n ")" ::: "memory")
#define PG8_BAR __builtin_amdgcn_s_barrier()
#define PG8_SCHED __builtin_amdgcn_sched_barrier(0)
    Unit cur, nxt; int ui = 0;
    if (!S.next(0, cur)) return;
    f32x4 acc[2][2][4][2];
#pragma unroll
    for (int a = 0; a < 2; ++a)
#pragma unroll
        for (int b = 0; b < 2; ++b)
#pragma unroll
            for (int m = 0; m < 4; ++m)
#pragma unroll
                for (int n = 0; n < 2; ++n) acc[a][b][m][n] = (f32x4){0.f, 0.f, 0.f, 0.f};
    bf16x8 At[4][2], B0[2][2], B1[2][2];
    const char* cA = (const char*)g.A + (size_t)cur.pm * tstep; const char* cB = (const char*)g.Bt + (size_t)cur.pn * tstep;
    S.a_ready(cur);
    if constexpr (SP2) {
        PG8_STAGE(PG8_SB(0, 0), cB, voffB); PG8_STAGE(PG8_SB(0, 1), cB + hstep, voffB); PG8_STAGE(PG8_SA(0, 0), cA, voffA); PG8_STAGE(PG8_SA(0, 1), cA + hstep, voffA);
        if (wr == 1) PG8_BAR;
        PG8_WAIT_V(2); PG8_BAR;
        PG8_STAGE(PG8_SB(1, 0), cB + kstep, voffB); PG8_STAGE(PG8_SA(1, 0), cA + kstep, voffA); PG8_STAGE(PG8_SB(1, 1), cB + hstep + kstep, voffB);
        PG8_WAIT_V(6); PG8_BAR;
    } else {
        PG8_STAGE(PG8_SB(0, 0), cB, voffB); PG8_STAGE(PG8_SA(0, 0), cA, voffA); PG8_STAGE(PG8_SB(0, 1), cB + hstep, voffB); PG8_STAGE(PG8_SA(0, 1), cA + hstep, voffA);
        if (wr == 1) PG8_BAR;
        PG8_WAIT_V(4); PG8_BAR;
        PG8_STAGE(PG8_SB(1, 0), cB + kstep, voffB); PG8_STAGE(PG8_SA(1, 0), cA + kstep, voffA); PG8_STAGE(PG8_SB(1, 1), cB + hstep + kstep, voffB);
        PG8_WAIT_V(6); PG8_BAR;
    }
    for (;;) {
        const bool has_next = S.next(ui + 1, nxt);
        const char* nA = has_next ? (const char*)g.A + (size_t)nxt.pm * tstep : cA; const char* nB = has_next ? (const char*)g.Bt + (size_t)nxt.pn * tstep : cB;
        for (int t = 0; t < nt; t += 2) {
            const bool last = (t == nt - 2);
            const char* a1 = cA + (size_t)(t + 1) * kstep;
            const char* a2 = last ? nA : cA + (size_t)(t + 2) * kstep; const char* b2 = last ? nB : cB + (size_t)(t + 2) * kstep;
            const char* a3 = a2 + kstep; const char* b3 = b2 + kstep;
            if (last && has_next) S.a_ready(nxt);
            if constexpr (SP2) {
            PG8_LDB(B0, 0, 0); PG8_LDB(B1, 0, 1); PG8_SCHED; PG8_LDA(At, 0, 0); PG8_STAGE(PG8_SA(1, 1), a1 + hstep, voffA);
            PG8_WAIT_V(8); PG8_WAIT_L(0); PG8_BAR; PG8_MMA(0, 0, At, B0); PG8_MMA(0, 1, At, B1); PG8_BAR; PG8_SCHED;
            PG8_LDA(At, 0, 1); PG8_STAGE(PG8_SB(0, 0), b2, voffB); PG8_STAGE(PG8_SB(0, 1), b2 + hstep, voffB); PG8_STAGE(PG8_SA(0, 0), a2, voffA);
            PG8_WAIT_V(8); PG8_WAIT_L(0); PG8_BAR; PG8_MMA(1, 0, At, B0); PG8_MMA(1, 1, At, B1); PG8_BAR; PG8_SCHED;
            PG8_LDB(B0, 1, 0); PG8_LDB(B1, 1, 1); PG8_SCHED; PG8_LDA(At, 1, 0); PG8_STAGE(PG8_SA(0, 1), a2 + hstep, voffA);
            PG8_WAIT_V(8); PG8_WAIT_L(0); PG8_BAR; PG8_MMA(0, 0, At, B0); PG8_MMA(0, 1, At, B1); PG8_BAR; PG8_SCHED;
            PG8_LDA(At, 1, 1); PG8_STAGE(PG8_SB(1, 0), b3, voffB); PG8_STAGE(PG8_SB(1, 1), b3 + hstep, voffB); PG8_STAGE(PG8_SA(1, 0), a3, voffA);
            PG8_WAIT_V(8); PG8_WAIT_L(0); PG8_BAR; PG8_MMA(1, 0, At, B0); PG8_MMA(1, 1, At, B1); PG8_BAR; PG8_SCHED;
            } else {
            PG8_LDB(B0, 0, 0); PG8_SCHED; PG8_LDA(At, 0, 0); PG8_STAGE(PG8_SA(1, 1), a1 + hstep, voffA);
            PG8_WAIT_L(8); PG8_BAR; PG8_WAIT_L(0); PG8_MMA(0, 0, At, B0); PG8_BAR; PG8_SCHED;
            PG8_LDB(B1, 0, 1); PG8_STAGE(PG8_SB(0, 0), b2, voffB);
            PG8_BAR; PG8_WAIT_L(0); PG8_MMA(0, 1, At, B1); PG8_BAR;
            PG8_LDA(At, 0, 1); PG8_STAGE(PG8_SA(0, 0), a2, voffA);
            PG8_BAR; PG8_WAIT_L(0); PG8_MMA(1, 0, At, B0); PG8_BAR; PG8_SCHED;
            PG8_STAGE(PG8_SB(0, 1), b2 + hstep, voffB);
            PG8_WAIT_V(6); PG8_BAR; PG8_MMA(1, 1, At, B1); PG8_BAR;
            PG8_LDB(B0, 1, 0); PG8_SCHED; PG8_LDA(At, 1, 0); PG8_STAGE(PG8_SA(0, 1), a2 + hstep, voffA);
            PG8_WAIT_L(8); PG8_BAR; PG8_WAIT_L(0); PG8_MMA(0, 0, At, B0); PG8_BAR; PG8_SCHED;
            PG8_LDB(B1, 1, 1); PG8_STAGE(PG8_SB(1, 0), b3, voffB);
            PG8_BAR; PG8_WAIT_L(0); PG8_MMA(0, 1, At, B1); PG8_BAR;
            PG8_LDA(At, 1, 1); PG8_STAGE(PG8_SA(1, 0), a3, voffA);
            PG8_BAR; PG8_WAIT_L(0); PG8_MMA(1, 0, At, B0); PG8_BAR; PG8_SCHED;
            PG8_STAGE(PG8_SB(1, 1), b3 + hstep, voffB);
            PG8_WAIT_V(6); PG8_BAR; PG8_MMA(1, 1, At, B1); PG8_BAR;
            }
        }
        if constexpr (ALIGN_EPI) { if (wr == 0) PG8_BAR; }
        E(acc, cur, wr, wc, fr, fq); S.done(cur);
        if (!has_next) break;
#pragma unroll
        for (int a = 0; a < 2; ++a)
#pragma unroll
            for (int b = 0; b < 2; ++b)
#pragma unroll
                for (int m = 0; m < 4; ++m)
#pragma unroll
                    for (int n = 0; n < 2; ++n) acc[a][b][m][n] = (f32x4){0.f, 0.f, 0.f, 0.f};
        cur = nxt; cA = nA; cB = nB; ++ui;
        if constexpr (ALIGN_EPI) { if (wr == 1) PG8_BAR; }
    }
    PG8_WAIT_V(0);
    if constexpr (!ALIGN_EPI) { if (wr == 0) PG8_BAR; }
    PG8_BAR;
#undef PG8_SA
#undef PG8_SB
#undef PG8_STAGE
#undef PG8_LDA
#undef PG8_LDB
#undef PG8_MMA
#undef PG8_WAIT_V
#undef PG8_WAIT_L
#undef PG8_BAR
#undef PG8_SCHED
}
}

typedef const f32x4 (&AccRef)[2][2][4][2];

struct EpiProj {
    static constexpr bool PERM = true, AFTER_DRAIN = false;
    bf16_t* O;
    DI void operator()(AccRef acc, const pg8::Unit& u, int wr, int wc, int fr, int fq) const {
        const int row0 = u.pm * 256 + wr * 64 + fr, colt = u.pn * 256, col0 = colt + wc * 32 + 8 * fq;
        const float sc = (colt >= 512 && colt < 1024) ? 0.125f : 1.0f;
#pragma unroll
        for (int ai = 0; ai < 2; ++ai)
#pragma unroll
            for (int m = 0; m < 4; ++m) { bf16_t* rowp = O + (size_t)(row0 + ai * 128 + m * 16) * NPROJ + col0;
#pragma unroll
                for (int bj = 0; bj < 2; ++bj) { *(u32x4*)(rowp + bj * 128) = pack8f(acc[ai][bj][m][0] * sc, acc[ai][bj][m][1] * sc); } }
    }
};
struct EpiSwiglu {
    static constexpr bool PERM = true, AFTER_DRAIN = false;
    bf16_t* H;
    DI void operator()(AccRef acc, const pg8::Unit& u, int wr, int wc, int fr, int fq) const {
        const int row0 = u.pm * 256 + wr * 64 + fr, col0 = u.pn * 128 + wc * 32 + 8 * fq;
#pragma unroll
        for (int ai = 0; ai < 2; ++ai)
#pragma unroll
            for (int m = 0; m < 4; ++m) {
                f32x4 h[2];
#pragma unroll
                for (int n = 0; n < 2; ++n) {
                    const f32x4 g = acc[ai][0][m][n], up = acc[ai][1][m][n];
#pragma unroll
                    for (int e = 0; e < 4; ++e) {
                        const float r = __builtin_amdgcn_rcpf(1.0f + __builtin_amdgcn_exp2f(g[e]));
                        h[n][e] = (g[e] * up[e]) * r; }
                }
                *(u32x4*)(H + (size_t)(row0 + ai * 128 + m * 16) * DFF + col0) = pack8f(h[0], h[1]);
            }
    }
};
DI f32x4 ld4(const void* base, size_t e, int bf) {
    if (bf) { const u32x2 w = *(const u32x2*)((const bf16_t*)base + e); return (f32x4){bf_lo(w.x), bf_hi(w.x), bf_lo(w.y), bf_hi(w.y)}; }
    return *(const f32x4*)((const float*)base + e);
}
DI void st4(void* base, size_t e, int bf, const f32x4 v) {
    if (bf) { u32x2 w; w.x = pk2(v[0], v[1]); w.y = pk2(v[2], v[3]); *(u32x2*)((bf16_t*)base + e) = w; }
    else *(f32x4*)((float*)base + e) = v;
}
struct EpiRes {
    static constexpr bool PERM = true, AFTER_DRAIN = false;
    const void* resP; const void* resS; void* out; const float* gate; int res_bf, out_bf;
    DI void operator()(AccRef acc, const pg8::Unit& u, int wr, int wc, int fr, int fq) const {
        const int col0 = u.pn * 256 + wc * 32 + 8 * fq;
#pragma unroll
        for (int ai = 0; ai < 2; ++ai) {
            const int rowb = u.pm * 256 + ai * 128 + wr * 64;
            const int seq = rowb < MP ? (rowb >> 12) : 8 + ((rowb - MP) >> 6);
            const float* gp = gate + (size_t)seq * 6144 + col0;
            const void* rb = rowb < MP ? resP : resS;
            const size_t re = (size_t)((rowb < MP ? rowb : rowb - MP) + fr) * D + col0, oe = (size_t)(rowb + fr) * D + col0;
            f32x4 gv[2][2];
#pragma unroll
            for (int bj = 0; bj < 2; ++bj)
#pragma unroll
                for (int n = 0; n < 2; ++n) gv[bj][n] = *(const f32x4*)(gp + bj * 128 + n * 4);
#pragma unroll
            for (int m = 0; m < 4; ++m) {
#pragma unroll
                for (int bj = 0; bj < 2; ++bj) {
                    const size_t e1 = re + m * 16 * D + bj * 128, e2 = oe + m * 16 * D + bj * 128;
                    f32x4 r0, r1;
                    if (res_bf) { const u32x4 w = *(const u32x4*)((const bf16_t*)rb + e1);
                        r0 = (f32x4){bf_lo(w.x), bf_hi(w.x), bf_lo(w.y), bf_hi(w.y)}; r1 = (f32x4){bf_lo(w.z), bf_hi(w.z), bf_lo(w.w), bf_hi(w.w)}; }
                    else { r0 = *(const f32x4*)((const float*)rb + e1); r1 = *(const f32x4*)((const float*)rb + e1 + 4); }
                    const f32x4 v0 = r0 + gv[bj][0] * acc[ai][bj][m][0], v1 = r1 + gv[bj][1] * acc[ai][bj][m][1];
                    if (out_bf) *(u32x4*)((bf16_t*)out + e2) = pack8f(v0, v1);
                    else { __builtin_nontemporal_store(v0, (f32x4*)((float*)out + e2)); __builtin_nontemporal_store(v1, (f32x4*)((float*)out + e2 + 4)); }
                }
                asm volatile("" ::: "memory");
            }
        }
    }
};
struct EpiQ {
    static constexpr bool PERM = true, AFTER_DRAIN = false;
    bf16_t* Q; const float* qg; float scale;
    DI void operator()(AccRef acc, const pg8::Unit& u, int wr, int wc, int fr, int fq) const {
        const int row0 = u.pm * 256 + wr * 64 + fr, colg = u.pn * 256 + wc * 64;
        f32x4 g4[2][2];
#pragma unroll
        for (int bj = 0; bj < 2; ++bj)
#pragma unroll
            for (int n = 0; n < 2; ++n) g4[bj][n] = *(const f32x4*)(qg + 32 * bj + 8 * fq + 4 * n);
#pragma unroll
        for (int ai = 0; ai < 2; ++ai)
#pragma unroll
            for (int m = 0; m < 4; ++m) {
                float ss = 0.f;
#pragma unroll
                for (int bj = 0; bj < 2; ++bj)
#pragma unroll
                    for (int n = 0; n < 2; ++n) { const f32x4 v = acc[ai][bj][m][n]; ss += (v[0] * v[0] + v[1] * v[1]) + (v[2] * v[2] + v[3] * v[3]); }
                ss += __shfl_xor(ss, 16); ss = xor32_sum(ss);
                const float rs = __builtin_amdgcn_rsqf(ss * (1.0f / 64.0f) + EPS) * scale;
                bf16_t* rowp = Q + (size_t)(row0 + ai * 128 + m * 16) * D + colg + 8 * fq;
#pragma unroll
                for (int bj = 0; bj < 2; ++bj) *(u32x4*)(rowp + 32 * bj) = pack8f(acc[ai][bj][m][0] * rs * g4[bj][0], acc[ai][bj][m][1] * rs * g4[bj][1]);
            }
    }
};
struct EpiKV {
    static constexpr bool PERM = true, AFTER_DRAIN = false;
    float* out; unsigned char* ws; const float* kg;
    DI void operator()(AccRef acc, const pg8::Unit& u, int wr, int wc, int fr, int fq) const {
        const bool isk = u.pn < 4;
        const int colb = isk ? (u.pn * 256 + wc * 64 + 8 * fq) : ((u.pn - 4) * 256 + wc * 32 + 8 * fq);
        const int cstep = isk ? 32 : 128;
        f32x4 g4[2][2];
#pragma unroll
        for (int bj = 0; bj < 2; ++bj)
#pragma unroll
            for (int n = 0; n < 2; ++n) g4[bj][n] = isk ? *(const f32x4*)(kg + 32 * bj + 8 * fq + 4 * n) : (f32x4){1.f, 1.f, 1.f, 1.f};
#pragma unroll
        for (int ai = 0; ai < 2; ++ai) {
            const int rowb = u.pm * 256 + ai * 128 + wr * 64;
            float* op; bf16_t* bp;
            if (rowb < MP) { const size_t oo = isk ? (size_t)OFF_PK : (size_t)OFF_PV, bo = isk ? WS_KP : WS_VP;
                op = out + oo + (size_t)(rowb + fr) * D + colb; bp = (bf16_t*)(ws + bo) + (size_t)(rowb + fr) * D + colb; }
            else { const int r2 = rowb - MP; const size_t oo = isk ? (size_t)OFF_SK : (size_t)OFF_SV, bo = isk ? WS_KS : WS_VS;
                op = out + oo + (size_t)(r2 + fr) * D + colb; bp = (bf16_t*)(ws + bo) + ((size_t)(r2 >> 6) * KSROWS + 4096 + fr) * D + colb; }
#pragma unroll
            for (int m = 0; m < 4; ++m) {
                float rs = 1.0f;
                if (isk) {
                    float ss = 0.f;
#pragma unroll
                    for (int bj = 0; bj < 2; ++bj)
#pragma unroll
                        for (int n = 0; n < 2; ++n) { const f32x4 v = acc[ai][bj][m][n]; ss += (v[0] * v[0] + v[1] * v[1]) + (v[2] * v[2] + v[3] * v[3]); }
                    ss += __shfl_xor(ss, 16); ss = xor32_sum(ss);
                    rs = __builtin_amdgcn_rsqf(ss * (1.0f / 64.0f) + EPS);
                }
#pragma unroll
                for (int bj = 0; bj < 2; ++bj) {
                    const f32x4 v0 = acc[ai][bj][m][0] * rs * g4[bj][0], v1 = acc[ai][bj][m][1] * rs * g4[bj][1];
                    float* o2 = op + m * 16 * D + bj * cstep; bf16_t* b2 = bp + m * 16 * D + bj * cstep;
                    __builtin_nontemporal_store(v0, (f32x4*)(o2)); __builtin_nontemporal_store(v1, (f32x4*)(o2 + 4));
                    *(u32x4*)(b2) = pack8f(v0, v1);
                }
                asm volatile("" ::: "memory");
            }
        }
    }
};

constexpr int GS_A = 0, GS_B = 17408, GS_BUF = 52224;
template <class Epi, bool BMAP1 = false>
DI void gemm_small(LAS unsigned char* lds, const bf16_t* A, const bf16_t* Bt, int nM, int nN, int K, const Epi& E, int vcu, int G, int tid, int wave, int lane) {
    const int wr = wave >> 2, wc = wave & 3, r = lane & 31, hh = lane >> 5;
    const int srow = tid >> 4, scc = tid & 15, nkt = K >> 7;
    struct Stage { u32x4 a0, a1, b0, b1, b2, b3; };
#pragma unroll 1
    for (int u = vcu; u < nM * nN; u += G) {
        const int pm = u / nN, pn = u % nN;
        const bf16_t* ga = A + (size_t)(pm * 64 + srow) * K + scc * 8;
        const bf16_t* gb = Bt + (size_t)((BMAP1 ? 256 * (pn >> 1) + 32 * ((2 * pn) & 3) : pn * 128) + srow) * K + scc * 8;
        constexpr int BR1 = BMAP1 ? 128 : 32, BR2 = BMAP1 ? 32 : 64, BR3 = BMAP1 ? 160 : 96;
        auto load = [&](Stage& st, int kt) {
            const bf16_t* pa = ga + kt * 128; const bf16_t* pb = gb + kt * 128;
            st.a0 = *(const u32x4*)pa; st.a1 = *(const u32x4*)(pa + (size_t)32 * K);
            st.b0 = *(const u32x4*)pb; st.b1 = *(const u32x4*)(pb + (size_t)BR1 * K); st.b2 = *(const u32x4*)(pb + (size_t)BR2 * K); st.b3 = *(const u32x4*)(pb + (size_t)BR3 * K);
        };
        auto store = [&](const Stage& st, LAS unsigned char* buf) {
            LAS unsigned char* pa = buf + GS_A + srow * 272 + scc * 16; LAS unsigned char* pb = buf + GS_B + srow * 272 + scc * 16;
            *(LAS u32x4*)pa = st.a0; *(LAS u32x4*)(pa + 32 * 272) = st.a1;
            *(LAS u32x4*)pb = st.b0; *(LAS u32x4*)(pb + 32 * 272) = st.b1; *(LAS u32x4*)(pb + 64 * 272) = st.b2; *(LAS u32x4*)(pb + 96 * 272) = st.b3;
        };
        f32x16 acc = f32x16{};
        auto compute = [&](const LAS unsigned char* buf) {
            const LAS unsigned char* pa = buf + GS_A + (32 * wr + r) * 272 + hh * 16; const LAS unsigned char* pb = buf + GS_B + (32 * wc + r) * 272 + hh * 16;
#pragma unroll
            for (int kh = 0; kh < 2; ++kh) {
                bf16x8 af[4], bfr[4];
#pragma unroll
                for (int ks = 0; ks < 4; ++ks) { af[ks] = *(const LAS bf16x8*)(pa + (4 * kh + ks) * 32); bfr[ks] = *(const LAS bf16x8*)(pb + (4 * kh + ks) * 32); }
#pragma unroll
                for (int ks = 0; ks < 4; ++ks) acc = MFMA32(af[ks], bfr[ks], acc);
            }
        };
        Stage s0, s1, s2, s3;
        load(s0, 0); load(s1, 1); if (2 < nkt) load(s2, 2); if (3 < nkt) load(s3, 3);
#pragma unroll 1
        for (int kt = 0; kt < nkt; kt += 4) {
            store(s0, lds); LDS_BARRIER(); if (kt + 4 < nkt) load(s0, kt + 4); compute(lds);
            if (kt + 1 < nkt) { store(s1, lds + GS_BUF); LDS_BARRIER(); if (kt + 5 < nkt) load(s1, kt + 5); compute(lds + GS_BUF); }
            if (kt + 2 < nkt) { store(s2, lds); LDS_BARRIER(); if (kt + 6 < nkt) load(s2, kt + 6); compute(lds); }
            if (kt + 3 < nkt) { store(s3, lds + GS_BUF); LDS_BARRIER(); if (kt + 7 < nkt) load(s3, kt + 7); compute(lds + GS_BUF); }
        }
        E(acc, pm, pn, wr, wc, r, hh);
        LDS_BARRIER();
    }
}
struct EpiResSmall {
    const void* res; void* out; const float* gate; int res_bf, out_bf;
    DI void operator()(const f32x16& acc, int pm, int pn, int wr, int wc, int r, int hh) const {
        const int col = pn * 128 + wc * 32 + r;
        const float g = gate[(size_t)(8 + pm) * 6144 + col];
        const size_t base = (size_t)(pm * 64 + 32 * wr + 4 * hh) * D + col;
#pragma unroll
        for (int i = 0; i < 16; ++i) { const size_t o = base + (size_t)((i & 3) + 8 * (i >> 2)) * D;
            const float rv = res_bf ? __uint_as_float((unsigned)((const bf16_t*)res)[o] << 16) : ((const float*)res)[o];
            const float v = rv + g * acc[i];
            if (out_bf) ((bf16_t*)out)[o] = (bf16_t)(pk2(v, 0.f) & 0xffffu); else ((float*)out)[o] = v; }
    }
};

struct EpiQSmall {
    bf16_t* Q; const float* qg; float scale; LAS float* X;
    DI void operator()(const f32x16& acc, int pm, int pn, int wr, int wc, int r, int hh) const {
        float ss[16];
#pragma unroll
        for (int i = 0; i < 16; ++i) { float v = acc[i] * acc[i];
#pragma unroll
            for (int o = 1; o < 32; o <<= 1) v += __shfl_xor(v, o);
            ss[i] = v; }
        const int w = wr * 4 + wc;
        if (r == 0) {
#pragma unroll
            for (int i = 0; i < 16; ++i) X[(w * 2 + hh) * 16 + i] = ss[i];
        }
        LDS_BARRIER();
        const int col = pn * 128 + wc * 32 + r;
        const float g = qg[(wc & 1) * 32 + r] * scale;
        bf16_t* qp = Q + (size_t)(pm * 64 + 32 * wr + 4 * hh) * D + col;
#pragma unroll
        for (int i = 0; i < 16; ++i) {
            const float tot = ss[i] + X[((w ^ 1) * 2 + hh) * 16 + i];
            const float rs = __builtin_amdgcn_rsqf(tot * (1.0f / 64.0f) + EPS);
            qp[(size_t)((i & 3) + 8 * (i >> 2)) * D] = (bf16_t)(pk2(acc[i] * rs * g, 0.f) & 0xffffu);
        }
    }
};

template <bool NORM>
struct EpiKVSmall {
    float* out; bf16_t* bc; const float* kg; LAS float* X;
    DI void operator()(const f32x16& acc, int pm, int pn, int wr, int wc, int r, int hh) const {
        const int col = pn * 128 + wc * 32 + r;
        float* op = out + (size_t)(pm * 64 + 32 * wr + 4 * hh) * D + col;
        bf16_t* bp = bc + ((size_t)pm * KSROWS + 4096 + 32 * wr + 4 * hh) * D + col;
        if constexpr (NORM) {
            float ss[16];
#pragma unroll
            for (int i = 0; i < 16; ++i) { float v = acc[i] * acc[i];
#pragma unroll
                for (int o = 1; o < 32; o <<= 1) v += __shfl_xor(v, o);
                ss[i] = v; }
            const int w = wr * 4 + wc;
            if (r == 0) {
#pragma unroll
                for (int i = 0; i < 16; ++i) X[(w * 2 + hh) * 16 + i] = ss[i];
            }
            LDS_BARRIER();
            const float g = kg[(wc & 1) * 32 + r];
#pragma unroll
            for (int i = 0; i < 16; ++i) {
                const float tot = ss[i] + X[((w ^ 1) * 2 + hh) * 16 + i];
                const float v = acc[i] * __builtin_amdgcn_rsqf(tot * (1.0f / 64.0f) + EPS) * g;
                const size_t o = (size_t)((i & 3) + 8 * (i >> 2)) * D;
                op[o] = v; bp[o] = (bf16_t)(pk2(v, 0.f) & 0xffffu);
            }
        } else {
#pragma unroll
            for (int i = 0; i < 16; ++i) { const size_t o = (size_t)((i & 3) + 8 * (i >> 2)) * D; op[o] = acc[i]; bp[o] = (bf16_t)(pk2(acc[i], 0.f) & 0xffffu); }
        }
    }
};

#define XB_TMO      128
#define XB_XCNT(j)  (256  + 64 * (j))
#define XB_XSUB(j)  (1280 + 64 * (j))
#define XB_XGEN(j)  (2304 + 64 * (j))
#define XB_TOP      3328
#define XB_TOPGEN   3392
#define XCD_BAR_WORDS 3456
#define XB_SPIN_CAP (1u << 22)
DI unsigned xb_ld(unsigned* p)              { return __hip_atomic_load(p, __ATOMIC_RELAXED, __HIP_MEMORY_SCOPE_AGENT); }
DI unsigned xb_add(unsigned* p, unsigned v) { return __hip_atomic_fetch_add(p, v, __ATOMIC_RELAXED, __HIP_MEMORY_SCOPE_AGENT); }
DI unsigned xb_xcc_id() { return (unsigned)__builtin_amdgcn_s_getreg((3 << 11) | 20) & 0xFu; }
#define XB_SPIN(cond, bar) do { unsigned _sp = 0; while (cond) { __builtin_amdgcn_s_sleep(1); \
    if ((++_sp & 255u) == 0u) { if (xb_ld(&(bar)[XB_TMO])) break; if (_sp > XB_SPIN_CAP) { atomicAdd(&(bar)[XB_TMO], 1u); break; } } } } while (0)
struct XcdBarrier { unsigned* bar; unsigned x; int w0; volatile LAS unsigned* st; };
DI bool xb_thread0(int w0) { return w0 == 0 && __builtin_amdgcn_mbcnt_hi(~0u, __builtin_amdgcn_mbcnt_lo(~0u, 0u)) == 0u; }
DI XcdBarrier xcd_barrier_post(unsigned* bar, int w0, volatile LAS unsigned* st) {
    XcdBarrier b; b.bar = bar; b.x = xb_xcc_id(); b.w0 = w0; b.st = st;
    if (xb_thread0(w0)) (void)xb_add(&bar[XB_XCNT(b.x)], 1u);
    return b;
}
DI void xcd_barrier_complete(unsigned* bar, unsigned x, unsigned& nloc, unsigned& nx) {
    const unsigned G = gridDim.x * gridDim.y * gridDim.z;
    unsigned sum, cnt, mine, sp = 0u;
    for (;;) {
        sum = 0u; cnt = 0u; mine = 0u;
#pragma unroll
        for (unsigned j = 0; j < 16; ++j) { const unsigned c = xb_ld(&bar[XB_XCNT(j)]); sum += c; cnt += (c > 0u) ? 1u : 0u; mine = (j == x) ? c : mine; }
        if (sum == G) break;
        __builtin_amdgcn_s_sleep(1);
        if ((++sp & 255u) == 0u) { if (xb_ld(&bar[XB_TMO])) break; if (sp > XB_SPIN_CAP) { atomicAdd(&bar[XB_TMO], 1u); break; } }
    }
    nloc = mine > 0u ? mine : 1u; nx = cnt > 0u ? cnt : 1u;
}
DI void xcd_barrier(const XcdBarrier& b) {
    asm volatile("s_waitcnt vmcnt(0)" ::: "memory");
    __syncthreads();
    if (xb_thread0(b.w0)) {
        unsigned* bar = b.bar;
        __builtin_amdgcn_s_waitcnt(0);
        unsigned nloc = b.st[0], nx = b.st[1];
        if (nloc == 0u) { xcd_barrier_complete(bar, b.x, nloc, nx); b.st[0] = nloc; b.st[1] = nx; }
        const unsigned old = xb_add(&bar[XB_XSUB(b.x)], 1u);
        const unsigned gen = old / nloc;
        if (old + 1u == (gen + 1u) * nloc) {
            __builtin_amdgcn_fence(__ATOMIC_RELEASE, "agent");
            asm volatile("s_waitcnt vmcnt(0)" ::: "memory");
            const unsigned og = xb_add(&bar[XB_TOP], 1u);
            const unsigned tg = og / nx;
            if (og + 1u == (tg + 1u) * nx) xb_add(&bar[XB_TOPGEN], 1u);
            else XB_SPIN(xb_ld(&bar[XB_TOPGEN]) == tg, bar);
            __builtin_amdgcn_fence(__ATOMIC_ACQUIRE, "agent");
            xb_add(&bar[XB_XGEN(b.x)], 1u);
            asm volatile("s_waitcnt vmcnt(0)" ::: "memory");
        } else {
            XB_SPIN(xb_ld(&bar[XB_XGEN(b.x)]) == gen, bar);
            __builtin_amdgcn_fence(__ATOMIC_ACQUIRE, "agent");
            asm volatile("s_waitcnt vmcnt(0)" ::: "memory");
        }
    }
    __syncthreads();
}

struct Args { const float* in[29]; float* out; unsigned char* ws; int ph_lo, ph_hi; };
typedef const __attribute__((address_space(4))) Args& ArgsRef;
DI ArgsRef kargs() { const __attribute__((address_space(4))) Args* p = (const __attribute__((address_space(4))) Args*)__builtin_amdgcn_kernarg_segment_ptr(); asm volatile("" : "+s"(p)); return *p; }
enum { I_XP = 0, I_XS, I_CP, I_CS, I_SC, I_SN, I_SM, I_CK, I_CV, I_ADAW, I_ADAB, I_NORMG, I_WIN, I_BG, I_MHG, I_WOUT, I_KVG, I_WK, I_WV, I_KG,
       I_WQ, I_QG, I_LAM, I_AHG, I_WO, I_RELB, I_WGATE, I_WUP, I_WDOWN };

constexpr long CACHE_CH = 2 * 16777216L, CACHE_T0 = 2097152L, CACHE_T1 = 2 * 2097152L, CACHE_T2 = CACHE_T1 + 1048576L, CACHE_T3 = CACHE_T2 + 1048576L;
DI int dst_row_map(int mode, int n) {
    if (mode == 1) return (n & ~255) | (((n >> 5) & 1) << 7) | (((n >> 6) & 3) << 5) | (n & 31);
    if (mode == 2) return 256 * (n >> 7) + (n & 127);
    if (mode == 3) return 256 * (n >> 7) + 128 + (n & 127);
    return n;
}
DI void transpose_item(const float* __restrict__ W, int ldw, int K, bf16_t* WT, int k0, int n0, int drow0, float wsc, LAS float* scr, int lane) {
    float wv[32];
#pragma unroll
    for (int i = 0; i < 32; ++i) { const int kk = 2 * i + (lane >> 5); wv[i] = __builtin_nontemporal_load(W + (size_t)(k0 + kk) * ldw + n0 + (lane & 31)); }
#pragma unroll
    for (int i = 0; i < 32; ++i) { const int kk = 2 * i + (lane >> 5); scr[kk * 33 + (lane & 31)] = wv[i]; }
    asm volatile("s_waitcnt lgkmcnt(0)" ::: "memory");
    const int c = lane & 7;
#pragma unroll
    for (int j = 0; j < 4; ++j) { const int n = (lane >> 3) + 8 * j; const LAS float* s = scr + (8 * c) * 33 + n;
        u32x4 o; o.x = pk2(s[0 * 33] * wsc, s[1 * 33] * wsc); o.y = pk2(s[2 * 33] * wsc, s[3 * 33] * wsc); o.z = pk2(s[4 * 33] * wsc, s[5 * 33] * wsc); o.w = pk2(s[6 * 33] * wsc, s[7 * 33] * wsc);
        *(u32x4*)(WT + (size_t)(drow0 + n) * K + k0 + 8 * c) = o; }
    asm volatile("s_waitcnt lgkmcnt(0)" ::: "memory");
}
DI void prologue_weights(ArgsRef a, LAS unsigned char* lds, int gw, int NGW, int wave, int lane, int sel) {
    LAS float* scr = (LAS float*)(lds + wave * 8448);
    unsigned char* ws = a.ws;
    constexpr int I_WINI = 16 * 96, I_SQ = 16 * 32, I_GU = 16 * 88, I_DN = 44 * 32;
    constexpr int NITEMS = 2 * I_WINI + 4 * I_SQ + 2 * I_SQ + 2 * I_SQ + 8 * I_GU + 4 * I_DN;
    for (int it = gw; it < NITEMS; it += NGW) {
        int r = it; const float* W; int ldw, K, nblk, mode; bf16_t* WT; int first = 0;
        if (r < 2 * I_WINI) { const int l = r / I_WINI; first = (l == 0); r -= l * I_WINI; W = a.in[I_WIN] + (size_t)l * 1024 * MIN; ldw = MIN; K = 1024; nblk = 96; mode = 0; WT = (bf16_t*)(ws + WS_WIN) + (size_t)l * NPROJ * 1024; }
        else { r -= 2 * I_WINI;
        if (r < 4 * I_SQ) { const int l = r / I_SQ; first = (l == 0); r -= l * I_SQ; W = (l < 2 ? a.in[I_WOUT] + (size_t)l * 1048576 : a.in[I_WO] + (size_t)(l - 2) * 1048576); ldw = 1024; K = 1024; nblk = 32; mode = 0; WT = (bf16_t*)(ws + WS_WMO) + (size_t)l * 1048576; }
        else { r -= 4 * I_SQ;
        if (r < 2 * I_SQ) { const int j = r / I_SQ; r -= j * I_SQ; W = a.in[I_WQ] + (size_t)j * 1048576; ldw = 1024; K = 1024; nblk = 32; mode = 1; WT = (bf16_t*)(ws + WS_WQ) + (size_t)j * 1048576; }
        else { r -= 2 * I_SQ;
        if (r < 2 * I_SQ) { const int j = r / I_SQ; r -= j * I_SQ; W = j ? a.in[I_WV] : a.in[I_WK]; ldw = 1024; K = 1024; nblk = 32; mode = j ? 0 : 1; WT = (bf16_t*)(ws + WS_WKV) + (size_t)j * 1048576; }
        else { r -= 2 * I_SQ;
        if (r < 8 * I_GU) { const int q = r / I_GU; r -= q * I_GU; const int l = q >> 1, up = q & 1; first = (l == 0); W = (up ? a.in[I_WUP] : a.in[I_WGATE]) + (size_t)l * 1024 * DFF; ldw = DFF; K = 1024; nblk = 88; mode = 2 + up; WT = (bf16_t*)(ws + WS_WGU) + (size_t)l * 5632 * 1024; }
        else { r -= 8 * I_GU; const int l = r / I_DN; first = (l == 0); r -= l * I_DN; W = a.in[I_WDOWN] + (size_t)l * DFF * 1024; ldw = 1024; K = DFF; nblk = 32; mode = 0; WT = (bf16_t*)(ws + WS_WD) + (size_t)l * 1024 * DFF; } } } } }
        if (first == sel) continue;
        const int kb = r / nblk, nb = r % nblk;
        const float wsc = mode == 2 ? -LOG2E : (mode == 3 ? -0.6931471805599453f : 1.0f);
        transpose_item(W, ldw, K, WT, 64 * kb, 32 * nb, dst_row_map(mode, 32 * nb), wsc, scr, lane);
    }
}
DI void prologue_cache(ArgsRef a, int gtid, int NT, long cbeg, long cend) {
    constexpr long NCH = 16777216L;
    const long len = cend - cbeg, step = 4L * NT;
    if (len <= 0) return;
    const int T = (int)((len + step - 1) / step);
    const int ib = (int)cbeg + gtid, ie = (int)cend, ilen = (int)len, istep = (int)step;
    auto ld = [&](f32x4 (&v)[4][2], int t) {
#pragma unroll
        for (int j = 0; j < 4; ++j) { int ci = ib + t * istep + j * NT; if (ci >= ie) ci -= ilen;
            const int which = ci >= (int)NCH; const unsigned c = (unsigned)(which ? ci - (int)NCH : ci);
            const float* src = (const float*)((const char*)(which ? a.in[I_CV] : a.in[I_CK]) + (size_t)(c * 32u));
            v[j][0] = __builtin_nontemporal_load((const f32x4*)src); v[j][1] = __builtin_nontemporal_load((const f32x4*)(src + 4)); }
    };
    auto st = [&](const f32x4 (&v)[4][2], int t) {
#pragma unroll
        for (int j = 0; j < 4; ++j) { int ci = ib + t * istep + j * NT; if (ci >= ie) ci -= ilen;
            const int which = ci >= (int)NCH; const unsigned c = (unsigned)(which ? ci - (int)NCH : ci);
            const unsigned b = c >> 19, rest = c & ((1u << 19) - 1u);
            bf16_t* dst = (bf16_t*)(a.ws + (which ? WS_VS : WS_KS) + (size_t)(b * (unsigned)(KSROWS * 2048) + rest * 16u));
            __builtin_nontemporal_store(pack8f(v[j][0], v[j][1]), (u32x4*)dst); }
    };
    f32x4 va[4][2], vb[4][2];
    int t = 0;
    ld(va, 0);
#pragma unroll 1
    while (t + 2 < T) { ld(vb, t + 1); st(va, t); ld(va, t + 2); st(vb, t + 1); t += 2; }
    if (t + 1 < T) { ld(vb, t + 1); st(va, t); st(vb, t + 1); } else st(va, t);
}
DI void prologue_adaln(ArgsRef a, LAS unsigned char* lds, int vcu, int G, int tid, int wave, int lane) {
    LAS float* sc = (LAS float*)lds;
    LAS float* red = (LAS float*)(lds + 81920);
    float* mod = (float*)(a.ws + WS_MOD);
    for (int it = vcu; it < 8 * 96; it += G) {
        const int l = it / 192, j0 = ((it % 192) >> 1) * 64;
        { const int p = it & 1;
            for (int i = tid; i < 1024; i += 512) {
#pragma unroll
                for (int s = 0; s < 20; ++s) { const int sq = 20 * p + s; const float c = sq < 8 ? a.in[I_CP][sq * 1024 + i] : a.in[I_CS][(sq - 8) * 1024 + i];
                    sc[i * 20 + s] = c / (1.0f + __expf(-c)); }
            }
            LDS_BARRIER();
            float acc[20];
#pragma unroll
            for (int s = 0; s < 20; ++s) acc[s] = 0.f;
            const float* wp = a.in[I_ADAW] + ((size_t)l * 1024 + wave * 128) * 6144 + j0 + lane;
#pragma unroll 1
            for (int i0 = 0; i0 < 128; i0 += 16) {
                float w16[16];
#pragma unroll
                for (int k = 0; k < 16; ++k) w16[k] = wp[(size_t)(i0 + k) * 6144];
#pragma unroll
                for (int k = 0; k < 16; ++k) {
                    const float w = w16[k];
                    const LAS f32x4* s4 = (const LAS f32x4*)(sc + (wave * 128 + i0 + k) * 20);
#pragma unroll
                    for (int q = 0; q < 5; ++q) { const f32x4 v = s4[q]; acc[4 * q] += v.x * w; acc[4 * q + 1] += v.y * w; acc[4 * q + 2] += v.z * w; acc[4 * q + 3] += v.w * w; }
                    if ((k & 3) == 3) asm volatile("" ::: "memory");
                }
            }
#pragma unroll
            for (int s = 0; s < 20; ++s) red[(wave * 20 + s) * 64 + lane] = acc[s];
            LDS_BARRIER();
            for (int o = tid; o < 1280; o += 512) { const int s = o >> 6, jj = o & 63; float v = a.in[I_ADAB][l * 6144 + j0 + jj];
#pragma unroll
                for (int w = 0; w < 8; ++w) v += red[(w * 20 + s) * 64 + jj];
                mod[((size_t)l * 40 + 20 * p + s) * 6144 + j0 + jj] = v; }
            LDS_BARRIER();
        }
    }
}

template <int CTRL, int ROWMASK> DI float dpp_f(float old, float src) {
    return __builtin_bit_cast(float, __builtin_amdgcn_update_dpp(__builtin_bit_cast(int, old), __builtin_bit_cast(int, src), CTRL, ROWMASK, 0xf, false));
}
DI float wave_scan_add(float v) {
    v += dpp_f<0x111, 0xf>(0.f, v); v += dpp_f<0x112, 0xf>(0.f, v); v += dpp_f<0x114, 0xf>(0.f, v); v += dpp_f<0x118, 0xf>(0.f, v);
    v += dpp_f<0x142, 0xa>(0.f, v); v += dpp_f<0x143, 0xc>(0.f, v); return v;
}
DI float wave_scan_max(float v) {
    const float ninf = -3.0e38f;
    v = fmaxf(v, dpp_f<0x111, 0xf>(ninf, v)); v = fmaxf(v, dpp_f<0x112, 0xf>(ninf, v)); v = fmaxf(v, dpp_f<0x114, 0xf>(ninf, v)); v = fmaxf(v, dpp_f<0x118, 0xf>(ninf, v));
    v = fmaxf(v, dpp_f<0x142, 0xa>(ninf, v)); v = fmaxf(v, dpp_f<0x143, 0xc>(ninf, v)); return v;
}

DI float wave_sum_u(float v) { v = wave_scan_add(v); return __builtin_bit_cast(float, __builtin_amdgcn_readlane(__builtin_bit_cast(int, v), 63)); }

DI int ncol(int lane, int q) { return 8 * lane + 512 * (q >> 1) + 4 * (q & 1); }
DI void ld8pair(const void* base, size_t e, int bf, f32x4& a0, f32x4& a1) {
    if (bf) { const u32x4 w = __builtin_nontemporal_load((const u32x4*)((const bf16_t*)base + e)); a0 = (f32x4){bf_lo(w.x), bf_hi(w.x), bf_lo(w.y), bf_hi(w.y)}; a1 = (f32x4){bf_lo(w.z), bf_hi(w.z), bf_lo(w.w), bf_hi(w.w)}; }
    else { a0 = *(const f32x4*)((const float*)base + e); a1 = *(const f32x4*)((const float*)base + e + 4); }
}
template <bool MODULATE, bool GATES>
DI void norm_phase(ArgsRef a, LAS unsigned char* lds, const void* xP, const void* xS, int in_bf, const float* g, const float* modl, int sh_off, int sc_off,
                   const float* Wg  , const float* bg, int vcu, int G, int tid, int wave, int lane) {
    bf16_t* XM = (bf16_t*)(a.ws + WS_XM);
    float* gates = (float*)(a.ws + WS_GATES);
    LAS float* wl = (LAS float*)lds;
    if (GATES) {
        for (int i = tid; i < 1024 * 16; i += 512) { const int r = i >> 4, c = i & 15; wl[c * 1024 + r] = Wg[(size_t)r * MIN + c]; }
        LDS_BARRIER();
    }
    f32x4 gv[4], shv[4], scv[4];
#pragma unroll
    for (int q = 0; q < 4; ++q) { gv[q] = *(const f32x4*)(g + ncol(lane, q)); shv[q] = (f32x4){0.f, 0.f, 0.f, 0.f}; scv[q] = shv[q]; }
    int cur_seq = -1;
    const float bgv = (GATES && lane < 16) ? bg[lane] : 0.f;
    const int NW = G * NWAVES, gw = vcu * NWAVES + wave;
    const int per = (M + NW - 1) / NW;
    const int r0 = gw * per, r1 = (r0 + per < M) ? r0 + per : M;
    f32x4 xn[4];
    auto load_row = [&](int row) {
        const void* xb = row < MP ? xP : xS; const size_t e0 = (size_t)(row < MP ? row : row - MP) * D + 8 * lane;
#pragma unroll
        for (int h2 = 0; h2 < 2; ++h2) ld8pair(xb, e0 + 512 * h2, in_bf, xn[2 * h2], xn[2 * h2 + 1]);
    };
    if (r0 < r1) load_row(r0);
    for (int row = r0; row < r1; ++row) {
        f32x4 x[4]; float ss = 0.f;
#pragma unroll
        for (int q = 0; q < 4; ++q) { x[q] = xn[q]; ss += (x[q][0] * x[q][0] + x[q][1] * x[q][1]) + (x[q][2] * x[q][2] + x[q][3] * x[q][3]); }
        if (row + 1 < r1) load_row(row + 1);
        if (MODULATE) {
            const int seq = row < MP ? (row >> 12) : 8 + ((row - MP) >> 6);
            if (seq != cur_seq) { cur_seq = seq; const float* mp = modl + (size_t)seq * 6144;
#pragma unroll
                for (int q = 0; q < 4; ++q) { shv[q] = *(const f32x4*)(mp + sh_off + ncol(lane, q)); scv[q] = *(const f32x4*)(mp + sc_off + ncol(lane, q)) + 1.0f; } }
        }
        ss = wave_sum_u(ss);
        const float rstd = __builtin_amdgcn_rsqf(ss * (1.0f / D) + EPS);
#pragma unroll
        for (int q = 0; q < 4; ++q) { x[q] = x[q] * rstd * gv[q]; if (MODULATE) x[q] = x[q] * scv[q] + shv[q]; }
        bf16_t* o = XM + (size_t)row * D + 8 * lane;
#pragma unroll
        for (int h2 = 0; h2 < 2; ++h2) *(u32x4*)(o + 512 * h2) = pack8f(x[2 * h2], x[2 * h2 + 1]);
        if (GATES) {
            float mine = 0.f;
#pragma unroll
            for (int c = 0; c < 16; ++c) {
                float acc = 0.f;
#pragma unroll
                for (int q = 0; q < 4; ++q) { const f32x4 w = *(const LAS f32x4*)(wl + c * 1024 + ncol(lane, q)); acc += (x[q][0] * w.x + x[q][1] * w.y) + (x[q][2] * w.z + x[q][3] * w.w); }
                const float t = wave_sum_u(acc); if (lane == c) mine = t;
                if (c & 1) asm volatile("" ::: "memory");
            }
            if (lane < 16) gates[(size_t)row * 16 + lane] = mine + bgv;
        }
    }
    if (GATES) LDS_BARRIER();
}

DI void norm_dual_phase(ArgsRef a, const bf16_t* XB, bf16_t* XM, bf16_t* XM2, const float* gkv, const float* g2, const float* modl2, int sh_off, int sc_off, int vcu, int G, int wave, int lane) {
    f32x4 gk[4], gv[4], shv[4], scv[4];
#pragma unroll
    for (int q = 0; q < 4; ++q) { gk[q] = *(const f32x4*)(gkv + ncol(lane, q)); gv[q] = *(const f32x4*)(g2 + ncol(lane, q)); shv[q] = (f32x4){0.f, 0.f, 0.f, 0.f}; scv[q] = shv[q]; }
    int cur_seq = -1;
    const int NW = G * NWAVES, gw = vcu * NWAVES + wave;
    const int per = (M + NW - 1) / NW;
    const int r0 = gw * per, r1 = (r0 + per < M) ? r0 + per : M;
    f32x4 xn[4];
    auto load_row = [&](int row) {
#pragma unroll
        for (int h2 = 0; h2 < 2; ++h2) ld8pair(XB, (size_t)row * D + 8 * lane + 512 * h2, 1, xn[2 * h2], xn[2 * h2 + 1]);
    };
    if (r0 < r1) load_row(r0);
    for (int row = r0; row < r1; ++row) {
        f32x4 x[4]; float ss = 0.f;
#pragma unroll
        for (int q = 0; q < 4; ++q) { x[q] = xn[q]; ss += (x[q][0] * x[q][0] + x[q][1] * x[q][1]) + (x[q][2] * x[q][2] + x[q][3] * x[q][3]); }
        if (row + 1 < r1) load_row(row + 1);
        const int seq = row < MP ? (row >> 12) : 8 + ((row - MP) >> 6);
        if (seq != cur_seq) { cur_seq = seq; const float* mp = modl2 + (size_t)seq * 6144;
#pragma unroll
            for (int q = 0; q < 4; ++q) { shv[q] = *(const f32x4*)(mp + sh_off + ncol(lane, q)); scv[q] = *(const f32x4*)(mp + sc_off + ncol(lane, q)) + 1.0f; } }
        ss = wave_sum_u(ss);
        const float rstd = __builtin_amdgcn_rsqf(ss * (1.0f / D) + EPS);
        bf16_t* o1 = XM + (size_t)row * D + 8 * lane; bf16_t* o2 = XM2 + (size_t)row * D + 8 * lane;
#pragma unroll
        for (int h2 = 0; h2 < 2; ++h2) {
            const f32x4 xa = x[2 * h2] * rstd, xb2 = x[2 * h2 + 1] * rstd;
            *(u32x4*)(o1 + 512 * h2) = pack8f(xa * gk[2 * h2], xb2 * gk[2 * h2 + 1]);
            *(u32x4*)(o2 + 512 * h2) = pack8f(xa * gv[2 * h2] * scv[2 * h2] + shv[2 * h2], xb2 * gv[2 * h2 + 1] * scv[2 * h2 + 1] + shv[2 * h2 + 1]);
        }
    }
}

constexpr int ML_Q = 0, ML_K = 9216, ML_KW = 18432, ML_V = 30720, ML_BUF = 51200;
constexpr int ML_SCR = 2 * ML_BUF;
constexpr int ML_RED = ML_SCR + 8 * 2048;
constexpr int ML_NP = ML_RED + 1024;
DI float logsigmoidf(float x) { return fminf(x, 0.f) - __logf(1.0f + __expf(-fabsf(x))); }
DI void mlstm_unit(ArgsRef a, LAS unsigned char* lds, int l, int seq, int h, int tid, int wave, int lane) {
    const bool isP = seq < 8; const int NC = isP ? 64 : 1;
    const int rowbase0 = isP ? seq * 4096 : MP + (seq - 8) * 64;
    const bf16_t* PROJ = (const bf16_t*)(a.ws + WS_PROJ);
    const float* GT = (const float*)(a.ws + WS_GATES);
    bf16_t* HG = (bf16_t*)(a.ws + WS_HG);
    const int dvs = wave & 3, th = wave >> 2;
    LAS float* scr = (LAS float*)(lds + ML_SCR + wave * 2048);
    LAS float* red = (LAS float*)(lds + ML_RED);
    LAS float* npart = (LAS float*)(lds + ML_NP);
    f32x16 Cst[2]; float nst, mprev;
    const int sidx = isP ? 0 : ((l * 32 + (seq - 8)) * 8 + h);
    if (isP) { Cst[0] = f32x16{}; Cst[1] = f32x16{}; nst = 0.f; mprev = 0.f; }
    else {
        const float* Cin = a.in[I_SC] + (size_t)sidx * 8192 + 32 * dvs + (lane & 31) + (lane >> 5) * 512;
#pragma unroll
        for (int kb = 0; kb < 2; ++kb)
#pragma unroll
            for (int i = 0; i < 16; ++i) Cst[kb][i] = Cin[(32 * kb + crow(i, 0)) * 128];
        nst = a.in[I_SN][(size_t)sidx * 64 + lane]; mprev = a.in[I_SM][sidx];
    }
    scr[448 + lane] = nst;
    const int srow = tid >> 3, scc = tid & 7;
    u32x4 pq, pk, pv0, pv1; u32x2 ogn[4]; float pig, pfg;
    auto issue_loads = [&](int c) {
        const size_t rb = (size_t)(rowbase0 + c * 64);
        const bf16_t* pr = PROJ + (rb + srow) * NPROJ;
        pq = *(const u32x4*)(pr + h * 64 + scc * 8);
        pk = *(const u32x4*)(pr + 512 + h * 64 + scc * 8);
        { const int idx = tid; const int vr = idx >> 4, vc = idx & 15; pv0 = *(const u32x4*)(PROJ + (rb + vr) * NPROJ + 1024 + h * 128 + vc * 8); }
        { const int idx = tid + 512; const int vr = idx >> 4, vc = idx & 15; pv1 = *(const u32x4*)(PROJ + (rb + vr) * NPROJ + 1024 + h * 128 + vc * 8); }
        pig = GT[(rb + lane) * 16 + h]; pfg = GT[(rb + lane) * 16 + 8 + h];
        const bf16_t* po = PROJ + (rb + 32 * th + (lane & 31)) * NPROJ + 2048 + h * 128 + 32 * dvs + 4 * (lane >> 5);
#pragma unroll
        for (int g = 0; g < 4; ++g) ogn[g] = *(const u32x2*)(po + 8 * g);
    };
    float bendN, A63N;
    auto gate_tables = [&](int par) {
        const float b = wave_scan_add(logsigmoidf(pfg));
        const float av = pig - b;
        const float cm = wave_scan_max(av);
        A63N = __builtin_bit_cast(float, __builtin_amdgcn_readlane(__builtin_bit_cast(int, cm), 63));
        bendN = __builtin_bit_cast(float, __builtin_amdgcn_readlane(__builtin_bit_cast(int, b), 63));
        scr[par * 64 + lane] = av; scr[128 + par * 64 + lane] = b; scr[256 + par * 64 + lane] = cm; scr[384 + lane] = __expf(av - A63N);
    };
    auto write_tiles = [&](int par) {
        LAS unsigned char* buf = lds + par * ML_BUF;
        *(LAS u32x4*)(buf + ML_Q + srow * 144 + scc * 16) = pq;
        *(LAS u32x4*)(buf + ML_K + srow * 144 + scc * 16) = pk;
        const float w = scr[384 + srow];
        u32x4 kw; kw.x = pk2(bf_lo(pk.x) * w, bf_hi(pk.x) * w); kw.y = pk2(bf_lo(pk.y) * w, bf_hi(pk.y) * w); kw.z = pk2(bf_lo(pk.z) * w, bf_hi(pk.z) * w); kw.w = pk2(bf_lo(pk.w) * w, bf_hi(pk.w) * w);
        *(LAS u32x4*)(buf + ML_KW + srow * 192 + scc * 16) = kw;
        { const int idx = tid; *(LAS u32x4*)(buf + ML_V + (idx >> 4) * 320 + (idx & 15) * 16) = pv0; }
        { const int idx = tid + 512; *(LAS u32x4*)(buf + ML_V + (idx >> 4) * 320 + (idx & 15) * 16) = pv1; }
    };
    issue_loads(0);
    gate_tables(0);
    asm volatile("s_waitcnt lgkmcnt(0)" ::: "memory");
    write_tiles(0);
    f32x4 hgr[4];
    { const float* hgv = a.in[I_MHG] + ((size_t)l * 8 + h) * 128 + 32 * dvs + 4 * (lane >> 5);
#pragma unroll
      for (int g = 0; g < 4; ++g) hgr[g] = *(const f32x4*)(hgv + 8 * g); }
    for (int c = 0; c < NC; ++c) {
        const int par = c & 1;
        LAS unsigned char* buf = lds + par * ML_BUF;
        LDS_BARRIER();
        int lo_ = lane; asm volatile("" : "+v"(lo_));
        const int r = lo_ & 31, hh = lo_ >> 5, q16 = (lo_ & 15) >> 2, p16 = lo_ & 3, g16 = (lo_ >> 4) & 1;
        const float bend = bendN, A63 = A63N;
        u32x2 og[4];
#pragma unroll
        for (int g = 0; g < 4; ++g) og[g] = ogn[g];
        if (c + 1 < NC) issue_loads(c + 1);
        const int t = 32 * th + r;
        const float bt = scr[128 + par * 64 + t], cmt = scr[256 + par * 64 + t];
        const float Mt = fmaxf(mprev, cmt), mt = bt + Mt, winter = __expf(mprev - Mt);
        const size_t rb = (size_t)(rowbase0 + c * 64);
        f32x16 sD = f32x16{}, sF = f32x16{};
        bf16x8 qf[4];
#pragma unroll
        for (int ks = 0; ks < 4; ++ks) {
            qf[ks] = *(const LAS bf16x8*)(buf + ML_Q + t * 144 + ks * 32 + hh * 16);
            const bf16x8 kD = *(const LAS bf16x8*)(buf + ML_K + t * 144 + ks * 32 + hh * 16);
            sD = MFMA32(kD, qf[ks], sD);
        }
        if (th == 1) {
#pragma unroll
            for (int ks = 0; ks < 4; ++ks) { const bf16x8 kF = *(const LAS bf16x8*)(buf + ML_K + r * 144 + ks * 32 + hh * 16); sF = MFMA32(kF, qf[ks], sF); }
        }
        f32x16 acc = f32x16{};
#pragma unroll
        for (int kb = 0; kb < 2; ++kb)
#pragma unroll
            for (int s = 0; s < 2; ++s) {
                const LAS unsigned char* qp = buf + ML_Q + t * 144 + (32 * kb + 16 * s + 4 * hh) * 2;
                const v4i16 lo = *(const LAS v4i16*)qp, hi = *(const LAS v4i16*)(qp + 16);
                const bf16x8 qb = __builtin_shufflevector(lo, hi, 0, 1, 2, 3, 4, 5, 6, 7);
                acc = MFMA32(pack_step(Cst[kb], s), qb, acc);
            }
        float psum = 0.f;
#pragma unroll
        for (int i = 0; i < 16; ++i) {
            const int s0 = crow(i, hh);
            const float w0 = __expf(scr[par * 64 + 32 * th + s0] - Mt);
            sD[i] = (s0 <= r) ? sD[i] * w0 : 0.f;
            psum += sD[i];
        }
        if (th == 1) {
#pragma unroll
            for (int i = 0; i < 16; ++i) { const float w1 = __expf(scr[par * 64 + crow(i, hh)] - Mt); sF[i] *= w1; psum += sF[i]; }
        }
        psum = xor32_sum(psum);
        float qn = 0.f;
#pragma unroll
        for (int ks = 0; ks < 4; ++ks) { const u32x4 qq = __builtin_bit_cast(u32x4, qf[ks]); const LAS float* np = scr + 448 + 16 * ks + 8 * hh;
            qn += bf_lo(qq.x) * np[0] + bf_hi(qq.x) * np[1] + bf_lo(qq.y) * np[2] + bf_hi(qq.y) * np[3] + bf_lo(qq.z) * np[4] + bf_hi(qq.z) * np[5] + bf_lo(qq.w) * np[6] + bf_hi(qq.w) * np[7]; }
        qn = xor32_sum(qn);
        const float den = winter * qn + psum;
        const float inv = __builtin_amdgcn_rcpf(fmaxf(fabsf(den), __expf(-mt)));
#pragma unroll
        for (int i = 0; i < 16; ++i) acc[i] *= winter;
        {
            const LAS unsigned char* vb = buf + ML_V + (4 * hh + q16) * 320 + (32 * dvs + 16 * g16 + 4 * p16) * 2;
            const LAS unsigned char* vd = vb + (32 * th) * 320;
#pragma unroll
            for (int s = 0; s < 2; ++s) { const bf16x8 vf = tr_pair(vd + (16 * s) * 320, vd + (16 * s + 8) * 320); acc = MFMA32(vf, pack_step(sD, s), acc); }
            asm volatile("" ::: "memory");
            if (th == 1) {
#pragma unroll
                for (int s = 0; s < 2; ++s) { const bf16x8 vf = tr_pair(vb + (16 * s) * 320, vb + (16 * s + 8) * 320); acc = MFMA32(vf, pack_step(sF, s), acc); }
            }
        }
        {
            float ps = 0.f;
#pragma unroll
            for (int i = 0; i < 8; ++i) { const unsigned short v = *(const LAS unsigned short*)(buf + ML_KW + (8 * wave + i) * 192 + lane * 2); ps += __uint_as_float((unsigned)v << 16); }
            npart[wave * 64 + lane] = ps;
        }
        float hs = 0.f;
#pragma unroll
        for (int i = 0; i < 16; ++i) { acc[i] *= inv; hs += acc[i] * acc[i]; }
        hs = xor32_sum(hs);
        if (hh == 0) red[(th * 4 + dvs) * 32 + r] = hs;
        f32x16 Cl[2]; Cl[0] = f32x16{}; Cl[1] = f32x16{};
        {
            const LAS unsigned char* vb = buf + ML_V + (8 * hh + q16) * 320 + (32 * dvs + 16 * g16 + 4 * p16) * 2;
            const LAS unsigned char* kb_ = buf + ML_KW + (8 * hh + q16) * 192 + (16 * g16 + 4 * p16) * 2;
#pragma unroll
            for (int ks = 0; ks < 4; ++ks) {
                const bf16x8 bfv = tr_pair(vb + (16 * ks) * 320, vb + (16 * ks + 4) * 320);
#pragma unroll
                for (int kb = 0; kb < 2; ++kb) { const bf16x8 af = tr_pair(kb_ + (16 * ks) * 192 + 64 * kb, kb_ + (16 * ks + 4) * 192 + 64 * kb); Cl[kb] = MFMA32(af, bfv, Cl[kb]); }
                asm volatile("" ::: "memory");
            }
        }
        const float mloc = bend + A63, mnew = fmaxf(bend + mprev, mloc);
        const float wo = __expf(bend + mprev - mnew), wn = __expf(mloc - mnew);
#pragma unroll
        for (int kb = 0; kb < 2; ++kb)
#pragma unroll
            for (int i = 0; i < 16; ++i) Cst[kb][i] = wo * Cst[kb][i] + wn * Cl[kb][i];
        mprev = mnew;
        if (c + 1 < NC) { gate_tables(par ^ 1); asm volatile("s_waitcnt lgkmcnt(0)" ::: "memory"); write_tiles(par ^ 1); }
        LDS_BARRIER();
        const float tot = red[(th * 4 + 0) * 32 + r] + red[(th * 4 + 1) * 32 + r] + red[(th * 4 + 2) * 32 + r] + red[(th * 4 + 3) * 32 + r];
        const float rstd = __builtin_amdgcn_rsqf(tot * (1.0f / 128.0f) + EPS);
        u32x2 ov[4];
#pragma unroll
        for (int g = 0; g < 4; ++g) {
            const f32x4 hg4 = hgr[g];
            const float o0 = bf_lo(og[g].x), o1 = bf_hi(og[g].x), o2 = bf_lo(og[g].y), o3 = bf_hi(og[g].y);
            const float v0 = acc[4 * g + 0] * rstd * hg4.x * __builtin_amdgcn_rcpf(1.0f + __expf(-o0)), v1 = acc[4 * g + 1] * rstd * hg4.y * __builtin_amdgcn_rcpf(1.0f + __expf(-o1));
            const float v2 = acc[4 * g + 2] * rstd * hg4.z * __builtin_amdgcn_rcpf(1.0f + __expf(-o2)), v3 = acc[4 * g + 3] * rstd * hg4.w * __builtin_amdgcn_rcpf(1.0f + __expf(-o3));
            ov[g].x = pk2(v0, v1); ov[g].y = pk2(v2, v3);
        }
#pragma unroll
        for (int gp = 0; gp < 2; ++gp) {
            const auto sx = __builtin_amdgcn_permlane32_swap(ov[2 * gp].x, ov[2 * gp + 1].x, false, false), sy = __builtin_amdgcn_permlane32_swap(ov[2 * gp].y, ov[2 * gp + 1].y, false, false);
            u32x4 w; w.x = sx[0]; w.y = sy[0]; w.z = sx[1]; w.w = sy[1];
            *(u32x4*)(HG + (size_t)(rb + t) * D + h * 128 + 32 * dvs + 16 * gp + 8 * hh) = w;
        }
        {
            float nl = 0.f;
#pragma unroll
            for (int w = 0; w < 8; ++w) nl += npart[w * 64 + lane];
            nst = wo * nst + wn * nl; scr[448 + lane] = nst;
        }
    }
    {
        float* out = a.out;
        const size_t oidx = isP ? (size_t)((l * 8 + seq) * 8 + h) : (size_t)sidx;
        float* Co = out + (isP ? OFF_PC : OFF_SC) + oidx * 8192 + 32 * dvs + (lane & 31) + (lane >> 5) * 512;
        if (th == 0) {
#pragma unroll
            for (int kb = 0; kb < 2; ++kb)
#pragma unroll
                for (int i = 0; i < 16; ++i) Co[(32 * kb + crow(i, 0)) * 128] = Cst[kb][i];
        }
        if (wave == 0) { out[(isP ? OFF_PN : OFF_SN) + oidx * 64 + lane] = nst; if (lane == 0) out[(isP ? OFF_PM : OFF_SM) + oidx] = mprev; }
    }
    WG_BARRIER();
}
DI void mlstm_phase(ArgsRef a, LAS unsigned char* lds, int l, int vcu, int G, int tid, int wave, int lane) {
    const int nrest = G > 64 ? G - 64 : G, first = G > 64 ? 64 : 0;
    int u = vcu; bool inP = true;
#pragma unroll 1
    for (;;) {
        int seq, h;
        if (inP) { if (u >= 64) { inP = false; u = vcu >= first ? vcu - first : 256; continue; } seq = u >> 3; h = u & 7; u += G; }
        else { if (u >= 256) break; seq = 8 + (u >> 3); h = u & 7; u += nrest; }
        mlstm_unit(a, lds, l, seq, h, tid, wave, lane);
    }
    if (l == 0 && vcu >= first) {
        prologue_weights(a, lds, (vcu - first) * NWAVES + wave, nrest * NWAVES, wave, lane, 1);
        prologue_cache(a, (vcu - first) * 512 + tid, nrest * 512, CACHE_T3, CACHE_CH);
    }
}

constexpr int ML_NUNITS = 4352;
DI void ml_unit_decode(int u, int& rowbase, int& h) {
    if (u < 4096) { rowbase = (u >> 9) * 4096 + (u & 63) * 64; h = (u >> 6) & 7; } else { const int us = u - 4096; rowbase = MP + (us >> 3) * 64; h = us & 7; }
}
constexpr int MA_KW = 0, MA_V = 12288, MA_BUF = 32768;
constexpr int MA_SCR = 2 * MA_BUF, MA_NP = MA_SCR + 8 * 256;
DI void mlA_phase(ArgsRef a, LAS unsigned char* lds, int vcu, int G, int tid, int wave, int lane) {
    const bf16_t* PROJ = (const bf16_t*)(a.ws + WS_PROJ);
    const float* GT = (const float*)(a.ws + WS_GATES);
    float* CL = (float*)(a.ws + WS_CL); float* NL = (float*)(a.ws + WS_NL); float* TAB = (float*)(a.ws + WS_TAB);
    const int per = (ML_NUNITS + G - 1) / G, u0 = vcu * per, u1 = (u0 + per < ML_NUNITS) ? u0 + per : ML_NUNITS;
    if (u0 >= u1) return;
    const int dvs = wave & 3, kb = wave >> 2;
    LAS float* wT = (LAS float*)(lds + MA_SCR + wave * 256);
    LAS float* npart = (LAS float*)(lds + MA_NP);
    const int srow = tid >> 3, scc = tid & 7;
    struct InA { u32x4 pk, pv0, pv1; float pig, pfg; };
    InA X, Y;
    auto issue_loads = [&](InA& in, int u) {
        int rb, h; ml_unit_decode(u, rb, h);
        in.pk = *(const u32x4*)(PROJ + (size_t)(rb + srow) * NPROJ + 512 + h * 64 + scc * 8);
        { const int idx = tid; in.pv0 = *(const u32x4*)(PROJ + (size_t)(rb + (idx >> 4)) * NPROJ + 1024 + h * 128 + (idx & 15) * 8); }
        { const int idx = tid + 512; in.pv1 = *(const u32x4*)(PROJ + (size_t)(rb + (idx >> 4)) * NPROJ + 1024 + h * 128 + (idx & 15) * 8); }
        in.pig = GT[(size_t)(rb + lane) * 16 + h]; in.pfg = GT[(size_t)(rb + lane) * 16 + 8 + h];
    };
    auto stage = [&](const InA& in, int u, int par) {
        const float b = wave_scan_add(logsigmoidf(in.pfg));
        const float av = in.pig - b;
        const float cm = wave_scan_max(av);
        const float A63 = __builtin_bit_cast(float, __builtin_amdgcn_readlane(__builtin_bit_cast(int, cm), 63));
        const float bend = __builtin_bit_cast(float, __builtin_amdgcn_readlane(__builtin_bit_cast(int, b), 63));
        wT[lane] = __expf(av - A63);
        if (wave == 0) { float* t = TAB + (size_t)u * 256; t[lane] = av; t[64 + lane] = b; t[128 + lane] = cm; if (lane == 0) { t[192] = bend; t[193] = bend + A63; } }
        asm volatile("s_waitcnt lgkmcnt(0)" ::: "memory");
        LAS unsigned char* buf = lds + par * MA_BUF;
        const float w = wT[srow]; const u32x4 pk = in.pk;
        u32x4 kw; kw.x = pk2(bf_lo(pk.x) * w, bf_hi(pk.x) * w); kw.y = pk2(bf_lo(pk.y) * w, bf_hi(pk.y) * w); kw.z = pk2(bf_lo(pk.z) * w, bf_hi(pk.z) * w); kw.w = pk2(bf_lo(pk.w) * w, bf_hi(pk.w) * w);
        *(LAS u32x4*)(buf + MA_KW + srow * 192 + scc * 16) = kw;
        { const int idx = tid; *(LAS u32x4*)(buf + MA_V + (idx >> 4) * 320 + (idx & 15) * 16) = in.pv0; }
        { const int idx = tid + 512; *(LAS u32x4*)(buf + MA_V + (idx >> 4) * 320 + (idx & 15) * 16) = in.pv1; }
    };
    auto body = [&](int u, int par, InA& nxt) {
        LAS unsigned char* buf = lds + par * MA_BUF;
        LDS_BARRIER();
        int lo_ = lane; asm volatile("" : "+v"(lo_));
        const int r = lo_ & 31, hh = lo_ >> 5, q16 = (lo_ & 15) >> 2, p16 = lo_ & 3, g16 = (lo_ >> 4) & 1;
        if (u + 1 < u1) stage(nxt, u + 1, par ^ 1);
        if (u + 3 < u1) issue_loads(nxt, u + 3);
        if (u > u0 && wave == 0) {
            float nl = 0.f;
#pragma unroll
            for (int w = 0; w < 8; ++w) nl += npart[((par ^ 1) * 8 + w) * 64 + lo_];
            NL[(size_t)(u - 1) * 64 + lo_] = nl;
        }
        {
            float ps = 0.f;
#pragma unroll
            for (int i = 0; i < 8; ++i) { const unsigned short v = *(const LAS unsigned short*)(buf + MA_KW + (8 * wave + i) * 192 + lo_ * 2); ps += __uint_as_float((unsigned)v << 16); }
            npart[(par * 8 + wave) * 64 + lo_] = ps;
        }
        f32x16 Cl = f32x16{};
        {
            const LAS unsigned char* vb = buf + MA_V + (8 * hh + q16) * 320 + (32 * dvs + 16 * g16 + 4 * p16) * 2;
            const LAS unsigned char* kp = buf + MA_KW + (8 * hh + q16) * 192 + (32 * kb + 16 * g16 + 4 * p16) * 2;
            bf16x8 af[4], bfv[4];
#pragma unroll
            for (int ks = 0; ks < 4; ++ks) { bfv[ks] = tr_pair(vb + (16 * ks) * 320, vb + (16 * ks + 4) * 320); af[ks] = tr_pair(kp + (16 * ks) * 192, kp + (16 * ks + 4) * 192); }
#pragma unroll
            for (int ks = 0; ks < 4; ++ks) Cl = MFMA32(af[ks], bfv[ks], Cl);
        }
        float* Co = CL + (size_t)u * 8192 + (size_t)((kb * 4 + dvs) * 64 + lo_) * 16;
#pragma unroll
        for (int g = 0; g < 4; ++g) *(f32x4*)(Co + 4 * g) = (f32x4){Cl[4 * g], Cl[4 * g + 1], Cl[4 * g + 2], Cl[4 * g + 3]};
    };
    issue_loads(X, u0); if (u0 + 1 < u1) issue_loads(Y, u0 + 1);
    stage(X, u0, 0);
    if (u0 + 2 < u1) issue_loads(X, u0 + 2);
#pragma unroll 1
    for (int u = u0; u < u1; u += 2) {
        body(u, 0, Y);
        if (u + 1 < u1) body(u + 1, 1, X);
    }
    LDS_BARRIER();
    if (wave == 0) { const int par = (u1 - 1 - u0) & 1; float nl = 0.f;
#pragma unroll
        for (int w = 0; w < 8; ++w) nl += npart[(par * 8 + w) * 64 + lane];
        NL[(size_t)(u1 - 1) * 64 + lane] = nl; }
    LDS_BARRIER();
}
DI void mlB_phase(ArgsRef a, int l, int vcu, int G, int tid) {
    const float* CL = (const float*)(a.ws + WS_CL); const float* NL = (const float*)(a.ws + WS_NL); const float* TAB = (const float*)(a.ws + WS_TAB);
    bf16_t* CP = (bf16_t*)(a.ws + WS_CP); float* NPREV = (float*)(a.ws + WS_NPREV); float* MPREV = (float*)(a.ws + WS_MPREV);
    float* out = a.out;
#pragma unroll 1
    for (int cp = vcu; cp < 256; cp += G) {
        const int chain = cp >> 2, part = cp & 3, e0 = part * 2048 + tid * 4;
        f32x4 C = (f32x4){0.f, 0.f, 0.f, 0.f}, n4 = C; float m = 0.f;
        const bool nthr = (part == 0 && tid < 16);
        const float* cl = CL + (size_t)chain * 64 * 8192 + e0; bf16_t* cpo = CP + (size_t)chain * 64 * 8192 + e0;
        const int nblk = e0 >> 10, nln = (e0 >> 4) & 63, ni0 = e0 & 15;
        const int nat0 = (32 * (nblk >> 2) + 8 * (ni0 >> 2) + 4 * (nln >> 5)) * 128 + 32 * (nblk & 3) + (nln & 31);
        float woL = 0.f, wnL = 0.f, mpL = 0.f;
        { const int ln = tid & 63; const float be = TAB[(size_t)(chain * 64 + ln) * 256 + 192], ml = TAB[(size_t)(chain * 64 + ln) * 256 + 193];
#pragma unroll 1
          for (int c = 0; c < 64; ++c) {
              const float b = __builtin_bit_cast(float, __builtin_amdgcn_readlane(__builtin_bit_cast(int, be), c)), q = __builtin_bit_cast(float, __builtin_amdgcn_readlane(__builtin_bit_cast(int, ml), c));
              const float mnew = fmaxf(b + m, q), wo = __expf(b + m - mnew), wn = __expf(q - mnew);
              if (ln == c) { woL = wo; wnL = wn; mpL = m; }
              m = mnew;
          } }
        f32x4 nb[8], nn[8];
        const float* nlp = NL + (size_t)chain * 64 * 64 + (nthr ? tid * 4 : 0);
#pragma unroll
        for (int j = 0; j < 8; ++j) { nb[j] = __builtin_nontemporal_load((const f32x4*)(cl + (size_t)j * 8192)); nn[j] = *(const f32x4*)(nlp + j * 64); }
#pragma unroll 1
        for (int cb = 0; cb < 8; ++cb) {
            f32x4 cb8[8], cn8[8];
#pragma unroll
            for (int j = 0; j < 8; ++j) { cb8[j] = nb[j]; cn8[j] = nn[j]; }
            if (cb + 1 < 8) {
#pragma unroll
                for (int j = 0; j < 8; ++j) { nb[j] = __builtin_nontemporal_load((const f32x4*)(cl + (size_t)(8 * (cb + 1) + j) * 8192)); nn[j] = *(const f32x4*)(nlp + (8 * (cb + 1) + j) * 64); }
            }
#pragma unroll
            for (int j = 0; j < 8; ++j) {
                const int c = 8 * cb + j, u = chain * 64 + c;
                const float wo = __builtin_bit_cast(float, __builtin_amdgcn_readlane(__builtin_bit_cast(int, woL), c)), wn = __builtin_bit_cast(float, __builtin_amdgcn_readlane(__builtin_bit_cast(int, wnL), c));
                { u32x2 w; w.x = pk2(C.x, C.y); w.y = pk2(C.z, C.w); *(u32x2*)(cpo + (size_t)c * 8192) = w; }
                C = C * wo + cb8[j] * wn;
                if (nthr) { *(f32x4*)(NPREV + (size_t)u * 64 + tid * 4) = n4; if (tid == 0) MPREV[u] = __builtin_bit_cast(float, __builtin_amdgcn_readlane(__builtin_bit_cast(int, mpL), c)); }
                n4 = n4 * wo + cn8[j] * wn;
            }
        }
        const size_t oidx = (size_t)(l * 64 + chain);
        { float* po = out + OFF_PC + oidx * 8192 + nat0; po[0] = C.x; po[128] = C.y; po[256] = C.z; po[384] = C.w; }
        if (nthr) { *(f32x4*)(out + OFF_PN + oidx * 64 + tid * 4) = n4; if (tid == 0) out[OFF_PM + oidx] = m; }
    }
    const int NT = G * 512, gt = vcu * 512 + tid;
    for (int i = gt; i < 256 * 2048; i += NT) {
        const int us = i >> 11, q = i & 2047, u = 4096 + us; const size_t sidx = (size_t)l * 256 + us;
        const float m = a.in[I_SM][sidx];
        const float bend = TAB[(size_t)u * 256 + 192], mloc = TAB[(size_t)u * 256 + 193];
        const float mnew = fmaxf(bend + m, mloc), wo = __expf(bend + m - mnew), wn = __expf(mloc - mnew);
        const int e = q * 4, sblk = e >> 10, sln = (e >> 4) & 63, si0 = e & 15;
        const int nat = (32 * (sblk >> 2) + 8 * (si0 >> 2) + 4 * (sln >> 5)) * 128 + 32 * (sblk & 3) + (sln & 31);
        const float* ci = a.in[I_SC] + sidx * 8192 + nat; float* co = out + OFF_SC + sidx * 8192 + nat;
        const f32x4 cl4 = *(const f32x4*)(CL + (size_t)u * 8192 + e);
        co[0] = ci[0] * wo + cl4.x * wn; co[128] = ci[128] * wo + cl4.y * wn; co[256] = ci[256] * wo + cl4.z * wn; co[384] = ci[384] * wo + cl4.w * wn;
        if (q < 16) { const f32x4 nin = *(const f32x4*)(a.in[I_SN] + sidx * 64 + q * 4), nl4 = *(const f32x4*)(NL + (size_t)u * 64 + q * 4);
            *(f32x4*)(out + OFF_SN + sidx * 64 + q * 4) = nin * wo + nl4 * wn; if (q == 0) out[OFF_SM + sidx] = mnew; }
    }
}
constexpr int MC_Q = 0, MC_K = 9216, MC_V = 18432, MC_BUF = 38912;
constexpr int MC_SCR = 2 * MC_BUF;
constexpr int MC_RED = MC_SCR + 8 * 2048, MC_HG = MC_RED + 1024;
DI void mlC_phase(ArgsRef a, LAS unsigned char* lds, int l, int vcu, int G, int tid, int wave, int lane) {
    const bf16_t* PROJ = (const bf16_t*)(a.ws + WS_PROJ);
    const float* TAB = (const float*)(a.ws + WS_TAB); const bf16_t* CP = (const bf16_t*)(a.ws + WS_CP);
    const float* NPREV = (const float*)(a.ws + WS_NPREV); const float* MPREV = (const float*)(a.ws + WS_MPREV);
    bf16_t* HG = (bf16_t*)(a.ws + WS_HG);
    const int per = (ML_NUNITS + G - 1) / G, u0 = vcu * per, u1 = (u0 + per < ML_NUNITS) ? u0 + per : ML_NUNITS;
    if (u0 >= u1) return;
    const int dvs = wave & 3, th = wave >> 2;
    LAS float* scr = (LAS float*)(lds + MC_SCR + wave * 2048);
    LAS float* red = (LAS float*)(lds + MC_RED);
    const int srow = tid >> 3, scc = tid & 7;
    LAS float* hgl = (LAS float*)(lds + MC_HG);
    for (int i = tid; i < 1024; i += 512) hgl[i] = a.in[I_MHG][(size_t)l * 1024 + i];
    struct InC { u32x4 pq, pk, pv0, pv1; float ta, tb, tc, tn; };
    InC X, Y; u32x2 ogn[4]; float mpn; bf16x8 Cn[2][2];
    auto issue_tiles = [&](InC& in, int u) {
        int rb, h; ml_unit_decode(u, rb, h);
        const bf16_t* pr = PROJ + (size_t)(rb + srow) * NPROJ;
        in.pq = *(const u32x4*)(pr + h * 64 + scc * 8);
        in.pk = *(const u32x4*)(pr + 512 + h * 64 + scc * 8);
        { const int idx = tid; in.pv0 = *(const u32x4*)(PROJ + (size_t)(rb + (idx >> 4)) * NPROJ + 1024 + h * 128 + (idx & 15) * 8); }
        { const int idx = tid + 512; in.pv1 = *(const u32x4*)(PROJ + (size_t)(rb + (idx >> 4)) * NPROJ + 1024 + h * 128 + (idx & 15) * 8); }
        const float* t = TAB + (size_t)u * 256; in.ta = t[lane]; in.tb = t[64 + lane]; in.tc = t[128 + lane];
        if (u < 4096) in.tn = NPREV[(size_t)u * 64 + lane]; else in.tn = a.in[I_SN][((size_t)l * 256 + (u - 4096)) * 64 + lane];
    };
    auto issue_regs = [&](int u) {
        int rb, h; ml_unit_decode(u, rb, h);
        const bf16_t* po = PROJ + (size_t)(rb + 32 * th + (lane & 31)) * NPROJ + 2048 + h * 128 + 32 * dvs + 4 * (lane >> 5);
#pragma unroll
        for (int g = 0; g < 4; ++g) ogn[g] = *(const u32x2*)(po + 8 * g);
        if (u < 4096) {
            mpn = MPREV[u];
#pragma unroll
            for (int kb = 0; kb < 2; ++kb) { const bf16_t* cp = CP + (size_t)u * 8192 + (size_t)((kb * 4 + dvs) * 64 + lane) * 16;
                Cn[kb][0] = *(const bf16x8*)cp; Cn[kb][1] = *(const bf16x8*)(cp + 8); }
        } else {
            const size_t sidx = (size_t)l * 256 + (u - 4096); mpn = a.in[I_SM][sidx];
            const float* Cin = a.in[I_SC] + sidx * 8192 + 32 * dvs + (lane & 31) + (lane >> 5) * 512;
#pragma unroll
            for (int kb = 0; kb < 2; ++kb) { f32x16 cf;
#pragma unroll
                for (int i = 0; i < 16; ++i) cf[i] = Cin[(32 * kb + (i & 3) + 8 * (i >> 2)) * 128];
                Cn[kb][0] = pack_step(cf, 0); Cn[kb][1] = pack_step(cf, 1); }
        }
    };
    auto stage = [&](const InC& in, int par) {
        LAS unsigned char* buf = lds + par * MC_BUF;
        *(LAS u32x4*)(buf + MC_Q + srow * 144 + scc * 16) = in.pq;
        *(LAS u32x4*)(buf + MC_K + srow * 144 + scc * 16) = in.pk;
        { const int idx = tid; *(LAS u32x4*)(buf + MC_V + (idx >> 4) * 320 + (idx & 15) * 16) = in.pv0; }
        { const int idx = tid + 512; *(LAS u32x4*)(buf + MC_V + (idx >> 4) * 320 + (idx & 15) * 16) = in.pv1; }
        scr[par * 64 + lane] = in.ta; scr[128 + par * 64 + lane] = in.tb; scr[256 + par * 64 + lane] = in.tc; scr[384 + par * 64 + lane] = in.tn;
    };
    issue_tiles(X, u0); issue_regs(u0); if (u0 + 1 < u1) issue_tiles(Y, u0 + 1);
    stage(X, 0);
    if (u0 + 2 < u1) issue_tiles(X, u0 + 2);
    LDS_BARRIER();
    auto body = [&](int u, int par, InC& nxt) {
        LAS unsigned char* buf = lds + par * MC_BUF;
        LDS_BARRIER();
        int lo_ = lane; asm volatile("" : "+v"(lo_));
        const int r = lo_ & 31, hh = lo_ >> 5, q16 = (lo_ & 15) >> 2, p16 = lo_ & 3, g16 = (lo_ >> 4) & 1;
        int rb, h; ml_unit_decode(u, rb, h);
        u32x2 og[4]; bf16x8 Cst[2][2]; const float mprev = mpn;
#pragma unroll
        for (int g = 0; g < 4; ++g) og[g] = ogn[g];
        Cst[0][0] = Cn[0][0]; Cst[0][1] = Cn[0][1]; Cst[1][0] = Cn[1][0]; Cst[1][1] = Cn[1][1];
        if (u + 1 < u1) { stage(nxt, par ^ 1); issue_regs(u + 1); }
        if (u + 3 < u1) issue_tiles(nxt, u + 3);
        const int t = 32 * th + r;
        const float bt = scr[128 + par * 64 + t], cmt = scr[256 + par * 64 + t];
        const float Mt = fmaxf(mprev, cmt), mt = bt + Mt, winter = __expf(mprev - Mt);
        f32x16 sD = f32x16{}, sF = f32x16{};
        bf16x8 qf[4];
#pragma unroll
        for (int ks = 0; ks < 4; ++ks) {
            qf[ks] = *(const LAS bf16x8*)(buf + MC_Q + t * 144 + ks * 32 + hh * 16);
            const bf16x8 kD = *(const LAS bf16x8*)(buf + MC_K + t * 144 + ks * 32 + hh * 16);
            sD = MFMA32(kD, qf[ks], sD);
        }
        if (th == 1) {
#pragma unroll
            for (int ks = 0; ks < 4; ++ks) { const bf16x8 kF = *(const LAS bf16x8*)(buf + MC_K + r * 144 + ks * 32 + hh * 16); sF = MFMA32(kF, qf[ks], sF); }
        }
        f32x16 acc = f32x16{};
#pragma unroll
        for (int kb = 0; kb < 2; ++kb)
#pragma unroll
            for (int s = 0; s < 2; ++s) {
                const LAS unsigned char* qp = buf + MC_Q + t * 144 + (32 * kb + 16 * s + 4 * hh) * 2;
                const v4i16 lo = *(const LAS v4i16*)qp, hi = *(const LAS v4i16*)(qp + 16);
                const bf16x8 qb = __builtin_shufflevector(lo, hi, 0, 1, 2, 3, 4, 5, 6, 7);
                acc = MFMA32(Cst[kb][s], qb, acc);
            }
        float psum = 0.f;
#pragma unroll
        for (int i = 0; i < 16; ++i) {
            const int s0 = crow(i, hh);
            const float w0 = __expf(scr[par * 64 + 32 * th + s0] - Mt);
            sD[i] = (s0 <= r) ? sD[i] * w0 : 0.f;
            psum += sD[i];
        }
        if (th == 1) {
#pragma unroll
            for (int i = 0; i < 16; ++i) { const float w1 = __expf(scr[par * 64 + crow(i, hh)] - Mt); sF[i] *= w1; psum += sF[i]; }
        }
        psum = xor32_sum(psum);
        float qn = 0.f;
#pragma unroll
        for (int ks = 0; ks < 4; ++ks) { const u32x4 qq = __builtin_bit_cast(u32x4, qf[ks]); const LAS float* np = scr + 384 + par * 64 + 16 * ks + 8 * hh;
            qn += bf_lo(qq.x) * np[0] + bf_hi(qq.x) * np[1] + bf_lo(qq.y) * np[2] + bf_hi(qq.y) * np[3] + bf_lo(qq.z) * np[4] + bf_hi(qq.z) * np[5] + bf_lo(qq.w) * np[6] + bf_hi(qq.w) * np[7]; }
        qn = xor32_sum(qn);
        const float den = winter * qn + psum;
        const float inv = __builtin_amdgcn_rcpf(fmaxf(fabsf(den), __expf(-mt)));
#pragma unroll
        for (int i = 0; i < 16; ++i) acc[i] *= winter;
        {
            const LAS unsigned char* vb = buf + MC_V + (4 * hh + q16) * 320 + (32 * dvs + 16 * g16 + 4 * p16) * 2;
            const LAS unsigned char* vd = vb + (32 * th) * 320;
#pragma unroll
            for (int s = 0; s < 2; ++s) { const bf16x8 vf = tr_pair(vd + (16 * s) * 320, vd + (16 * s + 8) * 320); acc = MFMA32(vf, pack_step(sD, s), acc); }
            asm volatile("" ::: "memory");
            if (th == 1) {
#pragma unroll
                for (int s = 0; s < 2; ++s) { const bf16x8 vf = tr_pair(vb + (16 * s) * 320, vb + (16 * s + 8) * 320); acc = MFMA32(vf, pack_step(sF, s), acc); }
            }
        }
        float hs = 0.f;
#pragma unroll
        for (int i = 0; i < 16; ++i) { acc[i] *= inv; hs += acc[i] * acc[i]; }
        hs = xor32_sum(hs);
        if (hh == 0) red[(th * 4 + dvs) * 32 + r] = hs;
        LDS_BARRIER();
        const float tot = red[(th * 4 + 0) * 32 + r] + red[(th * 4 + 1) * 32 + r] + red[(th * 4 + 2) * 32 + r] + red[(th * 4 + 3) * 32 + r];
        const float rstd = __builtin_amdgcn_rsqf(tot * (1.0f / 128.0f) + EPS);
        u32x2 ov[4];
#pragma unroll
        for (int g = 0; g < 4; ++g) {
            const f32x4 hgq = *(const LAS f32x4*)(hgl + h * 128 + 32 * dvs + 8 * g + 4 * hh);
            const float o0 = bf_lo(og[g].x), o1 = bf_hi(og[g].x), o2 = bf_lo(og[g].y), o3 = bf_hi(og[g].y);
            const float v0 = acc[4 * g + 0] * rstd * hgq.x * __builtin_amdgcn_rcpf(1.0f + __expf(-o0)), v1 = acc[4 * g + 1] * rstd * hgq.y * __builtin_amdgcn_rcpf(1.0f + __expf(-o1));
            const float v2 = acc[4 * g + 2] * rstd * hgq.z * __builtin_amdgcn_rcpf(1.0f + __expf(-o2)), v3 = acc[4 * g + 3] * rstd * hgq.w * __builtin_amdgcn_rcpf(1.0f + __expf(-o3));
            ov[g].x = pk2(v0, v1); ov[g].y = pk2(v2, v3);
        }
#pragma unroll
        for (int gp = 0; gp < 2; ++gp) {
            const auto sx = __builtin_amdgcn_permlane32_swap(ov[2 * gp].x, ov[2 * gp + 1].x, false, false), sy = __builtin_amdgcn_permlane32_swap(ov[2 * gp].y, ov[2 * gp + 1].y, false, false);
            u32x4 w; w.x = sx[0]; w.y = sy[0]; w.z = sx[1]; w.w = sy[1];
            *(u32x4*)(HG + (size_t)(rb + t) * D + h * 128 + 32 * dvs + 16 * gp + 8 * hh) = w;
        }
    };
#pragma unroll 1
    for (int u = u0; u < u1; u += 2) {
        body(u, 0, Y);
        if (u + 1 < u1) body(u + 1, 1, X);
    }
    LDS_BARRIER();
}

constexpr int AT_HALFB = 65536;
constexpr int AT_TBL = 2 * AT_HALFB;
constexpr int AT_MISC = AT_TBL + 8192;
struct AttnHalf { const bf16_t* Q; const bf16_t* K; const bf16_t* V; int qrow0; int h, qc, t0, t1; };

template <bool SHARED, bool KSPLIT = false>
DI void attn_workunit(ArgsRef a, LAS unsigned char* lds, const AttnHalf hp, int niter, int nmax, bool merge, float lam, float onem, const LAS float* hgain,
                      int tid, int wave, int lane) {
    asm volatile("" : "+v"(lane));
    const int hw = wave >> 2, wl = wave & 3, cbr = wl >> 1, qh = wl & 1, r = lane & 31, hh = lane >> 5;
    const int q16 = (lane & 15) >> 2, p16 = lane & 3, g16 = (lane >> 4) & 1;
    LAS unsigned char* hb = lds + hw * AT_HALFB;
    const LAS float* tbl = (const LAS float*)(lds + AT_TBL) + hp.h * 256;
    bf16_t* HG = (bf16_t*)(a.ws + WS_HG);
    const int n = hp.t1 - hp.t0;
    const int wd = SHARED ? wave : wl;
    const int rowl = 4 * wd + (lane >> 4), pc = lane & 15;
    const int ck = pc ^ (rowl & 15);
    const int cv = (((pc >> 2) ^ ((lane >> 4) & 3)) << 2) | (pc & 3);
    const bf16_t* gk = hp.K + ((size_t)hp.t0 * 64 + rowl) * D + hp.h * 128 + ck * 8;
    const bf16_t* gv = hp.V + ((size_t)hp.t0 * 64 + rowl) * D + hp.h * 128 + cv * 8;
    auto kslot = [&](int j) -> LAS unsigned char* { if constexpr (SHARED) { int sj = j & 3; asm volatile("" : "+s"(sj)); return lds + sj * 32768; } else return hb + (j & 1) * 16384; };
    auto vslot = [&](int j) -> LAS unsigned char* { if constexpr (SHARED) { int sj = j & 3; asm volatile("" : "+s"(sj)); return lds + sj * 32768 + 16384; } else return hb + 32768 + (j & 1) * 16384; };
    auto dma_k = [&](int j) {
        LAS unsigned char* dst = kslot(j) + wd * 1024; const bf16_t* src = gk + (size_t)j * 64 * D;
        if constexpr (SHARED) {
#pragma unroll
            for (int q = 0; q < 2; ++q) __builtin_amdgcn_global_load_lds((const unsigned*)(src + q * 32 * D), (LAS unsigned*)(dst + q * 8192), 16, 0, KSPLIT ? 2 : 0);
        } else {
#pragma unroll
            for (int q = 0; q < 4; ++q) __builtin_amdgcn_global_load_lds((const unsigned*)(src + q * 16 * D), (LAS unsigned*)(dst + q * 4096), 16, 0, 0);
        }
    };
    auto dma_v = [&](int j) {
        LAS unsigned char* dst = vslot(j) + wd * 1024; const bf16_t* src = gv + (size_t)j * 64 * D;
        if constexpr (SHARED) {
#pragma unroll
            for (int q = 0; q < 2; ++q) __builtin_amdgcn_global_load_lds((const unsigned*)(src + q * 32 * D), (LAS unsigned*)(dst + q * 8192), 16, 0, KSPLIT ? 2 : 0);
        } else {
#pragma unroll
            for (int q = 0; q < 4; ++q) __builtin_amdgcn_global_load_lds((const unsigned*)(src + q * 16 * D), (LAS unsigned*)(dst + q * 4096), 16, 0, 0);
        }
    };
    int ka[4], va[4];
    { const int y = (cbr * 8 + hh) ^ (r & 15);
#pragma unroll
      for (int ks = 0; ks < 4; ++ks) ka[ks] = r * 256 + ((y ^ (2 * ks)) << 4);
#pragma unroll
      for (int d = 0; d < 4; ++d) va[d] = (4 * hh + q16) * 256 + ((d ^ q16) << 6) + 32 * g16 + 8 * p16; }
    if constexpr (SHARED) {
        if (nmax > 0) { dma_k(0); dma_v(0); }
        if (nmax > 1) { dma_k(1); dma_v(1); }
        if (nmax > 2) { dma_k(2); dma_v(2); }
    } else {
        if (n > 0) { dma_k(0); dma_v(0); }
        if (n > 1) dma_k(1);
    }
    bf16x8 qf[4];
    { const bf16_t* qp = hp.Q + (size_t)(hp.qrow0 + 32 * qh + r) * D + hp.h * 128 + cbr * 64 + 8 * hh;
#pragma unroll
      for (int ks = 0; ks < 4; ++ks) qf[ks] = *(const bf16x8*)(qp + 16 * ks); }
    f32x16 O[4]; O[0] = f32x16{}; O[1] = f32x16{}; O[2] = f32x16{}; O[3] = f32x16{};
    float mrun = 0.f, lrun = 0.f;
    const float c15 = tbl[0];
    f32x16 cb;
#pragma unroll
    for (int i = 0; i < 16; ++i) cb[i] = c15;
    const int qq = 32 * qh + r;
    auto qk = [&](f32x16& sA, f32x16& sB, int j) {
        const LAS unsigned char* Kt = kslot(j);
        const int dt = hp.qc - (hp.t0 + j);
        bf16x8 kf[8];
#pragma unroll
        for (int ks = 0; ks < 4; ++ks) { kf[2 * ks] = *(const LAS bf16x8*)(Kt + ka[ks]); kf[2 * ks + 1] = *(const LAS bf16x8*)(Kt + ka[ks] + 8192); }
        if (dt >= 3) {
            sA = MFMA32(kf[0], qf[0], cb); sB = MFMA32(kf[1], qf[0], cb);
        } else {
            const int base = 192 - 64 * dt - qq;
#pragma unroll
            for (int i = 0; i < 16; ++i) { sA[i] = tbl[base + crow(i, hh)] - mrun; sB[i] = tbl[base + 32 + crow(i, hh)] - mrun; }
            sA = MFMA32(kf[0], qf[0], sA); sB = MFMA32(kf[1], qf[0], sB);
        }
#pragma unroll
        for (int ks = 1; ks < 4; ++ks) { sA = MFMA32(kf[2 * ks], qf[ks], sA); sB = MFMA32(kf[2 * ks + 1], qf[ks], sB); }
    };
    auto step = [&](int i, f32x16& sA, f32x16& sB, f32x16& nA, f32x16& nB) {
        if constexpr (SHARED) {
            if (i + 2 < nmax) asm volatile("s_waitcnt vmcnt(4) lgkmcnt(0)" ::: "memory"); else asm volatile("s_waitcnt vmcnt(0) lgkmcnt(0)" ::: "memory");
            __builtin_amdgcn_s_barrier(); asm volatile("" ::: "memory");
            if (i + 3 < nmax) { dma_k(i + 3); dma_v(i + 3); }
        } else {
            asm volatile("s_waitcnt vmcnt(0) lgkmcnt(0)" ::: "memory");
            __builtin_amdgcn_s_barrier(); asm volatile("" ::: "memory");
            if (i + 2 < n) dma_k(i + 2);
            if (i + 1 < n) dma_v(i + 1);
        }
        if (i < n) {
            qk(nA, nB, i + 1);
            const LAS unsigned char* Vt = vslot(i);
            float mx0 = max3f(sA[0], sB[0], sA[1]), mx1 = max3f(sB[1], sA[2], sB[2]);
#pragma unroll
            for (int k = 3; k < 15; k += 2) { mx0 = max3f(mx0, sA[k], sB[k]); mx1 = max3f(mx1, sA[k + 1], sB[k + 1]); }
            float mx = max3f(mx0, mx1, sA[15]); mx = max3f(mx, sB[15], sB[15]); mx = xor32_max(mx);
            if (__any(mx > 6.0f)) {
                const float dm = fmaxf(mx, 0.f), alpha = __builtin_amdgcn_exp2f(-dm);
                mrun += dm; lrun *= alpha;
#pragma unroll
                for (int k = 0; k < 16; ++k) { sA[k] -= dm; sB[k] -= dm; nA[k] -= dm; nB[k] -= dm; cb[k] -= dm; }
#pragma unroll
                for (int d = 0; d < 4; ++d)
#pragma unroll
                    for (int k = 0; k < 16; ++k) O[d][k] *= alpha;
            }
            float ps = lrun;
#pragma unroll
            for (int k = 0; k < 8; ++k) { sA[k] = __builtin_amdgcn_exp2f(sA[k]); sB[k] = __builtin_amdgcn_exp2f(sB[k]); ps = ps + sA[k]; ps = ps + sB[k]; }
            const bf16x8 pA0 = pack_step(sA, 0), pB0 = pack_step(sB, 0);
            bf16x8 vf[4];
#pragma unroll
            for (int dh = 0; dh < 2; ++dh) {
#pragma unroll
                for (int d2 = 0; d2 < 2; ++d2) { const int d = 2 * dh + d2; vf[2 * d2] = tr_pair(Vt + va[d], Vt + va[d] + 8 * 256); vf[2 * d2 + 1] = tr_pair(Vt + va[d] + 32 * 256, Vt + va[d] + 40 * 256); }
#pragma unroll
                for (int d2 = 0; d2 < 2; ++d2) { const int d = 2 * dh + d2; O[d] = MFMA32(vf[2 * d2], pA0, O[d]); O[d] = MFMA32(vf[2 * d2 + 1], pB0, O[d]); }
            }
#pragma unroll
            for (int k = 8; k < 16; ++k) { sA[k] = __builtin_amdgcn_exp2f(sA[k]); sB[k] = __builtin_amdgcn_exp2f(sB[k]); ps = ps + sA[k]; ps = ps + sB[k]; }
            lrun = ps;
            const bf16x8 pA1 = pack_step(sA, 1), pB1 = pack_step(sB, 1);
#pragma unroll
            for (int dh = 0; dh < 2; ++dh) {
#pragma unroll
                for (int d2 = 0; d2 < 2; ++d2) { const int d = 2 * dh + d2; vf[2 * d2] = tr_pair(Vt + va[d] + 16 * 256, Vt + va[d] + 24 * 256); vf[2 * d2 + 1] = tr_pair(Vt + va[d] + 48 * 256, Vt + va[d] + 56 * 256); }
#pragma unroll
                for (int d2 = 0; d2 < 2; ++d2) { const int d = 2 * dh + d2; O[d] = MFMA32(vf[2 * d2], pA1, O[d]); O[d] = MFMA32(vf[2 * d2 + 1], pB1, O[d]); }
            }
        }
    };
    f32x16 s0A, s0B, s1A, s1B;
    asm volatile("s_waitcnt vmcnt(0) lgkmcnt(0)" ::: "memory");
    __builtin_amdgcn_s_barrier(); asm volatile("" ::: "memory");
    if constexpr (KSPLIT) {
        auto qk1 = [&](f32x16& sA, int j) {
            const LAS unsigned char* Kt = kslot(j) + hw * 8192;
            const int dt = hp.qc - (hp.t0 + j);
            bf16x8 kf[4];
#pragma unroll
            for (int ks = 0; ks < 4; ++ks) kf[ks] = *(const LAS bf16x8*)(Kt + ka[ks]);
            if (dt >= 3) {
                sA = MFMA32(kf[0], qf[0], cb);
            } else {
                const int base = 192 - 64 * dt - qq + 32 * hw;
#pragma unroll
                for (int i = 0; i < 16; ++i) sA[i] = tbl[base + crow(i, hh)] - mrun;
                sA = MFMA32(kf[0], qf[0], sA);
            }
#pragma unroll
            for (int ks = 1; ks < 4; ++ks) sA = MFMA32(kf[ks], qf[ks], sA);
        };
        auto step1 = [&](int i, f32x16& sA, f32x16& nA) {
            if (i + 2 < nmax) asm volatile("s_waitcnt vmcnt(4) lgkmcnt(0)" ::: "memory"); else asm volatile("s_waitcnt vmcnt(0) lgkmcnt(0)" ::: "memory");
            __builtin_amdgcn_s_barrier(); asm volatile("" ::: "memory");
            if (i + 3 < nmax) { dma_k(i + 3); dma_v(i + 3); }
            if (i < n) {
                qk1(nA, i + 1);
                const LAS unsigned char* Vt = vslot(i) + hw * 8192;
                float mx0 = max3f(sA[0], sA[1], sA[2]), mx1 = max3f(sA[3], sA[4], sA[5]);
#pragma unroll
                for (int k = 6; k < 14; k += 4) { mx0 = max3f(mx0, sA[k], sA[k + 1]); mx1 = max3f(mx1, sA[k + 2], sA[k + 3]); }
                float mx = max3f(mx0, mx1, sA[14]); mx = max3f(mx, sA[15], sA[15]); mx = xor32_max(mx);
                if (__any(mx > 6.0f)) {
                    const float dm = fmaxf(mx, 0.f), alpha = __builtin_amdgcn_exp2f(-dm);
                    mrun += dm; lrun *= alpha;
#pragma unroll
                    for (int k = 0; k < 16; ++k) { sA[k] -= dm; nA[k] -= dm; cb[k] -= dm; }
#pragma unroll
                    for (int d = 0; d < 4; ++d)
#pragma unroll
                        for (int k = 0; k < 16; ++k) O[d][k] *= alpha;
                }
                float ps = 0.f;
#pragma unroll
                for (int k = 0; k < 8; ++k) { sA[k] = __builtin_amdgcn_exp2f(sA[k]); ps += sA[k]; }
                const bf16x8 qA0 = pack_step(sA, 0);
                bf16x8 vf[4];
#pragma unroll
                for (int d = 0; d < 4; ++d) vf[d] = tr_pair(Vt + va[d], Vt + va[d] + 8 * 256);
#pragma unroll
                for (int d = 0; d < 4; ++d) O[d] = MFMA32(vf[d], qA0, O[d]);
#pragma unroll
                for (int k = 8; k < 16; ++k) { sA[k] = __builtin_amdgcn_exp2f(sA[k]); ps += sA[k]; }
                lrun += ps;
                const bf16x8 qA1 = pack_step(sA, 1);
#pragma unroll
                for (int d = 0; d < 4; ++d) vf[d] = tr_pair(Vt + va[d] + 16 * 256, Vt + va[d] + 24 * 256);
#pragma unroll
                for (int d = 0; d < 4; ++d) O[d] = MFMA32(vf[d], qA1, O[d]);
            }
        };
        qk1(s0A, 0);
#pragma unroll 1
        for (int it = 0; it < niter; it += 2) { step1(it, s0A, s1A); step1(it + 1, s1A, s0A); }
    } else {
    qk(s0A, s0B, 0);
#pragma unroll 1
    for (int it = 0; it < niter; it += 2) {
        step(it, s0A, s0B, s1A, s1B);
        step(it + 1, s1A, s1B, s0A, s0B);
    }
    }
    asm volatile("s_waitcnt vmcnt(0)" ::: "memory");
    LDS_BARRIER();
    LAS float* X = (LAS float*)lds;
    if (merge) {
        if (hw == 1) {
            LAS float* xp = X + wl * 66 * 64 + lane;
#pragma unroll
            for (int d = 0; d < 4; ++d)
#pragma unroll
                for (int i = 0; i < 16; ++i) xp[(16 * d + i) * 64] = O[d][i];
            xp[64 * 64] = mrun; xp[65 * 64] = lrun;
        }
        LDS_BARRIER();
        if (hw == 0) {
            const LAS float* xp = X + wl * 66 * 64 + lane;
            const float m2 = xp[64 * 64], l2 = xp[65 * 64];
            const float mn = fmaxf(mrun, m2), f1 = __builtin_amdgcn_exp2f(mrun - mn), f2 = __builtin_amdgcn_exp2f(m2 - mn);
#pragma unroll
            for (int d = 0; d < 4; ++d)
#pragma unroll
                for (int i = 0; i < 16; ++i) O[d][i] = O[d][i] * f1 + xp[(16 * d + i) * 64] * f2;
            lrun = lrun * f1 + l2 * f2; mrun = mn;
        }
        LDS_BARRIER();
    }
    const float ltot = xor32_sum(lrun);
    const float linv = 1.0f / ltot;
    LAS float* xb = (LAS float*)(lds + hw * AT_HALFB) + qh * 64 * 64 + lane;
    if (cbr == 1) {
#pragma unroll
        for (int d = 0; d < 4; ++d)
#pragma unroll
            for (int i = 0; i < 16; ++i) xb[(16 * d + i) * 64] = O[d][i] * linv;
    }
    LDS_BARRIER();
    if (cbr == 0 && !(merge && hw == 1)) {
        float ssq = 0.f;
#pragma unroll
        for (int d = 0; d < 4; ++d)
#pragma unroll
            for (int i = 0; i < 16; ++i) { const float v = O[d][i] * linv - lam * xb[(16 * d + i) * 64]; O[d][i] = v; ssq += v * v; }
        ssq = xor32_sum(ssq);
        const float rs = __builtin_amdgcn_rsqf(ssq * (1.0f / 128.0f) + EPS) * onem;
        bf16_t* op = HG + (size_t)(hp.qrow0 + 32 * qh + r) * D + hp.h * 128;
#pragma unroll
        for (int d = 0; d < 4; ++d)
#pragma unroll
            for (int gp = 0; gp < 2; ++gp) {
                u32x2 o[2];
#pragma unroll
                for (int q = 0; q < 2; ++q) { const int g = 2 * gp + q; const f32x4 g4 = *(const LAS f32x4*)(hgain + 32 * d + 8 * g + 4 * hh);
                    o[q].x = pk2(O[d][4 * g] * rs * g4.x, O[d][4 * g + 1] * rs * g4.y); o[q].y = pk2(O[d][4 * g + 2] * rs * g4.z, O[d][4 * g + 3] * rs * g4.w); }
                const auto sx = __builtin_amdgcn_permlane32_swap(o[0].x, o[1].x, false, false), sy = __builtin_amdgcn_permlane32_swap(o[0].y, o[1].y, false, false);
                u32x4 w; w.x = sx[0]; w.y = sy[0]; w.z = sx[1]; w.w = sy[1];
                *(u32x4*)(op + 32 * d + 16 * gp + 8 * hh) = w;
            }
    }
    LDS_BARRIER();
}
DI int rel_bucket(int rel) {
    const int n = rel < 0 ? -rel : rel; int b;
    if (n < 8) b = n; else { const int lg = 31 - __builtin_clz((unsigned)(n * n)); b = 2 + lg; if (b > 15) b = 15; }
    return (rel > 0 ? 16 : 0) + b;
}
DI void attn_phase(ArgsRef a, LAS unsigned char* lds, int j  , int vcu, int G, int tid, int wave, int lane) {
    LAS float* tbl = (LAS float*)(lds + AT_TBL);
    for (int i = tid; i < 8 * 256; i += 512) { const int h = i >> 8, rel = (i & 255) - 192; tbl[i] = a.in[I_RELB][rel_bucket(rel) * 8 + h] * LOG2E; }
    LAS float* misc = (LAS float*)(lds + AT_MISC);
    if (wave == 0) {
        const float* lp = a.in[I_LAM] + (size_t)j * 256;
        const float s1 = wave_sum(lp[lane] * lp[64 + lane]), s2 = wave_sum(lp[128 + lane] * lp[192 + lane]);
        if (lane == 0) misc[0] = expf(s1) - expf(s2);
    }
    LDS_BARRIER();
    const int l = 2 + j;
    const float lam_init = 0.8f - 0.6f * expf(-0.3f * (float)l);
    const float lam = misc[0] + lam_init, onem = 1.0f - lam_init;
    { LAS float* hgl = (LAS float*)(lds + AT_MISC + 64); if (tid < 128) hgl[tid] = a.in[I_AHG][(size_t)j * 128 + tid]; }
    const LAS float* hgain = (const LAS float*)(lds + AT_MISC + 64);
    const bf16_t* Q = (const bf16_t*)(a.ws + WS_PROJ);
    const bf16_t* KP = (const bf16_t*)(a.ws + WS_KP); const bf16_t* VP = (const bf16_t*)(a.ws + WS_VP);
    const bf16_t* KS = (const bf16_t*)(a.ws + WS_KS); const bf16_t* VS = (const bf16_t*)(a.ws + WS_VS);
    const int hw = wave >> 2;
#pragma unroll 1
    for (int v = vcu; v < 256; v += G) {
        const int xg = v >> 5, jj = v & 31;
        {
            const int b = v >> 3;
            AttnHalf hp; hp.Q = Q; hp.K = KS + (size_t)b * KSROWS * D; hp.V = VS + (size_t)b * KSROWS * D; hp.qrow0 = MP + b * 64; hp.h = v & 7; hp.qc = 64;
            hp.t0 = 0; hp.t1 = 65;
            for (int rep = 0; rep < REP_N(11); ++rep)
            attn_workunit<true, true>(a, lds, hp, 65, 65, true, lam, onem, hgain, tid, wave, lane);
        }
#pragma unroll 1
        for (int h = 0; h < 8; ++h) {
            const int c = (h & 1) ? 31 - jj : jj, qc = 2 * c + hw;
            AttnHalf hp; hp.Q = Q; hp.K = KP + (size_t)xg * 4096 * D; hp.V = VP + (size_t)xg * 4096 * D; hp.qrow0 = xg * 4096 + qc * 64; hp.h = h; hp.qc = qc;
            hp.t0 = 0; hp.t1 = qc + 1;
            for (int rep = 0; rep < REP_N(12); ++rep)
            attn_workunit<true>(a, lds, hp, 2 * c + 2, 2 * c + 2, false, lam, onem, hgain, tid, wave, lane);
        }
    }
}

constexpr int N_PHASES = 35;
__host__ __device__ constexpr bool phase_exists(int p) { return p == 0 || (((p - 1) % 9) < 7) || ((p - 1) / 9 == 1); }

__global__ void __launch_bounds__(NWAVES * 64, 2) yoco_fwd(Args args) {
    extern __shared__ __attribute__((aligned(16))) unsigned char lds_raw[];
    LAS unsigned char* lds = (LAS unsigned char*)lds_raw;
    volatile LAS unsigned* MISC = (volatile LAS unsigned*)(lds + MISC_OFF);
#define PH_IDS const int tid = opaque_tid(wv0), lane = tid & 63, wave = __builtin_amdgcn_readfirstlane(tid >> 6)
    const int G = gridDim.x; const int bx = blockIdx.x; const int vcu = (G % 8 == 0) ? (bx % 8) * (G / 8) + bx / 8 : bx;
    unsigned char* ws = args.ws;
    const int wv0 = __builtin_amdgcn_readfirstlane((int)threadIdx.x >> 6);
    if (threadIdx.x < 32) MISC[threadIdx.x] = 0u;
    __syncthreads();
    XcdBarrier bar; bar.bar = (unsigned*)(ws + WS_CTL) + 4096; bar.x = 0; bar.w0 = wv0; bar.st = nullptr;
#if MK_SINGLE_LAUNCH
    bar = xcd_barrier_post((unsigned*)(ws + WS_CTL) + 4096, wv0, MISC + 8);
#endif
    const int lo = args.ph_lo, hi = args.ph_hi;
#define IN(k) (lo <= (k) && (k) < hi)
#define REP_BEGIN(k) for (int rep = 0; rep < REP_N(k); ++rep) { if (rep) xcd_barrier(bar);
#define REP_END }
#if MK_SINGLE_LAUNCH
#define SEAM(k) do { if ((k) + 1 < hi) xcd_barrier(bar); } while (0)
#else
#define SEAM(k) do { } while (0)
#endif
#define PH_PTRS ArgsRef A = kargs(); unsigned char* ws = A.ws; float* X = A.out + OFF_Y; const float* mod = (const float*)(ws + WS_MOD); bf16_t* XB = (bf16_t*)(ws + WS_XB); \
    bf16_t* XM = (bf16_t*)(ws + WS_XM); bf16_t* HGb = (bf16_t*)(ws + WS_HG); bf16_t* PROJ = (bf16_t*)(ws + WS_PROJ); bf16_t* HID = (bf16_t*)(ws + WS_HID); \
    (void)X; (void)mod; (void)XB; (void)XM; (void)HGb; (void)PROJ; (void)HID
#define PH_LPTRS PH_PTRS; const float* modl = mod + (size_t)l * 40 * 6144; \
    const void* xP = l == 0 ? (const void*)A.in[I_XP] : (const void*)XB; const void* xS = l == 0 ? (const void*)A.in[I_XS] : (const void*)(XB + (size_t)MP * D); (void)modl; (void)xP; (void)xS

    if (PH_ON(0) && IN(0)) {
        PH_PTRS;
        PH_IDS;
        REP_BEGIN(0)
        prologue_weights(A, lds, vcu * NWAVES + wave, G * NWAVES, wave, lane, 0);
        __syncthreads();
        prologue_adaln(A, lds, vcu, G, tid, wave, lane);
        REP_END
        SEAM(0);
    }
#pragma unroll 1
    for (int l = 0; l < 4; ++l) {
        const int pb = 1 + 9 * l;
        if (PH_ON(1) && IN(pb + 0) && l != 2) {
            PH_LPTRS;
            PH_IDS;
            REP_BEGIN(1)
            if (l < 2) norm_phase<true, true>(A, lds, xP, xS, l != 0, A.in[I_NORMG] + (size_t)(l * 2 + 0) * D, modl, 0, 1024, A.in[I_WIN] + (size_t)l * 1024 * MIN + NPROJ, A.in[I_BG] + l * 16, vcu, G, tid, wave, lane);
            else norm_phase<true, false>(A, lds, xP, xS, 1, A.in[I_NORMG] + (size_t)(l * 2 + 0) * D, modl, 0, 1024, nullptr, nullptr, vcu, G, tid, wave, lane);
            REP_END
            SEAM(pb + 0);
        }
        if (IN(pb + 1) && l != 2) {
            PH_LPTRS;
            REP_BEGIN(2)
            if (!PH_ON(2)) {} else if (l < 2) {
                pg8::Gemm g{XM, (const bf16_t*)(ws + WS_WIN) + (size_t)l * NPROJ * 1024, M, NPROJ, 1024}; pg8::StaticOrder S; S.init(M, NPROJ, G, bx);
                EpiProj E{PROJ};
                pg8::gemm_phase<EpiProj, pg8::StaticOrder, true, true>(lds, g, S, E, wv0);
                {
                    const int nfull = ((M / 256) * (NPROJ / 256)) % G;
                    if (bx >= nfull) prologue_cache(A, (bx - nfull) * 512 + opaque_tid(wv0), (G - nfull) * 512, l == 0 ? 0L : CACHE_T0, l == 0 ? CACHE_T0 : CACHE_T1);
                }
            } else {
                pg8::Gemm g{XM, (const bf16_t*)(ws + WS_WQ) + (size_t)(l - 2) * 1048576, MP, 1024, 1024}; pg8::StaticOrder S; S.init(MP, 1024, G, bx);
                EpiQ E{PROJ, A.in[I_QG] + (l - 2) * 64, 0.125f * LOG2E};
                pg8::gemm_phase<EpiQ, pg8::StaticOrder, true, true>(lds, g, S, E, wv0);
                const int tid = opaque_tid(wv0), wave = __builtin_amdgcn_readfirstlane(tid >> 6), lane = tid & 63;
                EpiQSmall Es{PROJ + (size_t)MP * D, A.in[I_QG] + (l - 2) * 64, 0.125f * LOG2E, (LAS float*)(lds + 2 * GS_BUF)};
                gemm_small<EpiQSmall, true>(lds, XM + (size_t)MP * D, (const bf16_t*)(ws + WS_WQ) + (size_t)(l - 2) * 1048576, 32, 8, 1024, Es, vcu, G, tid, wave, lane);
            }
            REP_END
            SEAM(pb + 1);
        }
        if (IN(pb + 2)) {
            PH_LPTRS;
            PH_IDS;
            if (l < 2) { if (PH_ON(3)) for (int rep = 0; rep < REP_N(3); ++rep) { if (rep) xcd_barrier(bar);
                if ((ML3_MASK >> l) & 1) {
                    mlA_phase(A, lds, vcu, G, tid, wave, lane); xcd_barrier(bar);
                    mlB_phase(A, l, vcu, G, tid); xcd_barrier(bar);
                    mlC_phase(A, lds, l, vcu, G, tid, wave, lane);
                } else mlstm_phase(A, lds, l, vcu, G, tid, wave, lane); } }
            else if (PH_ON(4)) for (int rep = 0; rep < REP_N(4); ++rep) { if (rep) xcd_barrier(bar); attn_phase(A, lds, l - 2, vcu, G, tid, wave, lane); }
            SEAM(pb + 2);
        }
        if (PH_ON(5) && IN(pb + 3)) {
            PH_LPTRS;
            PH_IDS;
            REP_BEGIN(5)
            {
                pg8::Gemm g{HGb, (const bf16_t*)(ws + WS_WMO) + (size_t)l * 1048576, MP, 1024, 1024}; pg8::StaticOrder S; S.init(MP, 1024, G, bx);
                EpiRes E{xP, xS, (REP_N(5) == 2 && rep == 0) ? (void*)(ws + WS_HID) : (void*)XB, modl + 2048, l != 0, 1};
                pg8::gemm_phase<EpiRes, pg8::StaticOrder, true, true>(lds, g, S, E, wv0);
            }
            {
                bf16_t* Xs = ((REP_N(5) == 2 && rep == 0) ? (bf16_t*)(ws + WS_HID) : XB) + (size_t)MP * D;
                EpiResSmall E{xS, Xs, modl + 2048, l != 0, 1};
                gemm_small<EpiResSmall>(lds, HGb + (size_t)MP * D, (const bf16_t*)(ws + WS_WMO) + (size_t)l * 1048576, 32, 8, 1024, E, vcu, G, tid, wave, lane);
            }
            REP_END
            SEAM(pb + 3);
        }
        if (PH_ON(6) && IN(pb + 4)) {
            PH_LPTRS;
            PH_IDS;
            REP_BEGIN(6)
            norm_phase<true, false>(A, lds, XB, XB + (size_t)MP * D, 1, A.in[I_NORMG] + (size_t)(l * 2 + 1) * D, modl, 3072, 4096, nullptr, nullptr, vcu, G, tid, wave, lane);
            REP_END
            SEAM(pb + 4);
        }
        if (PH_ON(7) && IN(pb + 5)) {
            PH_LPTRS;
            pg8::Gemm g{XM, (const bf16_t*)(ws + WS_WGU) + (size_t)l * 5632 * 1024, M, 5632, 1024}; pg8::StaticOrder S; S.init(M, 5632, G, bx);
            REP_BEGIN(7)
            EpiSwiglu E{HID};
            pg8::gemm_phase<EpiSwiglu, pg8::StaticOrder, true, true>(lds, g, S, E, wv0);
            REP_END
            if (l < 2) {
                const int nfull = ((M / 256) * (5632 / 256)) % G;
                if (bx >= nfull) prologue_cache(A, (bx - nfull) * 512 + opaque_tid(wv0), (G - nfull) * 512, l == 0 ? CACHE_T1 : CACHE_T2, l == 0 ? CACHE_T2 : CACHE_T3);
            }
            SEAM(pb + 5);
        }
        if (PH_ON(8) && IN(pb + 6)) {
            PH_LPTRS;
            PH_IDS;
            REP_BEGIN(8)
            {
                pg8::Gemm g{HID, (const bf16_t*)(ws + WS_WD) + (size_t)l * 1024 * DFF, MP, 1024, DFF}; pg8::StaticOrder S; S.init(MP, 1024, G, bx);
                EpiRes E{XB, XB + (size_t)MP * D, (REP_N(8) == 2 && rep == 0) ? (void*)(ws + WS_PROJ) : (l == 3 ? (void*)X : (void*)XB), modl + 5120, 1, (REP_N(8) == 2 && rep == 0) ? 1 : (l != 3)};
                pg8::gemm_phase<EpiRes, pg8::StaticOrder, true, true>(lds, g, S, E, wv0);
            }
            {
                const int obf = (REP_N(8) == 2 && rep == 0) ? 1 : (l != 3);
                void* Xo = (REP_N(8) == 2 && rep == 0) ? (void*)((bf16_t*)(ws + WS_PROJ) + (size_t)MP * D) : (l == 3 ? (void*)(X + (size_t)MP * D) : (void*)(XB + (size_t)MP * D));
                EpiResSmall E{XB + (size_t)MP * D, Xo, modl + 5120, 1, obf};
                gemm_small<EpiResSmall>(lds, HID + (size_t)MP * DFF, (const bf16_t*)(ws + WS_WD) + (size_t)l * 1024 * DFF, 32, 8, DFF, E, vcu, G, tid, wave, lane);
            }
            REP_END
            SEAM(pb + 6);
        }
        if (l == 1) {
            if (PH_ON(9) && IN(pb + 7)) {
                PH_LPTRS;
                PH_IDS;
                REP_BEGIN(9)
                norm_dual_phase(A, XB, XM, (bf16_t*)(ws + WS_HID), A.in[I_KVG], A.in[I_NORMG] + (size_t)(2 * 2 + 0) * D, mod + (size_t)2 * 40 * 6144, 0, 1024, vcu, G, wave, lane);
                REP_END
                SEAM(pb + 7);
            }
            if (PH_ON(10) && IN(pb + 8)) {
                PH_LPTRS;
                pg8::Gemm g{XM, (const bf16_t*)(ws + WS_WKV), MP, 2048, 1024}; pg8::StaticOrder S; S.init(MP, 2048, G, bx);
                REP_BEGIN(10)
                EpiKV E{A.out, ws, A.in[I_KG]};
                pg8::gemm_phase<EpiKV, pg8::StaticOrder, true, true>(lds, g, S, E, wv0);
                REP_END
                {
                    pg8::Gemm gq{(const bf16_t*)(ws + WS_HID), (const bf16_t*)(ws + WS_WQ), MP, 1024, 1024}; pg8::StaticOrder Sq; Sq.init(MP, 1024, G, bx);
                    EpiQ Eq{PROJ, A.in[I_QG], 0.125f * LOG2E};
                    pg8::gemm_phase<EpiQ, pg8::StaticOrder, true, true>(lds, gq, Sq, Eq, wv0);
                }
                {
                    const int tid = opaque_tid(wv0), wave = __builtin_amdgcn_readfirstlane(tid >> 6), lane = tid & 63;
                    LAS float* Xn = (LAS float*)(lds + 2 * GS_BUF);
                    EpiKVSmall<true> Ek{A.out + OFF_SK, (bf16_t*)(ws + WS_KS), A.in[I_KG], Xn};
                    gemm_small<EpiKVSmall<true>, true>(lds, XM + (size_t)MP * D, (const bf16_t*)(ws + WS_WKV), 32, 8, 1024, Ek, vcu, G, tid, wave, lane);
                    EpiKVSmall<false> Ev{A.out + OFF_SV, (bf16_t*)(ws + WS_VS), nullptr, Xn};
                    gemm_small<EpiKVSmall<false>, false>(lds, XM + (size_t)MP * D, (const bf16_t*)(ws + WS_WKV) + 1048576, 32, 8, 1024, Ev, vcu, G, tid, wave, lane);
                    EpiQSmall Es{PROJ + (size_t)MP * D, A.in[I_QG], 0.125f * LOG2E, Xn};
                    gemm_small<EpiQSmall, true>(lds, (const bf16_t*)(ws + WS_HID) + (size_t)MP * D, (const bf16_t*)(ws + WS_WQ), 32, 8, 1024, Es, vcu, G, tid, wave, lane);
                }
                SEAM(pb + 8);
            }
        }
    }
#undef IN
#undef SEAM
}

extern "C" void kernel_launch(void* const* d_in, const int* in_sizes, int n_in, void* d_out, int out_size, void* d_ws, size_t ws_size, hipStream_t stream) {
    static int grid = 0;
    if (grid == 0) {
        if (n_in != 29 || out_size != OUT_TOTAL || ws_size < WS_END) { fprintf(stderr, "kernel_launch: unexpected shapes: n_in %d out %d ws %zu\n", n_in, out_size, ws_size); grid = -1; return; }
        int dev = 0, cus = 0, per_cu = 0;
        if (hipGetDevice(&dev) != hipSuccess || hipDeviceGetAttribute(&cus, hipDeviceAttributeMultiprocessorCount, dev) != hipSuccess) { grid = -1; return; }
        if (hipFuncSetAttribute((const void*)yoco_fwd, hipFuncAttributeMaxDynamicSharedMemorySize, LDS_BYTES) != hipSuccess) { fprintf(stderr, "kernel_launch: hipFuncSetAttribute failed\n"); grid = -1; return; }
        if (hipOccupancyMaxActiveBlocksPerMultiprocessor(&per_cu, (const void*)yoco_fwd, NWAVES * 64, LDS_BYTES) != hipSuccess || per_cu < 1)
            fprintf(stderr, "kernel_launch: note: occupancy query reports %d workgroups per CU\n", per_cu);
        (void)hipGetLastError();
        grid = cus;
    }
    if (grid < 0) return;
    if (hipMemsetAsync((char*)d_ws + WS_CTL, 0, CTL_ZERO_BYTES, stream) != hipSuccess) { fprintf(stderr, "kernel_launch: memset failed\n"); return; }
    Args a{};
    for (int i = 0; i < 29; ++i) a.in[i] = (const float*)d_in[i];
    a.out = (float*)d_out; a.ws = (unsigned char*)d_ws;
#if MK_SINGLE_LAUNCH
    a.ph_lo = 0; a.ph_hi = N_PHASES;
    hipLaunchKernelGGL(yoco_fwd, dim3(grid), dim3(NWAVES * 64), LDS_BYTES, stream, a);
#else
    for (int p = 0; p < N_PHASES; ++p) {
        if (!phase_exists(p)) continue;
        a.ph_lo = p; a.ph_hi = p + 1;
        hipLaunchKernelGGL(yoco_fwd, dim3(grid), dim3(NWAVES * 64), LDS_BYTES, stream, a);
    }
#endif
    const hipError_t le = hipPeekAtLastError();
    if (le != hipSuccess) fprintf(stderr, "kernel_launch: launch failed: %s\n", hipGetErrorName(le));
}
```
